# Optimizing an MI355X kernel written in HIP

```python
import jax
import jax.numpy as jnp
from jax import lax
import numpy as np

D_MODEL = 2048
BATCH = 4
SEQ = 4096
DEPTH = 2

GRID_W = 64
CTX_LEN = 256
RMS_EPS = 1e-6

HG_HEADS = 8
HG_DK = 128
HG_DV = 128
HG_WIDTH = HG_HEADS * HG_DV
HG_CHUNK = 64
POOL_WINDOWS = (2, 4, 8, 16)
POOL_WIDTH = 1024
POOL_GROUP = POOL_WIDTH // len(POOL_WINDOWS)
MLA_HEADS = 16
Q_LORA = 512
KV_LORA = 512
QK_NOPE = 128
QK_ROPE = 64
V_HEAD = 128
MLA_WIDTH = MLA_HEADS * V_HEAD
MLA_SCALE = (QK_NOPE + QK_ROPE) ** -0.5
ROPE_THETA = 10000.0
Q_BLOCK = 128
N_BRANCH = 3
PEER_HEADS = 8
PEER_NKEYS = 128
PEER_N = PEER_NKEYS * PEER_NKEYS
PEER_DKEY = 256
PEER_TOPK = 16
TOK_BLOCK = 128

IN_SIZES = (HG_HEADS * HG_DK, HG_HEADS * HG_DK, HG_HEADS * HG_DK, HG_WIDTH, HG_WIDTH,
            POOL_WIDTH, Q_LORA, KV_LORA, QK_ROPE, N_BRANCH * D_MODEL)
IN_COLS = sum(IN_SIZES)

kernel_name = 'hybrid_hgrn2_pool_mla_peer_dit_block'


def rms_norm(x, w, eps=RMS_EPS):
    xf = x.astype(jnp.float32)
    y = xf * lax.rsqrt(jnp.mean(xf * xf, axis=-1, keepdims=True) + eps)
    return (y * w.astype(jnp.float32)).astype(x.dtype)


def modulate(x, gain, shift, scale):
    return rms_norm(x, gain) * (1 + scale) + shift


def split_projection(p):
    parts, start = [], 0
    for size in IN_SIZES:
        parts.append(p[..., start:start + size])
        start += size
    return parts


def axial_rope_tables(n_tokens):
    rows = n_tokens // GRID_W
    r, col = jnp.meshgrid(jnp.arange(rows), jnp.arange(GRID_W), indexing='ij')
    n_freq = QK_ROPE // 4
    freqs = ROPE_THETA ** (-jnp.arange(n_freq, dtype=jnp.float32) / n_freq)
    ang = jnp.stack([r.reshape(-1)[:, None] * freqs, col.reshape(-1)[:, None] * freqs], axis=1)
    return jnp.cos(ang), jnp.sin(ang)


def apply_axial_rope(x, cos, sin):
    xs = x.reshape(x.shape[:-1] + (2, 2, QK_ROPE // 4))
    cs = cos[None, :, None].astype(x.dtype)
    sn = sin[None, :, None].astype(x.dtype)
    x1, x2 = xs[..., 0, :], xs[..., 1, :]
    return jnp.stack([x1 * cs - x2 * sn, x2 * cs + x1 * sn], axis=-2).reshape(x.shape)


def hgrn_lower_bounds(logits):
    cum = jnp.cumsum(jax.nn.softmax(logits.astype(jnp.float32), axis=0), axis=0)
    return cum - cum[0:1]


def gla_chunkwise(q, k, v, log_f, s0):
    B_, H_, L, _ = q.shape
    n = L // HG_CHUNK

    def to_chunks(t):
        return jnp.moveaxis(t.reshape(B_, H_, n, HG_CHUNK, t.shape[-1]), 2, 0)

    causal = jnp.tril(jnp.ones((HG_CHUNK, HG_CHUNK), dtype=bool))

    def step(S, chunk):
        qc, kc, vc, lf = chunk
        b = jnp.cumsum(lf, axis=2)
        b_end = b[:, :, -1:, :]
        rel = jnp.where(causal[:, :, None], b[:, :, :, None, :] - b[:, :, None, :, :], -jnp.inf)
        scores = jnp.einsum('bhtc,bhsc,bhtsc->bhts', qc, kc, jnp.exp(rel))
        o = (jnp.einsum('bhts,bhsv->bhtv', scores, vc)
             + jnp.einsum('bhtc,bhcv->bhtv', qc * jnp.exp(b), S))
        S_new = (jnp.exp(b_end[:, :, 0, :])[..., None] * S
                 + jnp.einsum('bhsc,bhsv->bhcv', kc * jnp.exp(b_end - b), vc))
        return S_new, o

    s_final, o = lax.scan(step, s0, (to_chunks(q), to_chunks(k), to_chunks(v), to_chunks(log_f)))
    return jnp.moveaxis(o, 0, 2).reshape(B_, H_, L, v.shape[-1]), s_final


def hgrn_direction(q, f_raw, v, lb, s0, reverse):
    lbf = lb.astype(jnp.float32)
    log_f = jnp.logaddexp(jnp.log(lbf), jnp.log1p(-lbf) + jax.nn.log_sigmoid(f_raw.astype(jnp.float32)))
    k = -jnp.expm1(log_f)

    def heads(t, d):
        t = t.astype(jnp.float32)
        if reverse:
            t = jnp.flip(t, axis=1)
        return jnp.transpose(t.reshape(t.shape[0], t.shape[1], HG_HEADS, d), (0, 2, 1, 3))

    o, s_final = gla_chunkwise(heads(q, HG_DK), heads(k, HG_DK), heads(v, HG_DV), heads(log_f, HG_DK), s0)
    if reverse:
        o = jnp.flip(o, axis=2)
    return o, s_final


def hgrn_readout(o, g, norm_w):
    B_, _, L, _ = o.shape
    o = rms_norm(jnp.transpose(o, (0, 2, 1, 3)), norm_w).reshape(B_, L, HG_WIDTH)
    return (o * jax.nn.silu(g.astype(jnp.float32))).astype(g.dtype)


def hgrn2_mixer(pc, pl, lb_pair, norm_w, need_ctx_out):
    s0 = jnp.zeros((pl[0].shape[0], HG_HEADS, HG_DK, HG_DV), jnp.float32)
    qc, ql = jax.nn.silu(pc[0]), jax.nn.silu(pl[0])
    oc_f, s_fwd = hgrn_direction(qc, pc[1], pc[3], lb_pair[0], s0, False)
    oc_b, s_bwd = hgrn_direction(qc, pc[2], pc[3], lb_pair[1], s0, True)
    ol_f, _ = hgrn_direction(ql, pl[1], pl[3], lb_pair[0], s_fwd, False)
    ol_b, _ = hgrn_direction(ql, pl[2], pl[3], lb_pair[1], s_bwd, True)
    out_l = hgrn_readout(ol_f + ol_b, pl[4], norm_w)
    out_c = hgrn_readout(oc_f + oc_b, pc[4], norm_w) if need_ctx_out else None
    return out_l, out_c


def multiscale_pool(u, w_pool, pool_scale):
    B_, L, _ = u.shape
    uf = u.astype(jnp.float32)
    csum = jnp.concatenate([jnp.zeros((B_, 1, POOL_WIDTH), jnp.float32), jnp.cumsum(uf, axis=1)], axis=1)
    t = jnp.arange(L)
    groups = []
    for gi, win in enumerate(POOL_WINDOWS):
        lo = jnp.clip(t - win // 2, 0, L)
        hi = jnp.clip(t + win // 2, 0, L)
        sl = slice(gi * POOL_GROUP, (gi + 1) * POOL_GROUP)
        cs = csum[:, :, sl]
        mean = (cs[:, hi] - cs[:, lo]) / (hi - lo).astype(jnp.float32)[None, :, None]
        groups.append(mean - uf[:, :, sl])
    pooled = jnp.stack(groups, axis=2)
    mixed = jnp.einsum('blgi,gio->blgo', pooled, w_pool.astype(jnp.float32))
    return (mixed.reshape(B_, L, POOL_WIDTH) * pool_scale.astype(jnp.float32)).astype(u.dtype)


def mla_queries(c_q, q_norm_w, w_uq, rope):
    B_, L, _ = c_q.shape
    q = (rms_norm(c_q, q_norm_w) @ w_uq).reshape(B_, L, MLA_HEADS, QK_NOPE + QK_ROPE)
    if rope is None:
        return q
    return jnp.concatenate([q[..., :QK_NOPE], apply_axial_rope(q[..., QK_NOPE:], *rope)], axis=-1)


def mla_keys_values(c_kv, k_rope_raw, kv_norm_w, w_ukv, rope):
    B_, L, _ = c_kv.shape
    kv = (rms_norm(c_kv, kv_norm_w) @ w_ukv).reshape(B_, L, MLA_HEADS, QK_NOPE + V_HEAD)
    k_rope = k_rope_raw[:, :, None, :]
    if rope is not None:
        k_rope = apply_axial_rope(k_rope, *rope)
    k = jnp.concatenate([kv[..., :QK_NOPE], jnp.broadcast_to(k_rope, (B_, L, MLA_HEADS, QK_ROPE))], axis=-1)
    return k, kv[..., QK_NOPE:]


def block_attention(q, k, v):
    B_, L, H_, Dqk = q.shape
    nb = L // Q_BLOCK
    q_blocks = jnp.moveaxis(q.reshape(B_, nb, Q_BLOCK, H_, Dqk), 1, 0)

    def attend(qb):
        s = jnp.einsum('bqhd,bkhd->bhqk', qb, k).astype(jnp.float32) * MLA_SCALE
        p = jax.nn.softmax(s, axis=-1).astype(v.dtype)
        return jnp.einsum('bhqk,bkhd->bqhd', p, v)

    o = lax.map(attend, q_blocks)
    return jnp.moveaxis(o, 0, 1).reshape(B_, L, H_ * v.shape[-1])


def mla_mixer(pc, pl, q_norm_w, w_uq, kv_norm_w, w_ukv, rope, need_ctx_out):
    k_c, v_c = mla_keys_values(pc[1], pc[2], kv_norm_w, w_ukv, None)
    k_l, v_l = mla_keys_values(pl[1], pl[2], kv_norm_w, w_ukv, rope)
    q_l = mla_queries(pl[0], q_norm_w, w_uq, rope)
    out_l = block_attention(q_l, jnp.concatenate([k_c, k_l], axis=1), jnp.concatenate([v_c, v_l], axis=1))
    out_c = block_attention(mla_queries(pc[0], q_norm_w, w_uq, None), k_c, v_c) if need_ctx_out else None
    return out_l, out_c


def merge_branches(y_a, y_b, y_c, gate_raw, w_a, w_b, w_c, w_o):
    g = jax.nn.sigmoid(gate_raw)
    m = (g[..., :D_MODEL] * (y_a @ w_a)
         + g[..., D_MODEL:2 * D_MODEL] * (y_b @ w_b)
         + g[..., 2 * D_MODEL:] * (y_c @ w_c))
    return m @ w_o


def peer_ffn(h, wq, keys, u_tab, v_tab):
    B_, L, D = h.shape
    tokens = h.reshape(-1, TOK_BLOCK, D)

    def one_block(hb):
        T = hb.shape[0]
        qh = (hb @ wq).reshape(T, PEER_HEADS, 2, PEER_DKEY // 2)
        s = jnp.einsum('thpd,phkd->thpk', qh, keys).astype(jnp.float32)
        s_top, i_top = lax.top_k(s, PEER_TOPK)
        cand = (s_top[:, :, 0, :, None] + s_top[:, :, 1, None, :]).reshape(T, PEER_HEADS, -1)
        cand_idx = (i_top[:, :, 0, :, None] * PEER_NKEYS + i_top[:, :, 1, None, :]).reshape(T, PEER_HEADS, -1)
        best, pos = lax.top_k(cand, PEER_TOPK)
        idx = jnp.take_along_axis(cand_idx, pos, axis=-1)
        gate = jax.nn.softmax(best, axis=-1)
        u = jnp.take(u_tab, idx, axis=0)
        act = jnp.einsum('thkd,td->thk', u, hb).astype(jnp.float32)
        w = (gate * jax.nn.gelu(act, approximate=False)).astype(v_tab.dtype)
        return jnp.einsum('thk,thkd->td', w, jnp.take(v_tab, idx, axis=0))

    return lax.map(one_block, tokens).reshape(B_, L, D)


def setup_inputs(seed: int = 0) -> dict:
    key = jax.random.key(seed)
    ks = jax.random.split(key, 32)
    D = D_MODEL

    def nrm(i, shape, std):
        return jax.random.normal(ks[i], shape, jnp.float32) * std

    def gain(i, shape):
        return 1.0 + nrm(i, shape, 0.05)

    return {
        'x': nrm(0, (BATCH, SEQ, D), 1.0),
        'c': nrm(1, (BATCH, D), 1.0),
        'ctx': nrm(2, (BATCH, CTX_LEN, D), 1.0),
        'c_ctx': nrm(3, (D,), 1.0),
        'w_mod': nrm(4, (DEPTH, D, 6 * D), 0.5 * D ** -0.5),
        'b_mod': nrm(5, (DEPTH, 6 * D), 0.01),
        'norm_mix': gain(6, (DEPTH, D)),
        'norm_ffn': gain(7, (DEPTH, D)),
        'w_in': nrm(8, (DEPTH, D, IN_COLS), D ** -0.5),
        'hg_lb_logits': nrm(9, (DEPTH, 2, HG_HEADS * HG_DK), 1.0),
        'hg_norm': gain(10, (DEPTH, HG_DV)),
        'pool_w': nrm(11, (DEPTH, len(POOL_WINDOWS), POOL_GROUP, POOL_GROUP), POOL_GROUP ** -0.5),
        'pool_scale': gain(12, (DEPTH, POOL_WIDTH)),
        'mla_q_norm': gain(13, (DEPTH, Q_LORA)),
        'mla_w_uq': nrm(14, (DEPTH, Q_LORA, MLA_HEADS * (QK_NOPE + QK_ROPE)), Q_LORA ** -0.5),
        'mla_kv_norm': gain(15, (DEPTH, KV_LORA)),
        'mla_w_ukv': nrm(16, (DEPTH, KV_LORA, MLA_HEADS * (QK_NOPE + V_HEAD)), KV_LORA ** -0.5),
        'w_branch_a': nrm(17, (DEPTH, HG_WIDTH, D), HG_WIDTH ** -0.5),
        'w_branch_b': nrm(18, (DEPTH, POOL_WIDTH, D), POOL_WIDTH ** -0.5),
        'w_branch_c': nrm(19, (DEPTH, MLA_WIDTH, D), MLA_WIDTH ** -0.5),
        'w_out': nrm(20, (DEPTH, D, D), D ** -0.5),
        'peer_wq': nrm(21, (DEPTH, D, PEER_HEADS * PEER_DKEY), D ** -0.5),
        'peer_keys': nrm(22, (DEPTH, 2, PEER_HEADS, PEER_NKEYS, PEER_DKEY // 2), (PEER_DKEY // 2) ** -0.5),
        'peer_u': nrm(23, (DEPTH, PEER_N, D), D ** -0.5),
        'peer_v': nrm(24, (DEPTH, PEER_N, D), PEER_HEADS ** -0.5),
        'final_norm': gain(25, (D,)),
    }


def reference(x, c, ctx, c_ctx, w_mod, b_mod, norm_mix, norm_ffn, w_in, hg_lb_logits, hg_norm,
              pool_w, pool_scale, mla_q_norm, mla_w_uq, mla_kv_norm, mla_w_ukv,
              w_branch_a, w_branch_b, w_branch_c, w_out, peer_wq, peer_keys, peer_u, peer_v, final_norm):
    rope = axial_rope_tables(x.shape[1])
    lower_bounds = hgrn_lower_bounds(hg_lb_logits)
    xc = ctx
    for l in range(DEPTH):
        last = l == DEPTH - 1
        mod_l = jnp.split((jax.nn.silu(c) @ w_mod[l] + b_mod[l])[:, None, :], 6, axis=-1)
        mod_c = jnp.split((jax.nn.silu(c_ctx) @ w_mod[l] + b_mod[l])[None, None, :], 6, axis=-1)
        h_l = modulate(x, norm_mix[l], mod_l[0], mod_l[1])
        h_c = modulate(xc, norm_mix[l], mod_c[0], mod_c[1])
        p_l = split_projection(h_l @ w_in[l])
        p_c = split_projection(h_c @ w_in[l])
        hg_l, hg_c = hgrn2_mixer(p_c[0:5], p_l[0:5], lower_bounds[l], hg_norm[l], not last)
        att_l, att_c = mla_mixer(p_c[6:9], p_l[6:9], mla_q_norm[l], mla_w_uq[l], mla_kv_norm[l],
                                 mla_w_ukv[l], rope, not last)
        pool_l = multiscale_pool(p_l[5], pool_w[l], pool_scale[l])
        x = x + mod_l[2] * merge_branches(hg_l, pool_l, att_l, p_l[9],
                                          w_branch_a[l], w_branch_b[l], w_branch_c[l], w_out[l])
        h2_l = modulate(x, norm_ffn[l], mod_l[3], mod_l[4])
        x = x + mod_l[5] * peer_ffn(h2_l, peer_wq[l], peer_keys[l], peer_u[l], peer_v[l])
        if not last:
            pool_c = multiscale_pool(p_c[5], pool_w[l], pool_scale[l])
            xc = xc + mod_c[2] * merge_branches(hg_c, pool_c, att_c, p_c[9],
                                                w_branch_a[l], w_branch_b[l], w_branch_c[l], w_out[l])
            h2_c = modulate(xc, norm_ffn[l], mod_c[3], mod_c[4])
            xc = xc + mod_c[5] * peer_ffn(h2_c, peer_wq[l], peer_keys[l], peer_u[l], peer_v[l])
    return rms_norm(x, final_norm)
```

```cpp
#include <hip/hip_runtime.h>
#include <stdint.h>
#include <cstdio>

#define GAS __attribute__((address_space(1)))
#define LAS __attribute__((address_space(3)))
typedef unsigned short bf16_t;
typedef short bf16x8 __attribute__((ext_vector_type(8)));
typedef short s16x4 __attribute__((ext_vector_type(4)));
typedef float f32x2 __attribute__((ext_vector_type(2)));
typedef float f32x4 __attribute__((ext_vector_type(4)));
typedef float f32x16 __attribute__((ext_vector_type(16)));
typedef unsigned u32x4 __attribute__((ext_vector_type(4)));
typedef unsigned u32x2 __attribute__((ext_vector_type(2)));
typedef int i32x4_t __attribute__((ext_vector_type(4)));
typedef int i32x8_t __attribute__((ext_vector_type(8)));

#ifndef MK_ONE_LAUNCH
#define MK_ONE_LAUNCH 1
#define CTX_SIDE 1
#endif
#ifndef PROBE_DUP
#define PROBE_DUP -1
#endif
#define DUP(k) for (int _d = 0; _d < ((PROBE_DUP == (k)) ? 2 : 1); ++_d)
#ifndef PHASE_MASK
#define PHASE_MASK 0xFFF
#endif
#define PH_ON(k) (((PHASE_MASK) >> (k)) & 1)
#ifndef SUB_MASK
#define SUB_MASK 0xFFFF
#endif
#define SUB_ON(k) (((SUB_MASK) >> (k)) & 1)

constexpr int D = 2048, NB = 4, SEQ = 4096, CTXL = 256;
constexpr int RL = NB * SEQ, RC = NB * CTXL, ROWS = RL + RC;
constexpr int NIN = 13568;
constexpr int NMOD = 6 * D;
constexpr float RMS_EPS = 1e-6f;
constexpr int NCH = 68;
constexpr int NSTREAM = NB * 8 * 2;
constexpr int NPH = 12;
constexpr float U_SCALE = 90.50966799f, V_SCALE = 5.656854249f, U_IDELTA = 135.008f;

constexpr size_t al256(size_t x) { return (x + 255) / 256 * 256; }
constexpr size_t WS_CTL = 0;
constexpr size_t WS_MOD = 65536;
constexpr size_t WS_LB = WS_MOD + al256((size_t)2 * 5 * NMOD * 4);
constexpr size_t WS_RT = WS_LB + al256((size_t)2 * 2 * 2 * 1024 * 4);
constexpr size_t WS_RSTD = WS_RT + 8192;
constexpr size_t WS_DEC = WS_RSTD + al256((size_t)2 * ROWS * 4);
constexpr size_t WS_WIN = WS_DEC + al256((size_t)NSTREAM * NCH * 128 * 4);
constexpr size_t WS_WUQ = WS_WIN + (size_t)NIN * D * 2;
constexpr size_t WS_WUKV = WS_WUQ + (size_t)3072 * 512 * 2;
constexpr size_t WS_WA = WS_WUKV + (size_t)4096 * 512 * 2;
constexpr size_t WS_WB = WS_WA + (size_t)D * 1024 * 2;
constexpr size_t WS_WC = WS_WB + (size_t)D * 1024 * 2;
constexpr size_t WS_WO = WS_WC + (size_t)D * D * 2;
constexpr size_t WS_WQ = WS_WO + (size_t)D * D * 2;
constexpr size_t WS_POOLT = WS_WQ + (size_t)D * D * 2;
constexpr size_t WS_KEYS = WS_POOLT + (size_t)4 * 256 * 256 * 2;
constexpr size_t WS_UT = WS_KEYS + (size_t)2 * 8 * 128 * 128 * 2;
constexpr size_t WS_VT = WS_UT + (size_t)16384 * D / 2;
constexpr size_t WS_H8 = WS_VT + (size_t)16384 * D / 2;
constexpr size_t WS_H = WS_H8 + (size_t)ROWS * D;
constexpr size_t WS_QH = WS_H + (size_t)ROWS * D * 2;
constexpr size_t WS_IH = WS_QH + (size_t)ROWS * 1024 * 2;
constexpr size_t WS_GH = WS_IH + (size_t)ROWS * 1024 * 2;
constexpr size_t WS_PU = WS_GH + (size_t)ROWS * 1024 * 2;
constexpr size_t WS_CQ = WS_PU + (size_t)ROWS * 1024 * 2;
constexpr size_t WS_CKV = WS_CQ + (size_t)ROWS * 512 * 2;
constexpr size_t WS_LF = WS_CKV + (size_t)ROWS * 512 * 2;
constexpr size_t WS_GT = WS_LF + (size_t)2 * ROWS * 1024 * 2;
constexpr size_t WS_KR = WS_GT + (size_t)ROWS * 6144 * 2;
constexpr size_t WS_KROPE = WS_KR + (size_t)ROWS * 64 * 4;
constexpr size_t WS_Q = WS_KROPE + (size_t)ROWS * 64 * 2;
constexpr size_t WS_KV = WS_Q + (size_t)ROWS * 3072 * 2;
constexpr size_t WS_ST = WS_KV + (size_t)ROWS * 4096 * 2;
constexpr size_t WS_PYA = WS_ST + (size_t)NSTREAM * NCH * 128 * 128 * 2;
constexpr size_t WS_XC = WS_PYA + (size_t)ROWS * 1024 * 2;
constexpr size_t WS_CB = WS_XC + (size_t)RC * D * 4;
constexpr size_t WS_CQ8 = WS_CB + 65536;
constexpr size_t WS_CKV8 = WS_CQ8 + (size_t)ROWS * 512;
constexpr size_t WS_END = WS_CKV8 + (size_t)ROWS * 512;
constexpr size_t WS_YC = WS_H;
constexpr size_t WS_YB = WS_WIN;
constexpr int NIN8 = 8448, NINF = 5120;
constexpr size_t WS_WIN8 = WS_WIN;
constexpr size_t WS_WINF = WS_WIN + (size_t)NIN8 * D;
static_assert((size_t)NIN8 * D + (size_t)NINF * D * 2 <= (size_t)NIN * D * 2, "WIN region");
constexpr size_t WS_SS = WS_KR;
constexpr size_t WS_M = WS_QH;
constexpr size_t WS_PQ = WS_GH;
constexpr size_t WS_IDX = WS_CQ;
constexpr size_t WS_GATE = WS_CQ + (size_t)ROWS * 128 * 4;
static_assert((size_t)ROWS * 1024 * 2 <= (size_t)NIN * D * 2, "y_b alias");
static_assert(WS_GATE + (size_t)ROWS * 128 * 4 <= WS_LF, "idx/gate alias");

constexpr int LDS_BYTES = 147456;
constexpr int LDS_BARW = LDS_BYTES - 16;

struct Params {
    const float* in[26];
    float* out;
    unsigned char* ws;
    int ph_lo, ph_hi;
};

typedef __bf16 bf16v2_t __attribute__((ext_vector_type(2)));
__device__ __forceinline__ unsigned cvt_pk_bf16(float lo, float hi) { const f32x2 v = {lo, hi}; return __builtin_bit_cast(unsigned, __builtin_convertvector(v, bf16v2_t)); }
__device__ __forceinline__ bf16_t f2bf(float f) { return (bf16_t)(cvt_pk_bf16(f, 0.f) & 0xffffu); }
__device__ __forceinline__ float bf2f(bf16_t b) { return __uint_as_float(((unsigned)b) << 16); }
__device__ __forceinline__ float bflo(unsigned w) { return __uint_as_float(w << 16); }
__device__ __forceinline__ float bfhi(unsigned w) { return __uint_as_float(w & 0xffff0000u); }
__device__ __forceinline__ float swap_add32(float a, float b) {
    auto r = __builtin_amdgcn_permlane32_swap(__float_as_uint(a), __float_as_uint(b), false, false); return __uint_as_float(r[0]) + __uint_as_float(r[1]); }
__device__ __forceinline__ float swap_add16(float a, float b) {
    auto r = __builtin_amdgcn_permlane16_swap(__float_as_uint(a), __float_as_uint(b), false, false); return __uint_as_float(r[0]) + __uint_as_float(r[1]); }
__device__ __forceinline__ float row_sum16(float t) {
    t += __uint_as_float(__builtin_amdgcn_update_dpp(0, __float_as_uint(t), 0x128, 0xf, 0xf, true));
    t += __uint_as_float(__builtin_amdgcn_update_dpp(0, __float_as_uint(t), 0x124, 0xf, 0xf, true));
    t += __uint_as_float(__builtin_amdgcn_update_dpp(0, __float_as_uint(t), 0x122, 0xf, 0xf, true));
    t += __uint_as_float(__builtin_amdgcn_update_dpp(0, __float_as_uint(t), 0x121, 0xf, 0xf, true));
    return t;
}
__device__ __forceinline__ float wave_sum(float v) { const float t = swap_add32(v, v); return row_sum16(swap_add16(t, t)); }
__device__ __forceinline__ float wave_max(float v) {
    auto r = __builtin_amdgcn_permlane32_swap(__float_as_uint(v), __float_as_uint(v), false, false); float t = fmaxf(__uint_as_float(r[0]), __uint_as_float(r[1]));
    auto r2 = __builtin_amdgcn_permlane16_swap(__float_as_uint(t), __float_as_uint(t), false, false); t = fmaxf(__uint_as_float(r2[0]), __uint_as_float(r2[1]));
    t = fmaxf(t, __uint_as_float(__builtin_amdgcn_update_dpp(0, __float_as_uint(t), 0x128, 0xf, 0xf, true)));
    t = fmaxf(t, __uint_as_float(__builtin_amdgcn_update_dpp(0, __float_as_uint(t), 0x124, 0xf, 0xf, true)));
    t = fmaxf(t, __uint_as_float(__builtin_amdgcn_update_dpp(0, __float_as_uint(t), 0x122, 0xf, 0xf, true)));
    t = fmaxf(t, __uint_as_float(__builtin_amdgcn_update_dpp(0, __float_as_uint(t), 0x121, 0xf, 0xf, true)));
    return t;
}
__device__ __forceinline__ float silu_f(float x) { return x * __builtin_amdgcn_rcpf(1.f + __expf(-x)); }
__device__ __forceinline__ float sigmoid_f(float x) { return __builtin_amdgcn_rcpf(1.f + __expf(-x)); }
__device__ __forceinline__ u32x4 pack8(const f32x4 a, const f32x4 b) {
    u32x4 w; w.x = cvt_pk_bf16(a[0], a[1]); w.y = cvt_pk_bf16(a[2], a[3]); w.z = cvt_pk_bf16(b[0], b[1]); w.w = cvt_pk_bf16(b[2], b[3]); return w;
}
__device__ __forceinline__ int ltid() { int t = threadIdx.x; asm volatile("" : "+v"(t)); return t; }
__device__ __forceinline__ int lbid() { int b = blockIdx.x; asm volatile("" : "+s"(b)); return b; }
__device__ __forceinline__ unsigned char* lws(unsigned char* w) { asm volatile("" : "+s"(w)); return w; }
#ifdef DIAG_SCAN
#define DFLAG(cond, k) do { if (cond) atomicMax((unsigned*)(p.ws + WS_CTL) + 8192, 1000u - (unsigned)(k)); } while (0)
#define NONFIN(x) (!(fabsf(x) < 3e38f))
#else
#define DFLAG(cond, k) do {} while (0)
#define NONFIN(x) false
#endif
__device__ __forceinline__ int crow(int r, int hi) { return (r & 3) + 8 * (r >> 2) + 4 * hi; }

#define XB_TMO      128
#define XB_XCNT(j)  (256  + 64 * (j))
#define XB_XSUB(j)  (1280 + 64 * (j))
#define XB_XGEN(j)  (2304 + 64 * (j))
#define XB_TOP      3328
#define XB_TOPGEN   3392
#define XCD_BAR_WORDS 3456
#define XB_SPIN_CAP (1u << 22)

__device__ __forceinline__ unsigned xb_ld(unsigned* p)              { return __hip_atomic_load(p, __ATOMIC_RELAXED, __HIP_MEMORY_SCOPE_AGENT); }
__device__ __forceinline__ unsigned xb_add(unsigned* p, unsigned v) { return __hip_atomic_fetch_add(p, v, __ATOMIC_RELAXED, __HIP_MEMORY_SCOPE_AGENT); }
__device__ __forceinline__ unsigned xb_xcc_id() { return (unsigned)__builtin_amdgcn_s_getreg((3 << 11) | 20) & 0xFu; }
#define XB_SPIN(cond, bar) do { unsigned _sp = 0; while (cond) { __builtin_amdgcn_s_sleep(1); \
    if ((++_sp & 255u) == 0u) { if (xb_ld(&(bar)[XB_TMO])) break; if (_sp > XB_SPIN_CAP) { atomicAdd(&(bar)[XB_TMO], 1u); break; } } } } while (0)

struct XcdBarrier { unsigned* bar; unsigned x; volatile LAS unsigned* st; };

__device__ __forceinline__ XcdBarrier xcd_barrier_post(unsigned* bar, volatile LAS unsigned* st) {
    XcdBarrier b; b.bar = bar; b.x = xb_xcc_id(); b.st = st;
    if (threadIdx.x == 0) (void)xb_add(&bar[XB_XCNT(b.x)], 1u);
    return b;
}
__device__ __forceinline__ void xcd_barrier_complete(unsigned* bar, unsigned x, unsigned& nloc, unsigned& nx) {
    const unsigned G = gridDim.x * gridDim.y * gridDim.z;
    unsigned sum, cnt, mine, sp = 0u;
    for (;;) {
        sum = 0u; cnt = 0u; mine = 0u;
#pragma unroll
        for (unsigned j = 0; j < 16; ++j) { const unsigned c = xb_ld(&bar[XB_XCNT(j)]); sum += c; cnt += (c > 0u) ? 1u : 0u; mine = (j == x) ? c : mine; }
        if (sum == G) break;
        __builtin_amdgcn_s_sleep(1);
        if ((++sp & 255u) == 0u) { if (xb_ld(&bar[XB_TMO])) break; if (sp > XB_SPIN_CAP) { atomicAdd(&bar[XB_TMO], 1u); break; } }
    }
    nloc = mine > 0u ? mine : 1u; nx = cnt > 0u ? cnt : 1u;
}
__device__ __forceinline__ void xcd_barrier(const XcdBarrier& b) {
    asm volatile("s_waitcnt vmcnt(0)" ::: "memory");
    __syncthreads();
    if (threadIdx.x == 0) {
        unsigned* bar = b.bar;
        __builtin_amdgcn_s_waitcnt(0);
        unsigned nloc = b.st[0], nx = b.st[1];
        if (nloc == 0u) { xcd_barrier_complete(bar, b.x, nloc, nx); b.st[0] = nloc; b.st[1] = nx; }
        const unsigned old = xb_add(&bar[XB_XSUB(b.x)], 1u);
        const unsigned gen = old / nloc;
        if (old + 1u == (gen + 1u) * nloc) {
            __builtin_amdgcn_fence(__ATOMIC_RELEASE, "agent");
            asm volatile("s_waitcnt vmcnt(0)" ::: "memory");
            const unsigned og = xb_add(&bar[XB_TOP], 1u);
            const unsigned tg = og / nx;
            if (og + 1u == (tg + 1u) * nx) xb_add(&bar[XB_TOPGEN], 1u);
            else XB_SPIN(xb_ld(&bar[XB_TOPGEN]) == tg, bar);
            __builtin_amdgcn_fence(__ATOMIC_ACQUIRE, "agent");
            xb_add(&bar[XB_XGEN(b.x)], 1u);
            asm volatile("s_waitcnt vmcnt(0)" ::: "memory");
        } else {
            XB_SPIN(xb_ld(&bar[XB_XGEN(b.x)]) == gen, bar);
            __builtin_amdgcn_fence(__ATOMIC_ACQUIRE, "agent");
            asm volatile("s_waitcnt vmcnt(0)" ::: "memory");
        }
    }
    __syncthreads();
}

constexpr int NSUBC = 32;
#define XB_SUBCTR 4096
__device__ __forceinline__ void sub_barrier(unsigned* bar, unsigned target) {
    asm volatile("s_waitcnt vmcnt(0)" ::: "memory");
    __syncthreads();
    if (threadIdx.x == 0) {
        __builtin_amdgcn_fence(__ATOMIC_RELEASE, "agent");
        asm volatile("s_waitcnt vmcnt(0)" ::: "memory");
        (void)xb_add(&bar[XB_SUBCTR], 1u);
        XB_SPIN(xb_ld(&bar[XB_SUBCTR]) < target, bar);
        __builtin_amdgcn_fence(__ATOMIC_ACQUIRE, "agent");
        asm volatile("s_waitcnt vmcnt(0)" ::: "memory");
    }
    __syncthreads();
}

namespace pg8 {
constexpr int BM = 256, BK = 64, HALF = 128, HTB = HALF * BK * 2, STAGE_BYTES = 8 * HTB, NXCD = 8, WGM = 8;
__device__ __forceinline__ int lds_byte(int r, int c) { const int st = (r >> 4) * 2 + (c >> 5), rr = r & 15, cc = c & 31, ob = rr * 64 + cc * 2; return st * 1024 + (ob ^ (((ob >> 9) & 1) << 5)); }
__device__ __forceinline__ void stage_rc(int b, int& R, int& C) { const int st = b / 1024, sb = b % 1024, swz = sb ^ (((sb >> 9) & 1) << 5); R = (st >> 1) * 16 + swz / 64; C = (st & 1) * 32 + (swz % 64) / 2; }
__device__ __forceinline__ int perm32(int rho) { const int n = rho >> 4, i = rho & 15; return 8 * (i >> 2) + 4 * n + (i & 3); }

struct Unit { int pm, pn; };
struct Gemm { const void* A; const void* Bt; int M, N, Kb, ldab, ldbb, acolb; };

struct StaticOrder {
    int nM, nN, nwg, G, c, full, off, span, pm0, xn, xdiv, xbase, xalt;
    __device__ void init(int M, int N, int G_, int c_) { nM = M / BM; nN = N / BM; nwg = nM * nN; G = G_; c = c_; full = 1 << 20; off = 0; span = G_; pm0 = 0; xn = 0; xdiv = 1; xbase = 0; xalt = 0; }
    __device__ void set_extra(int xn_, int xdiv_, int xbase_, int xalt_) { xn = xn_; xdiv = xdiv_; xbase = xbase_; xalt = xalt_; }
    __device__ void set_tail(int full_, int off_, int span_) { full = full_; off = off_; span = span_; }
    __device__ bool next(int i, Unit& u) const {
        long L;
        if (i < full) L = (long)i * G + c;
        else { const int cc = c - off; if (cc < 0 || cc >= span) return false; L = (long)full * G + (long)(i - full) * span + cc; }
        if (L >= nwg) { const int e = (int)L - nwg; if (e >= xn) return false; const int t = e % xdiv; u.pm = pm0 + nM + e / xdiv; u.pn = (xalt && t == xdiv - 1) ? xalt : xbase + t; return true; }
        int wgid = (int)L; { const int q = nwg / NXCD, r = nwg % NXCD, xcd = wgid % NXCD, off = wgid / NXCD; wgid = (xcd < r ? xcd * (q + 1) : r * (q + 1) + (xcd - r) * q) + off; }
        const int nig = WGM * nN, gid = wgid / nig, fm = gid * WGM, gsz = (nM - fm) < WGM ? (nM - fm) : WGM;
        u.pm = pm0 + fm + ((wgid % nig) % gsz); u.pn = (wgid % nig) / gsz; return true;
    }
};

template <bool FP8, class Epi>
__device__ __forceinline__ void gemm_phase(LAS unsigned char* lds, const Gemm g, const StaticOrder& S, const Epi& E) {
    const int tid = ltid(), wid = __builtin_amdgcn_readfirstlane(tid >> 6), lane = tid & 63, wr = wid >> 2, wc = wid & 3, fr = lane & 15, fq = lane >> 4;
    int Kl = g.Kb; asm volatile("" : "+s"(Kl));
    const int nt = Kl / (BK * 2);
    unsigned v_offA, v_offB;
    { int R, C; stage_rc(tid * 16, R, C); const int Rb = (R & ~31) + perm32(R & 31);
      v_offA = (unsigned)(R * g.ldab + C * 2); v_offB = (unsigned)(Rb * g.ldbb + C * 2); }
    const size_t pstep_offA = (size_t)64 * g.ldab, pstep_offB = (size_t)64 * g.ldbb;
    const size_t kstep = (size_t)(BK * 2);
    const size_t hstepA = (size_t)HALF * g.ldab, hstepB = (size_t)HALF * g.ldbb;
    const size_t tstepA = 2 * hstepA, tstepB = 2 * hstepB;
    const unsigned ldsw = (unsigned)wid * 1024u;
    const int aoff = lds_byte(wr * 64 + fr, fq * 8), boff = lds_byte(wc * 32 + fr, fq * 8);
#define PG8_SA(b, h) (((b) * 2 + (h)) * HTB)
#define PG8_SB(b, h) ((4 + (b) * 2 + (h)) * HTB)
#define PG8_STAGE(bufoff, gbase, voff) do { _Pragma("unroll") for (int _i = 0; _i < 2; ++_i) \
        __builtin_amdgcn_global_load_lds((const unsigned*)((const char*)(gbase) + _i * pstep_##voff + v_##voff), (LAS unsigned*)(lds + (bufoff) + ldsw + _i * 8192), 16, 0, 0); } while (0)
#define PG8_RD(off) (*(const LAS i32x4_t*)(lds + (off)))
#define PG8_LDA(dst, b, h) do { _Pragma("unroll") for (int m = 0; m < 4; ++m) dst[m] = __builtin_shufflevector(PG8_RD(PG8_SA(b, h) + aoff + m * 2048), PG8_RD(PG8_SA(b, h) + aoff + m * 2048 + 1024), 0, 1, 2, 3, 4, 5, 6, 7); } while (0)
#define PG8_LDB(dst, b, h) do { _Pragma("unroll") for (int n = 0; n < 2; ++n) dst[n] = __builtin_shufflevector(PG8_RD(PG8_SB(b, h) + boff + n * 2048), PG8_RD(PG8_SB(b, h) + boff + n * 2048 + 1024), 0, 1, 2, 3, 4, 5, 6, 7); } while (0)
#define PG8_LO(X) __builtin_bit_cast(bf16x8, __builtin_shufflevector(X, X, 0, 1, 2, 3))
#define PG8_HI(X) __builtin_bit_cast(bf16x8, __builtin_shufflevector(X, X, 4, 5, 6, 7))
#define PG8_MMA(ai, bj, At, Bt) do { __builtin_amdgcn_s_setprio(1); _Pragma("unroll") for (int m = 0; m < 4; ++m) _Pragma("unroll") for (int n = 0; n < 2; ++n) { \
        if constexpr (FP8) asm volatile("v_mfma_scale_f32_16x16x128_f8f6f4 %0, %1, %2, %0, %3, %3 op_sel_hi:[0,0,0]" : "+v"(acc[ai][bj][m][n]) : "v"(Bt[n]), "v"(At[m]), "v"(scl)); \
        else { acc[ai][bj][m][n] = __builtin_amdgcn_mfma_f32_16x16x32_bf16(PG8_LO(Bt[n]), PG8_LO(At[m]), acc[ai][bj][m][n], 0, 0, 0); \
               acc[ai][bj][m][n] = __builtin_amdgcn_mfma_f32_16x16x32_bf16(PG8_HI(Bt[n]), PG8_HI(At[m]), acc[ai][bj][m][n], 0, 0, 0); } } \
        __builtin_amdgcn_s_setprio(0); } while (0)
#define PG8_WAIT_V(n) asm volatile("s_waitcnt vmcnt(" #n ")" ::: "memory")
#define PG8_WAIT_L(n) asm volatile("s_waitcnt lgkmcnt(" #n ")" ::: "memory")
#define PG8_BAR __builtin_amdgcn_s_barrier()
#define PG8_SCHED __builtin_amdgcn_sched_barrier(0)
    Unit cur, nxt; int ui = 0;
    if (!S.next(0, cur)) return;
    f32x4 acc[2][2][4][2];
#pragma unroll
    for (int a = 0; a < 2; ++a)
#pragma unroll
        for (int b = 0; b < 2; ++b)
#pragma unroll
            for (int m = 0; m < 4; ++m)
#pragma unroll
                for (int n = 0; n < 2; ++n) acc[a][b][m][n] = (f32x4){0.f, 0.f, 0.f, 0.f};
    i32x8_t At[4], B0[2], B1[2];
    int scl = 0x7F7F7F7F; asm volatile("" : "+v"(scl));
    const char* cA = (const char*)g.A + (size_t)cur.pm * tstepA + (size_t)cur.pn * g.acolb; const char* cB = (const char*)g.Bt + (size_t)cur.pn * tstepB;
    PG8_STAGE(PG8_SB(0, 0), cB, offB); PG8_STAGE(PG8_SA(0, 0), cA, offA); PG8_STAGE(PG8_SB(0, 1), cB + hstepB, offB); PG8_STAGE(PG8_SA(0, 1), cA + hstepA, offA);
    if (wr == 1) PG8_BAR;
    PG8_WAIT_V(4); PG8_BAR;
    PG8_STAGE(PG8_SB(1, 0), cB + kstep, offB); PG8_STAGE(PG8_SA(1, 0), cA + kstep, offA); PG8_STAGE(PG8_SB(1, 1), cB + hstepB + kstep, offB);
    PG8_WAIT_V(6); PG8_BAR;
    for (;;) {
        const bool has_next = S.next(ui + 1, nxt);
        const char* nA = has_next ? (const char*)g.A + (size_t)nxt.pm * tstepA + (size_t)nxt.pn * g.acolb : cA; const char* nB = has_next ? (const char*)g.Bt + (size_t)nxt.pn * tstepB : cB;
        for (int t = 0; t < nt; t += 2) {
            const bool last = (t == nt - 2);
            const char* a1 = cA + (size_t)(t + 1) * kstep;
            const char* a2 = last ? nA : cA + (size_t)(t + 2) * kstep; const char* b2 = last ? nB : cB + (size_t)(t + 2) * kstep;
            const char* a3 = a2 + kstep; const char* b3 = b2 + kstep;
            PG8_LDB(B0, 0, 0); PG8_SCHED; PG8_LDA(At, 0, 0); PG8_STAGE(PG8_SA(1, 1), a1 + hstepA, offA);
            PG8_WAIT_L(8); PG8_BAR; PG8_WAIT_L(0); PG8_MMA(0, 0, At, B0); PG8_BAR; PG8_SCHED;
            PG8_LDB(B1, 0, 1); PG8_STAGE(PG8_SB(0, 0), b2, offB);
            PG8_BAR; PG8_WAIT_L(0); PG8_MMA(0, 1, At, B1); PG8_BAR;
            PG8_LDA(At, 0, 1); PG8_STAGE(PG8_SA(0, 0), a2, offA);
            PG8_BAR; PG8_WAIT_L(0); PG8_MMA(1, 0, At, B0); PG8_BAR; PG8_SCHED;
            PG8_STAGE(PG8_SB(0, 1), b2 + hstepB, offB);
            PG8_WAIT_V(6); PG8_BAR; PG8_MMA(1, 1, At, B1); PG8_BAR;
            PG8_LDB(B0, 1, 0); PG8_SCHED; PG8_LDA(At, 1, 0); PG8_STAGE(PG8_SA(0, 1), a2 + hstepA, offA);
            PG8_WAIT_L(8); PG8_BAR; PG8_WAIT_L(0); PG8_MMA(0, 0, At, B0); PG8_BAR; PG8_SCHED;
            PG8_LDB(B1, 1, 1); PG8_STAGE(PG8_SB(1, 0), b3, offB);
            PG8_BAR; PG8_WAIT_L(0); PG8_MMA(0, 1, At, B1); PG8_BAR;
            PG8_LDA(At, 1, 1); PG8_STAGE(PG8_SA(1, 0), a3, offA);
            PG8_BAR; PG8_WAIT_L(0); PG8_MMA(1, 0, At, B0); PG8_BAR; PG8_SCHED;
            PG8_STAGE(PG8_SB(1, 1), b3 + hstepB, offB);
            PG8_WAIT_V(6); PG8_BAR; PG8_MMA(1, 1, At, B1); PG8_BAR;
        }
        if constexpr (FP8) asm volatile("s_nop 15\n\ts_nop 15" ::: "memory");
        { int fr_ = fr, fq_ = fq; asm volatile("" : "+v"(fr_), "+v"(fq_));
          E(acc, cur, wr, wc, fr_, fq_); }
        if (!has_next) break;
#pragma unroll
        for (int a = 0; a < 2; ++a)
#pragma unroll
            for (int b = 0; b < 2; ++b)
#pragma unroll
                for (int m = 0; m < 4; ++m)
#pragma unroll
                    for (int n = 0; n < 2; ++n) acc[a][b][m][n] = (f32x4){0.f, 0.f, 0.f, 0.f};
        cur = nxt; cA = nA; cB = nB; ++ui;
    }
    PG8_WAIT_V(0);
    if (wr == 0) PG8_BAR;
    PG8_BAR;
#undef PG8_SA
#undef PG8_SB
#undef PG8_STAGE
#undef PG8_LDA
#undef PG8_LDB
#undef PG8_MMA
#undef PG8_LO
#undef PG8_HI
#undef PG8_RD
#undef PG8_WAIT_V
#undef PG8_WAIT_L
#undef PG8_BAR
#undef PG8_SCHED
}
}

typedef const f32x4 (&AccRef)[2][2][4][2];

struct EpiLF {
    unsigned char* ws; const float* lbp;
    __device__ __forceinline__ void operator()(AccRef acc, const pg8::Unit& u, int wr, int wc, int fr, int fq) const {
        const int pn = u.pn, row0 = u.pm * 256 + wr * 64 + fr, lc0 = wc * 32 + 8 * fq;
        if (pn >= 4 && pn < 12) {
            const int dir = (pn - 4) >> 2, cb = ((pn - 4) & 3) * 256;
            bf16_t* dst = (bf16_t*)(ws + WS_LF) + (size_t)dir * ROWS * 1024;
#pragma unroll
            for (int bj = 0; bj < 2; ++bj) {
                const int c = cb + bj * 128 + lc0;
                float la[8], lb1[8];
#pragma unroll
                for (int e = 0; e < 8; ++e) { la[e] = lbp[dir * 1024 + c + e]; lb1[e] = lbp[2048 + dir * 1024 + c + e]; }
#pragma unroll
                for (int ai = 0; ai < 2; ++ai)
#pragma unroll
                    for (int m = 0; m < 4; ++m) {
                        const int row = row0 + ai * 128 + m * 16;
                        float o[8];
#pragma unroll
                        for (int e = 0; e < 8; ++e) {
                            const float x = acc[ai][bj][m][e >> 2][e & 3];
                            const float ls = fminf(x, 0.f) - __logf(1.f + __expf(-fabsf(x)));
                            const float a = la[e], b = lb1[e] + ls;
                            const float mx = fmaxf(a, b);
                            o[e] = mx + __logf(1.f + __expf(-fabsf(a - b)));
                        }
                        u32x4 w; w.x = cvt_pk_bf16(o[0], o[1]); w.y = cvt_pk_bf16(o[2], o[3]); w.z = cvt_pk_bf16(o[4], o[5]); w.w = cvt_pk_bf16(o[6], o[7]);
                        *(u32x4*)(dst + (size_t)row * 1024 + c) = w;
                    }
            }
            return;
        }
        bf16_t* dst; int cb, act;
        if (pn < 4) { dst = (bf16_t*)(ws + WS_QH); cb = pn * 256; act = 1; }
        else if (pn < 16) { dst = (bf16_t*)(ws + WS_IH); cb = (pn - 12) * 256; act = 0; }
        else { dst = (bf16_t*)(ws + WS_GH); cb = (pn - 16) * 256; act = 1; }
#pragma unroll
        for (int ai = 0; ai < 2; ++ai)
#pragma unroll
            for (int m = 0; m < 4; ++m) {
                const int row = row0 + ai * 128 + m * 16;
#pragma unroll
                for (int bj = 0; bj < 2; ++bj) {
                    f32x4 v0 = acc[ai][bj][m][0], v1 = acc[ai][bj][m][1];
                    if (act == 1) {
#pragma unroll
                        for (int e = 0; e < 4; ++e) { v0[e] = silu_f(v0[e]); v1[e] = silu_f(v1[e]); }
                    }
                    *(u32x4*)(dst + (size_t)row * 1024 + cb + bj * 128 + lc0) = pack8(v0, v1);
                }
            }
    }
};
__device__ __forceinline__ unsigned pack4_fp8(float a, float b, float c, float d);
struct EpiWin8 {
    unsigned char* ws;
    __device__ __forceinline__ void operator()(AccRef acc, const pg8::Unit& u, int wr, int wc, int fr, int fq) const {
        const int pn = u.pn, row0 = u.pm * 256 + wr * 64 + fr, lc0 = wc * 32 + 8 * fq;
        constexpr float WS_ = 1.f / 32.f;
        if (pn == 32) {
            if (wc < 2) {
                float* dst = (float*)(ws + WS_KR);
#pragma unroll
                for (int ai = 0; ai < 2; ++ai)
#pragma unroll
                    for (int m = 0; m < 4; ++m) {
                        const int row = row0 + ai * 128 + m * 16;
                        *(f32x4*)(dst + (size_t)row * 64 + lc0) = acc[ai][0][m][0] * WS_;
                        *(f32x4*)(dst + (size_t)row * 64 + lc0 + 4) = acc[ai][0][m][1] * WS_;
                    }
            }
            return;
        }
        bf16_t* dst; int ld, cb, act;
        if (pn < 4) { dst = (bf16_t*)(ws + WS_PU); ld = 1024; cb = pn * 256; act = 0; }
        else if (pn < 6) { dst = (bf16_t*)(ws + WS_CQ); ld = 512; cb = (pn - 4) * 256; act = 0; }
        else if (pn < 8) { dst = (bf16_t*)(ws + WS_CKV); ld = 512; cb = (pn - 6) * 256; act = 0; }
        else { dst = (bf16_t*)(ws + WS_GT); ld = 6144; cb = (pn - 8) * 256; act = 2; }
#pragma unroll
        for (int ai = 0; ai < 2; ++ai)
#pragma unroll
            for (int m = 0; m < 4; ++m) {
                const int row = row0 + ai * 128 + m * 16;
#pragma unroll
                for (int bj = 0; bj < 2; ++bj) {
                    f32x4 v0 = acc[ai][bj][m][0] * WS_, v1 = acc[ai][bj][m][1] * WS_;
                    if (act == 1) {
#pragma unroll
                        for (int e = 0; e < 4; ++e) { v0[e] = silu_f(v0[e]); v1[e] = silu_f(v1[e]); }
                    } else if (act == 2) {
#pragma unroll
                        for (int e = 0; e < 4; ++e) { v0[e] = sigmoid_f(v0[e]); v1[e] = sigmoid_f(v1[e]); }
                    }
                    *(u32x4*)(dst + (size_t)row * ld + cb + bj * 128 + lc0) = pack8(v0, v1);
                    if (pn >= 4 && pn < 8)
                        *(u32x2*)(ws + (pn < 6 ? WS_CQ8 : WS_CKV8) + (size_t)row * 512 + cb + bj * 128 + lc0) = (u32x2){pack4_fp8(v0[0], v0[1], v0[2], v0[3]), pack4_fp8(v1[0], v1[1], v1[2], v1[3])};
                }
            }
    }
};
template <int MODE> struct EpiScale {
    bf16_t* O; int ld; const float* scale; float mul = 1.f;
    __device__ __forceinline__ void operator()(AccRef acc, const pg8::Unit& u, int wr, int wc, int fr, int fq) const {
        const int row0 = u.pm * 256 + wr * 64 + fr, col0 = u.pn * 256 + wc * 32 + 8 * fq;
        float rsv[2][4]; f32x4 csv[2][2];
#pragma unroll
        for (int ai = 0; ai < 2; ++ai)
#pragma unroll
            for (int m = 0; m < 4; ++m) rsv[ai][m] = (MODE == 1) ? scale[row0 + ai * 128 + m * 16] * mul : 1.f;
#pragma unroll
        for (int bj = 0; bj < 2; ++bj)
#pragma unroll
            for (int n = 0; n < 2; ++n) csv[bj][n] = (MODE == 2) ? *(const f32x4*)(scale + col0 + bj * 128 + 4 * n) : (f32x4){1.f, 1.f, 1.f, 1.f};
#pragma unroll
        for (int ai = 0; ai < 2; ++ai)
#pragma unroll
            for (int m = 0; m < 4; ++m) {
                const int row = row0 + ai * 128 + m * 16;
                const float rs = rsv[ai][m];
#pragma unroll
                for (int bj = 0; bj < 2; ++bj) {
                    f32x4 v0 = acc[ai][bj][m][0], v1 = acc[ai][bj][m][1];
                    if (MODE == 1) { v0 *= rs; v1 *= rs; }
                    if (MODE == 2) { v0 *= csv[bj][0]; v1 *= csv[bj][1]; }
                    if (MODE == 2) { v0 *= 4.f; v1 *= 4.f;
                        *(u32x2*)((unsigned char*)O + (size_t)row * (2 * ld) + col0 + bj * 128) = (u32x2){pack4_fp8(v0[0], v0[1], v0[2], v0[3]), pack4_fp8(v1[0], v1[1], v1[2], v1[3])}; }
                    else *(u32x4*)(O + (size_t)row * ld + col0 + bj * 128) = pack8(v0, v1);
                }
            }
    }
};
template <int MODE> struct EpiMerge {
    bf16_t* Mb; const bf16_t* GT; int gofs; float mul = 1.f;
    __device__ __forceinline__ void operator()(AccRef acc, const pg8::Unit& u, int wr, int wc, int fr, int fq) const {
        const int row0 = u.pm * 256 + wr * 64 + fr, col0 = u.pn * 256 + wc * 32 + 8 * fq;
#pragma unroll
        for (int ai = 0; ai < 2; ++ai) {
            u32x4 g[4][2], o[4][2];
#pragma unroll
            for (int m = 0; m < 4; ++m)
#pragma unroll
                for (int bj = 0; bj < 2; ++bj) {
                    const size_t row = (size_t)(row0 + ai * 128 + m * 16); const int col = col0 + bj * 128;
                    g[m][bj] = *(const u32x4*)(GT + row * 6144 + gofs + col);
                    if (MODE) o[m][bj] = *(const u32x4*)(Mb + row * D + col);
                }
#pragma unroll
            for (int m = 0; m < 4; ++m)
#pragma unroll
                for (int bj = 0; bj < 2; ++bj) {
                    const size_t row = (size_t)(row0 + ai * 128 + m * 16); const int col = col0 + bj * 128;
                    const u32x4 gg = g[m][bj];
                    f32x4 v0 = acc[ai][bj][m][0] * mul, v1 = acc[ai][bj][m][1] * mul;
                    v0[0] *= bflo(gg.x); v0[1] *= bfhi(gg.x); v0[2] *= bflo(gg.y); v0[3] *= bfhi(gg.y);
                    v1[0] *= bflo(gg.z); v1[1] *= bfhi(gg.z); v1[2] *= bflo(gg.w); v1[3] *= bfhi(gg.w);
                    if (MODE) { const u32x4 oo = o[m][bj];
                        v0[0] += bflo(oo.x); v0[1] += bfhi(oo.x); v0[2] += bflo(oo.y); v0[3] += bfhi(oo.y);
                        v1[0] += bflo(oo.z); v1[1] += bfhi(oo.z); v1[2] += bflo(oo.w); v1[3] += bfhi(oo.w); }
                    *(u32x4*)(Mb + row * D + col) = pack8(v0, v1);
                }
        }
    }
};
struct EpiResid {
    const float* xin_l; const float* xin_c; float* xout_l; float* xout_c; const float* modl; const float* gain2; bf16_t* XA; float* SS;
    __device__ __forceinline__ void operator()(AccRef acc, const pg8::Unit& u, int wr, int wc, int fr, int fq) const {
        const int col0 = u.pn * 256 + wc * 32 + 8 * fq;
        const bool isc = u.pm >= 64;
        const int mrow = isc ? 4 : (u.pm >> 4);
        const float* xin = isc ? xin_c : xin_l; float* xout = isc ? xout_c : xout_l;
        const int rbase = (isc ? (u.pm - 64) * 256 : u.pm * 256) + wr * 64 + fr;
        const int grow0 = u.pm * 256 + wr * 64 + fr;
        const float* gp = modl + (size_t)mrow * NMOD + 2 * D;
        const float* scp = modl + (size_t)mrow * NMOD + 4 * D;
        f32x4 gs[2][2], av[2][2];
#pragma unroll
        for (int bj = 0; bj < 2; ++bj)
#pragma unroll
            for (int n = 0; n < 2; ++n) {
                gs[bj][n] = *(const f32x4*)(gp + col0 + bj * 128 + 4 * n);
                const f32x4 g2 = *(const f32x4*)(gain2 + col0 + bj * 128 + 4 * n), sc = *(const f32x4*)(scp + col0 + bj * 128 + 4 * n);
                av[bj][n] = g2 * (sc + 1.f);
            }
#pragma unroll
        for (int am = 0; am < 4; ++am) {
            const int ai = am >> 1, m0 = (am & 1) * 2;
            f32x4 xi[2][2][2];
#pragma unroll
            for (int m = 0; m < 2; ++m)
#pragma unroll
                for (int bj = 0; bj < 2; ++bj)
#pragma unroll
                    for (int n = 0; n < 2; ++n) xi[m][bj][n] = *(const f32x4*)(xin + (size_t)(rbase + ai * 128 + (m0 + m) * 16) * D + col0 + bj * 128 + 4 * n);
            float ssr[2];
#pragma unroll
            for (int m = 0; m < 2; ++m) {
                float ss = 0.f;
#pragma unroll
                for (int bj = 0; bj < 2; ++bj) {
                    const f32x4 o0 = xi[m][bj][0] + gs[bj][0] * acc[ai][bj][m0 + m][0], o1 = xi[m][bj][1] + gs[bj][1] * acc[ai][bj][m0 + m][1];
                    *(f32x4*)(xout + (size_t)(rbase + ai * 128 + (m0 + m) * 16) * D + col0 + bj * 128) = o0;
                    *(f32x4*)(xout + (size_t)(rbase + ai * 128 + (m0 + m) * 16) * D + col0 + bj * 128 + 4) = o1;
#pragma unroll
                    for (int e = 0; e < 4; ++e) ss += o0[e] * o0[e] + o1[e] * o1[e];
                    *(u32x4*)(XA + (size_t)(grow0 + ai * 128 + (m0 + m) * 16) * D + col0 + bj * 128) = pack8(o0 * av[bj][0], o1 * av[bj][1]);
                }
                ssr[m] = ss;
            }
            float t = swap_add32(ssr[0], ssr[1]); t = swap_add16(t, t);
            if ((fq & 1) == 0) SS[(size_t)(grow0 + ai * 128 + (m0 + (fq >> 1)) * 16) * 32 + u.pn * 4 + wc] = t;
        }
    }
};
struct EpiPeerQ {
    bf16_t* O; const float* SS; const float* CB;
    __device__ __forceinline__ void operator()(AccRef acc, const pg8::Unit& u, int wr, int wc, int fr, int fq) const {
        const int row0 = u.pm * 256 + wr * 64 + fr, col0 = u.pn * 256 + wc * 32 + 8 * fq;
        const int mrow = (u.pm >= 64) ? 4 : (u.pm >> 4);
        float rs[2][4]; f32x4 cbv[2][2];
#pragma unroll
        for (int ai = 0; ai < 2; ++ai)
#pragma unroll
            for (int m = 0; m < 4; ++m) {
                const float* sp = SS + (size_t)(row0 + ai * 128 + m * 16) * 32 + fq * 8;
                const f32x4 s0 = *(const f32x4*)sp, s1 = *(const f32x4*)(sp + 4);
                rs[ai][m] = ((s0[0] + s0[1]) + (s0[2] + s0[3])) + ((s1[0] + s1[1]) + (s1[2] + s1[3]));
            }
#pragma unroll
        for (int bj = 0; bj < 2; ++bj)
#pragma unroll
            for (int n = 0; n < 2; ++n) cbv[bj][n] = *(const f32x4*)(CB + (size_t)mrow * D + col0 + bj * 128 + 4 * n);
#pragma unroll
        for (int ai = 0; ai < 2; ++ai)
#pragma unroll
            for (int m = 0; m < 4; ++m) { float t = swap_add32(rs[ai][m], rs[ai][m]); t = swap_add16(t, t); rs[ai][m] = rsqrtf(t * (1.f / D) + RMS_EPS); }
#pragma unroll
        for (int ai = 0; ai < 2; ++ai)
#pragma unroll
            for (int m = 0; m < 4; ++m) {
                const int row = row0 + ai * 128 + m * 16;
                const float r = rs[ai][m];
#pragma unroll
                for (int bj = 0; bj < 2; ++bj)
                    *(u32x4*)(O + (size_t)row * D + col0 + bj * 128) = pack8(acc[ai][bj][m][0] * r + cbv[bj][0], acc[ai][bj][m][1] * r + cbv[bj][1]);
            }
    }
};

struct TJob { const float* src; int ldsrc; void* dst; int K, N; const float* kscale; int winmap; float oscale; };
__device__ __forceinline__ void tjob_load(const TJob& j, int t, int nkt, int tid, f32x4& a, f32x4& b) {
    const int kt = t % nkt, ntl = t / nkt, n0 = ntl * 64, k0 = kt * 64;
    int s0 = n0; bool zero = false;
    if (j.winmap == 1) { if (n0 < 2048) s0 = n0 + 5120; else if (n0 < 8192) s0 = n0 - 2048 + 7232; else if (n0 < 8256) s0 = n0 - 8192 + 7168; else zero = true; }
    if (j.winmap >= 2) s0 = n0;
    const int kk = tid >> 3, cc = (tid & 7) * 8;
    a = (f32x4){0.f, 0.f, 0.f, 0.f}; b = a;
    if (!zero) { const float* sp = j.src + (size_t)(k0 + kk) * j.ldsrc + s0 + cc; a = *(const f32x4*)sp; b = *(const f32x4*)(sp + 4); }
    if (j.kscale) { const float s = j.kscale[k0 + kk]; a *= s; b *= s; }
}
__device__ __forceinline__ void tjob_run(const TJob& j, LAS float* tile  ) {
    const int tid = ltid(), nkt = j.K / 64, nnt = j.N / 64, ntile = nkt * nnt;
    int t = lbid();
    f32x4 a, b, a2, b2;
    if (t < ntile) tjob_load(j, t, nkt, tid, a, b);
    if (t + (int)gridDim.x < ntile) tjob_load(j, t + gridDim.x, nkt, tid, a2, b2);
    for (; t < ntile; t += gridDim.x) {
        const int kt = t % nkt, ntl = t / nkt;
        const int n0 = ntl * 64, k0 = kt * 64;
        __syncthreads();
        {
            const int kk = tid >> 3, cc = (tid & 7) * 8;
#pragma unroll
            for (int e = 0; e < 4; ++e) { tile[kk * 65 + cc + e] = a[e]; tile[kk * 65 + cc + 4 + e] = b[e]; }
        }
        __syncthreads();
        a = a2; b = b2;
        if (t + 2 * (int)gridDim.x < ntile) tjob_load(j, t + 2 * gridDim.x, nkt, tid, a2, b2);
        {
            const int nn = tid >> 3, kc = (tid & 7) * 8;
            float v[8];
#pragma unroll
            for (int e = 0; e < 8; ++e) v[e] = tile[(kc + e) * 65 + nn];
            if (j.winmap == 1 || j.winmap == 3) {
                int t0 = __builtin_amdgcn_cvt_pk_fp8_f32(v[0] * j.oscale, v[1] * j.oscale, 0, false); t0 = __builtin_amdgcn_cvt_pk_fp8_f32(v[2] * j.oscale, v[3] * j.oscale, t0, true);
                int t1 = __builtin_amdgcn_cvt_pk_fp8_f32(v[4] * j.oscale, v[5] * j.oscale, 0, false); t1 = __builtin_amdgcn_cvt_pk_fp8_f32(v[6] * j.oscale, v[7] * j.oscale, t1, true);
                *(u32x2*)((unsigned char*)j.dst + (size_t)(n0 + nn) * j.K + k0 + kc) = (u32x2){(unsigned)t0, (unsigned)t1};
            } else {
                u32x4 w; w.x = cvt_pk_bf16(v[0], v[1]); w.y = cvt_pk_bf16(v[2], v[3]); w.z = cvt_pk_bf16(v[4], v[5]); w.w = cvt_pk_bf16(v[6], v[7]);
                *(u32x4*)((bf16_t*)j.dst + (size_t)(n0 + nn) * j.K + k0 + kc) = w;
            }
        }
    }
    __syncthreads();
}
__device__ __forceinline__ void cvt_plain(const float* src, bf16_t* dst, size_t n8) {
    for (size_t i = (size_t)lbid() * 512 + ltid(); i < n8; i += (size_t)gridDim.x * 512) {
        const f32x4 a = *(const f32x4*)(src + i * 8), b = *(const f32x4*)(src + i * 8 + 4);
        *(u32x4*)(dst + i * 8) = pack8(a, b);
    }
}

__device__ __forceinline__ u32x4 fp4_pack32(const f32x4 (&x)[8], float scale) {
    u32x4 w;
#pragma unroll
    for (int d = 0; d < 4; ++d) {
        const f32x4 a = x[2 * d] * scale, b = x[2 * d + 1] * scale;
        unsigned t = 0u;
        t = __builtin_amdgcn_cvt_scalef32_pk_fp4_f32(t, a[0], a[1], 1.0f, 0);
        t = __builtin_amdgcn_cvt_scalef32_pk_fp4_f32(t, a[2], a[3], 1.0f, 1);
        t = __builtin_amdgcn_cvt_scalef32_pk_fp4_f32(t, b[0], b[1], 1.0f, 2);
        t = __builtin_amdgcn_cvt_scalef32_pk_fp4_f32(t, b[2], b[3], 1.0f, 3);
        w[d] = t;
    }
    return w;
}
__device__ __forceinline__ u32x4 i4_pack32(const f32x4 (&x)[8], float scale) {
    u32x4 w;
#pragma unroll
    for (int d = 0; d < 4; ++d) {
        unsigned t = 0u;
#pragma unroll
        for (int i = 0; i < 8; ++i) {
            const float v = (i < 4) ? x[2 * d][i & 3] : x[2 * d + 1][i & 3];
            const int n = __float2int_rn(__builtin_amdgcn_fmed3f(v * scale - 0.5f, -8.f, 7.f));
            t |= ((unsigned)n & 15u) << (4 * i);
        }
        w[d] = t;
    }
    return w;
}
template <bool I4>
__device__ __forceinline__ void cvt_fp4(const float* src, unsigned char* dst, size_t n32, float scale) {
    const size_t stride = (size_t)gridDim.x * 512;
    for (size_t i = (size_t)lbid() * 512 + ltid(); i < n32; i += 2 * stride) {
        const size_t i2 = i + stride; const bool two = i2 < n32;
        f32x4 x[8], y[8];
#pragma unroll
        for (int q = 0; q < 8; ++q) x[q] = *(const f32x4*)(src + i * 32 + q * 4);
        if (two) {
#pragma unroll
            for (int q = 0; q < 8; ++q) y[q] = *(const f32x4*)(src + i2 * 32 + q * 4);
        }
        *(u32x4*)(dst + i * 16) = I4 ? i4_pack32(x, scale) : fp4_pack32(x, scale);
        if (two) *(u32x4*)(dst + i2 * 16) = I4 ? i4_pack32(y, scale) : fp4_pack32(y, scale);
    }
}
__device__ __forceinline__ void phase_convert(const Params& p, int l, LAS unsigned char* lds) {
    unsigned char* ws = lws(p.ws);
    LAS float* tile = (LAS float*)lds;
    const int tid = ltid();
    if (l == 0) {
        LAS float* sc = (LAS float*)(lds + 32768);
        LAS float* red = (LAS float*)(lds + 32768 + 5 * 2048 * 4);
        for (int i = tid; i < 5 * 2048; i += 512) { const int r = i >> 11, k = i & 2047; const float v = (r < 4) ? p.in[1][r * 2048 + k] : p.in[3][k]; sc[i] = silu_f(v); }
        __syncthreads();
        const int wid = tid >> 6, lane = tid & 63;
        for (int task = lbid(); task < 2 * NMOD / 128; task += gridDim.x) {
            const int ll = task / (NMOD / 128), n0 = (task % (NMOD / 128)) * 128;
            const float* W = p.in[4] + (size_t)ll * D * NMOD + n0 + 2 * lane;
            const int kb = wid * 256;
            f32x2 a0 = {0.f, 0.f}, a1 = a0, a2 = a0, a3 = a0, a4 = a0;
#pragma unroll 16
            for (int k = 0; k < 256; ++k) { const f32x2 w = *(const f32x2*)(W + (size_t)(kb + k) * NMOD);
                a0 += sc[kb + k] * w; a1 += sc[2048 + kb + k] * w; a2 += sc[4096 + kb + k] * w; a3 += sc[6144 + kb + k] * w; a4 += sc[8192 + kb + k] * w; }
            *(LAS f32x2*)(red + (wid * 5 + 0) * 128 + 2 * lane) = a0; *(LAS f32x2*)(red + (wid * 5 + 1) * 128 + 2 * lane) = a1; *(LAS f32x2*)(red + (wid * 5 + 2) * 128 + 2 * lane) = a2;
            *(LAS f32x2*)(red + (wid * 5 + 3) * 128 + 2 * lane) = a3; *(LAS f32x2*)(red + (wid * 5 + 4) * 128 + 2 * lane) = a4;
            __syncthreads();
            for (int i = tid; i < 640; i += 512) { const int r = i >> 7, c = i & 127; float sm = 0.f;
#pragma unroll
                for (int w = 0; w < 8; ++w) sm += red[(w * 5 + r) * 128 + c];
                ((float*)(ws + WS_MOD))[((size_t)ll * 5 + r) * NMOD + n0 + c] = sm + p.in[5][ll * NMOD + n0 + c]; }
            __syncthreads();
        }
        for (int i = lbid() * 512 + tid; i < 2048; i += gridDim.x * 512) {
            float* LB = (float*)(ws + WS_LB);
            const float x0 = p.in[9][i], x1 = p.in[9][2048 + i];
            const float dlt = x1 - x0;
            const float ls1 = fminf(dlt, 0.f) - log1pf(expf(-fabsf(dlt)));
            const float ls0 = fminf(-dlt, 0.f) - log1pf(expf(-fabsf(dlt)));
            LB[i] = -INFINITY; LB[2048 + i] = 0.f;
            LB[4096 + i] = ls1; LB[4096 + 2048 + i] = ls0;
        }
        for (int i = lbid() * 512 + tid; i < 1024; i += gridDim.x * 512) {
            const int pos = i >> 4, jf = i & 15;
            const float fr = powf(10000.f, -(float)jf / 16.f);
            const float ang = (float)pos * fr;
            float* RT = (float*)(ws + WS_RT);
            RT[i * 2] = cosf(ang); RT[i * 2 + 1] = sinf(ang);
        }
    }
    { TJob j{p.in[8] + (size_t)l * D * 13376, 13376, ws + WS_WIN8, D, NIN8, nullptr, 1, 32.f}; tjob_run(j, tile); }
    { TJob j{p.in[8] + (size_t)l * D * 13376, 13376, ws + WS_WINF, D, NINF, nullptr, 2, 1.f}; tjob_run(j, tile); }
    { TJob j{p.in[14] + (size_t)l * 512 * 3072, 3072, ws + WS_WUQ, 512, 3072, p.in[13] + l * 512, 3, 32.f}; tjob_run(j, tile); }
    { TJob j{p.in[16] + (size_t)l * 512 * 4096, 4096, ws + WS_WUKV, 512, 4096, p.in[15] + l * 512, 3, 32.f}; tjob_run(j, tile); }
    { TJob j{p.in[17] + (size_t)l * 1024 * D, D, ws + WS_WA, 1024, D, nullptr, 3, 32.f}; tjob_run(j, tile); }
    { TJob j{p.in[18] + (size_t)l * 1024 * D, D, ws + WS_WB, 1024, D, nullptr, 3, 32.f}; tjob_run(j, tile); }
    { TJob j{p.in[19] + (size_t)l * D * D, D, ws + WS_WC, D, D, nullptr, 3, 32.f}; tjob_run(j, tile); }
    { TJob j{p.in[20] + (size_t)l * D * D, D, (bf16_t*)(ws + WS_WO), D, D, nullptr, 0, 1.f}; tjob_run(j, tile); }
    { TJob j{p.in[21] + (size_t)l * D * D, D, (bf16_t*)(ws + WS_WQ), D, D, nullptr, 0, 1.f}; tjob_run(j, tile); }
    for (int g = 0; g < 4; ++g) { TJob j{p.in[11] + ((size_t)l * 4 + g) * 65536, 256, (bf16_t*)(ws + WS_POOLT) + (size_t)g * 65536, 256, 256, nullptr, 0, 1.f}; tjob_run(j, tile); }
    cvt_plain(p.in[22] + (size_t)l * 2 * 8 * 128 * 128, (bf16_t*)(ws + WS_KEYS), (size_t)2 * 8 * 128 * 128 / 8);
    cvt_fp4<true>(p.in[23] + (size_t)l * 16384 * D, ws + WS_UT, (size_t)16384 * D / 32, U_IDELTA);
    cvt_fp4<false>(p.in[24] + (size_t)l * 16384 * D, ws + WS_VT, (size_t)16384 * D / 32, V_SCALE);
}

__device__ __forceinline__ unsigned pack4_fp8(float a, float b, float c, float d) {
    a = __builtin_amdgcn_fmed3f(a, -448.f, 448.f); b = __builtin_amdgcn_fmed3f(b, -448.f, 448.f); c = __builtin_amdgcn_fmed3f(c, -448.f, 448.f); d = __builtin_amdgcn_fmed3f(d, -448.f, 448.f);
    int t = __builtin_amdgcn_cvt_pk_fp8_f32(a, b, 0, false); return (unsigned)__builtin_amdgcn_cvt_pk_fp8_f32(c, d, t, true); }
__device__ __forceinline__ void modulate_store(const float (&x)[32], float rstd, const float* gain, const float* shift, const float* scale, bf16_t* hrow, unsigned char* h8row, int lane) {
#pragma unroll
    for (int j = 0; j < 4; ++j) {
        const int c = (j * 64 + lane) * 8;
        float o[8];
#pragma unroll
        for (int h4 = 0; h4 < 2; ++h4) {
            const f32x4 g = *(const f32x4*)(gain + c + 4 * h4), sh = *(const f32x4*)(shift + c + 4 * h4), sc = *(const f32x4*)(scale + c + 4 * h4);
#pragma unroll
            for (int e = 0; e < 4; ++e) o[h4 * 4 + e] = x[j * 8 + h4 * 4 + e] * rstd * g[e] * (1.f + sc[e]) + sh[e];
        }
        u32x4 w; w.x = cvt_pk_bf16(o[0], o[1]); w.y = cvt_pk_bf16(o[2], o[3]); w.z = cvt_pk_bf16(o[4], o[5]); w.w = cvt_pk_bf16(o[6], o[7]);
        *(u32x4*)(hrow + c) = w;
        if (h8row) *(u32x2*)(h8row + c) = (u32x2){pack4_fp8(o[0], o[1], o[2], o[3]), pack4_fp8(o[4], o[5], o[6], o[7])};
    }
}
__device__ __forceinline__ void load_row32(const float* xr, float (&x)[32], int lane) {
#pragma unroll
    for (int j = 0; j < 4; ++j) {
        const f32x4 a = *(const f32x4*)(xr + (j * 64 + lane) * 8), b = *(const f32x4*)(xr + (j * 64 + lane) * 8 + 4);
#pragma unroll
        for (int e = 0; e < 4; ++e) { x[j * 8 + e] = a[e]; x[j * 8 + 4 + e] = b[e]; }
    }
}
__device__ __forceinline__ void phase_modulate(const float* xl, const float* xc, const float* gain, const float* modl, int shift_i, int scale_i, bf16_t* H, unsigned char* H8, int nrows, int row0 = 0, int nb = 0) {
    const int tid_ = ltid(); const int wid = tid_ >> 6, lane = tid_ & 63;
    const int rstride = (nb ? nb : (int)gridDim.x) * 8;
    int row = row0 + lbid() * 8 + wid;
    float xn[32];
    if (row < nrows) load_row32((row >= RL) ? xc + (size_t)(row - RL) * D : xl + (size_t)row * D, xn, lane);
    for (; row < nrows; row += rstride) {
        const bool isc = row >= RL;
        const int mrow = isc ? 4 : (row >> 12);
        float x[32];
#pragma unroll
        for (int e = 0; e < 32; ++e) x[e] = xn[e];
        { const int nr = row + rstride;
          if (nr < nrows) load_row32((nr >= RL) ? xc + (size_t)(nr - RL) * D : xl + (size_t)nr * D, xn, lane); }
        float ss = 0.f;
#pragma unroll
        for (int e = 0; e < 32; ++e) ss += x[e] * x[e];
        ss = wave_sum(ss);
        const float rstd = rsqrtf(ss * (1.f / D) + RMS_EPS);
        modulate_store(x, rstd, gain, modl + (size_t)mrow * NMOD + shift_i * D, modl + (size_t)mrow * NMOD + scale_i * D, H + (size_t)row * D, H8 ? H8 + (size_t)row * D : nullptr, lane);
    }
}

__device__ __forceinline__ void phase_misc(const Params& p, int nrows) {
    unsigned char* ws = lws(p.ws);
    const int tid_ = ltid(); const int wid = tid_ >> 6, lane = tid_ & 63;
    const bf16_t* CQ = (const bf16_t*)(ws + WS_CQ); const bf16_t* CKV = (const bf16_t*)(ws + WS_CKV);
    const bf16_t* PU = (const bf16_t*)(ws + WS_PU); bf16_t* PO = (bf16_t*)(ws + WS_PYA);
    float* RS = (float*)(ws + WS_RSTD); const float* KR = (const float*)(ws + WS_KR); bf16_t* KROPE = (bf16_t*)(ws + WS_KROPE);
    const float* RT = (const float*)(ws + WS_RT);
    for (int row = lbid() * 8 + wid; row < ROWS; row += gridDim.x * 8) {
        const u32x4 a = *(const u32x4*)(CQ + (size_t)row * 512 + lane * 8), b = *(const u32x4*)(CKV + (size_t)row * 512 + lane * 8);
        const float xv = KR[(size_t)row * 64 + lane], xp = KR[(size_t)row * 64 + (lane ^ 16)];
        float cs = 1.f, sn = 0.f;
        if (row < RL) { const int t = row & 4095, part = lane >> 5, pos = part ? (t & 63) : (t >> 6), jf = lane & 15; cs = RT[(pos * 16 + jf) * 2]; sn = RT[(pos * 16 + jf) * 2 + 1]; }
        if (row < nrows) {
            const int seq0 = (row < RL) ? (row & ~4095) : (RL + ((row - RL) & ~255)), L = (row < RL) ? 4096 : 256, t = row - seq0;
            u32x4 w0[4], w1[16], me[2];
            float inv[2];
#pragma unroll
            for (int j = 0; j < 2; ++j) {
                const int ch = (j * 64 + lane) * 8, g = ch >> 8, half = 1 << g;
                int lo = t - half, hi = t + half; lo = lo < 0 ? 0 : lo; hi = hi > L ? L : hi;
                inv[j] = 1.f / (float)(hi - lo);
                me[j] = *(const u32x4*)(PU + (size_t)row * 1024 + ch);
                if (j == 0) {
#pragma unroll
                    for (int i = 0; i < 4; ++i) { int r = t - half + i; r = r < 0 ? 0 : (r >= L ? L - 1 : r); w0[i] = *(const u32x4*)(PU + (size_t)(seq0 + r) * 1024 + ch); }
                } else {
#pragma unroll
                    for (int i = 0; i < 16; ++i) { int r = t - half + i; r = r < 0 ? 0 : (r >= L ? L - 1 : r); w1[i] = *(const u32x4*)(PU + (size_t)(seq0 + r) * 1024 + ch); }
                }
            }
#pragma unroll
            for (int j = 0; j < 2; ++j) {
                const int ch = (j * 64 + lane) * 8, g = ch >> 8, half = 1 << g;
                float sacc[8] = {0.f, 0.f, 0.f, 0.f, 0.f, 0.f, 0.f, 0.f};
#pragma unroll
                for (int i = 0; i < (j == 0 ? 4 : 16); ++i) {
                    const int r = t - half + i; const bool ok = (i < 2 * half) && r >= 0 && r < L;
                    const u32x4 w = (j == 0) ? w0[i < 4 ? i : 0] : w1[i];
#pragma unroll
                    for (int e = 0; e < 4; ++e) { sacc[2 * e] += ok ? bflo(w[e]) : 0.f; sacc[2 * e + 1] += ok ? bfhi(w[e]) : 0.f; }
                }
                float o[8];
#pragma unroll
                for (int e = 0; e < 4; ++e) { o[2 * e] = sacc[2 * e] * inv[j] - bflo(me[j][e]); o[2 * e + 1] = sacc[2 * e + 1] * inv[j] - bfhi(me[j][e]); }
                u32x4 w; w.x = cvt_pk_bf16(o[0], o[1]); w.y = cvt_pk_bf16(o[2], o[3]); w.z = cvt_pk_bf16(o[4], o[5]); w.w = cvt_pk_bf16(o[6], o[7]);
                *(u32x4*)(PO + (size_t)row * 1024 + ch) = w;
            }
        }
        {
            float sa = 0.f, sb = 0.f;
#pragma unroll
            for (int e = 0; e < 4; ++e) { const float l0 = bflo(a[e]), h0 = bfhi(a[e]), l1 = bflo(b[e]), h1 = bfhi(b[e]); sa += l0 * l0 + h0 * h0; sb += l1 * l1 + h1 * h1; }
            sa = wave_sum(sa); sb = wave_sum(sb);
            if (lane == 0) { RS[row] = rsqrtf(sa * (1.f / 512.f) + RMS_EPS); RS[ROWS + row] = rsqrtf(sb * (1.f / 512.f) + RMS_EPS); }
        }
        {
            float o = xv;
            if (row < RL) o = (lane & 16) ? (xv * cs + xp * sn) : (xv * cs - xp * sn);
            KROPE[(size_t)row * 64 + lane] = f2bf(o);
        }
    }
}

__device__ __forceinline__ int chunk_row0(int b, int m) { return (m < 4) ? (RL + b * 256 + m * 64) : (b * 4096 + (m - 4) * 64); }
__device__ __forceinline__ int chunk_n(int m, int dir) { return dir ? ((m < 4) ? 3 - m : 71 - m) : m; }

__device__ __forceinline__ void phase_cb(const Params& p, const float* modl) {
    unsigned char* ws = lws(p.ws);
    const int tid = ltid(), wid = tid >> 6, lane = tid & 63;
    const bf16_t* WQ = (const bf16_t*)(ws + WS_WQ); float* CB = (float*)(ws + WS_CB);
    for (int n = lbid() * 8 + wid; n < D; n += gridDim.x * 8) {
        float w[32];
#pragma unroll
        for (int q = 0; q < 4; ++q) { const u32x4 ww = *(const u32x4*)(WQ + (size_t)n * D + lane * 32 + q * 8);
#pragma unroll
            for (int e = 0; e < 4; ++e) { w[q * 8 + 2 * e] = bflo(ww[e]); w[q * 8 + 2 * e + 1] = bfhi(ww[e]); } }
        float acc5[5];
#pragma unroll
        for (int b = 0; b < 5; ++b) {
            const float* sh = modl + (size_t)b * NMOD + 3 * D + lane * 32;
            float a = 0.f;
#pragma unroll
            for (int q = 0; q < 8; ++q) { const f32x4 sv = *(const f32x4*)(sh + q * 4);
#pragma unroll
                for (int e = 0; e < 4; ++e) a += sv[e] * w[q * 4 + e]; }
            acc5[b] = wave_sum(a);
        }
        if (lane < 5) CB[(size_t)lane * D + n] = (lane == 0) ? acc5[0] : (lane == 1) ? acc5[1] : (lane == 2) ? acc5[2] : (lane == 3) ? acc5[3] : acc5[4];
    }
}
__device__ __forceinline__ void hgrn_local(const Params& p, LAS unsigned char* lds) {
    unsigned char* ws = lws(p.ws);
    const int tid = ltid(), wid = tid >> 6, lane = tid & 63, r32 = lane & 31, hi = lane >> 5;
    const bf16_t* LF = (const bf16_t*)(ws + WS_LF); const bf16_t* IH = (const bf16_t*)(ws + WS_IH);
    bf16_t* ST = (bf16_t*)(ws + WS_ST); float* DEC = (float*)(ws + WS_DEC);
    constexpr int LQ = 136;
    LAS bf16_t* KT = (LAS bf16_t*)lds;
    LAS bf16_t* VT = (LAS bf16_t*)(lds + 2 * 128 * 72 * 2);
    LAS bf16_t* RLF = (LAS bf16_t*)(lds + 3 * 128 * 72 * 2);
    LAS float* SEG = (LAS float*)(lds + 3 * 128 * 72 * 2 + 2 * 64 * LQ * 2);
    for (int u = lbid(); u < NB * 8 * NCH; u += gridDim.x) {
        const int m = u % NCH, bh = u / NCH, b = bh >> 3, h = bh & 7, r0 = chunk_row0(b, m);
        __syncthreads();
#pragma unroll
        for (int i = 0; i < 2; ++i) {
            const int id = tid + 512 * i, row = id >> 4, c8 = (id & 15) * 8;
            const size_t g = (size_t)(r0 + row) * 1024 + h * 128 + c8;
            const u32x4 l0 = *(const u32x4*)(LF + g), l1 = *(const u32x4*)(LF + (size_t)ROWS * 1024 + g), vv = *(const u32x4*)(IH + g);
            *(LAS u32x4*)(RLF + row * LQ + c8) = l0; *(LAS u32x4*)(RLF + (64 + row) * LQ + c8) = l1;
#pragma unroll
            for (int e = 0; e < 4; ++e) { VT[(c8 + 2 * e) * 72 + row] = (bf16_t)(vv[e] & 0xffffu); VT[(c8 + 2 * e + 1) * 72 + row] = (bf16_t)(vv[e] >> 16); }
        }
        __syncthreads();
        const int c = tid & 127, seg = tid >> 7;
        float lf[2][16];
#pragma unroll
        for (int d = 0; d < 2; ++d) { float tot = 0.f;
#pragma unroll
            for (int r = 0; r < 16; ++r) { lf[d][r] = bf2f(RLF[(d * 64 + seg * 16 + r) * LQ + c]); tot += lf[d][r]; }
            SEG[(d * 4 + seg) * 128 + c] = tot; }
        __syncthreads();
#pragma unroll
        for (int d = 0; d < 2; ++d) {
            const float s0 = SEG[(d * 4 + 0) * 128 + c], s1 = SEG[(d * 4 + 1) * 128 + c], s2 = SEG[(d * 4 + 2) * 128 + c], s3 = SEG[(d * 4 + 3) * 128 + c];
            float run = (d == 0) ? ((seg < 3 ? s3 : 0.f) + (seg < 2 ? s2 : 0.f) + (seg < 1 ? s1 : 0.f))
                                 : ((seg > 0 ? s0 : 0.f) + (seg > 1 ? s1 : 0.f) + (seg > 2 ? s2 : 0.f));
            LAS bf16_t* dst = KT + (d * 128 + c) * 72 + seg * 16;
#pragma unroll
            for (int rr = 0; rr < 16; ++rr) {
                const int r = (d == 0) ? 15 - rr : rr;
                const float lv = (d == 0) ? lf[0][15 - rr] : lf[1][rr];
                dst[r] = f2bf((1.f - __expf(lv)) * __expf(run));
                run += lv;
            }
            if (seg == 0) DEC[((size_t)((bh * 2 + d) * NCH) + chunk_n(m, d)) * 128 + c] = __expf(s0 + s1 + s2 + s3);
        }
        __syncthreads();
        {
            const int dir = wid >> 2, vt = wid & 3;
            f32x16 acc[4];
#pragma unroll
            for (int ct = 0; ct < 4; ++ct) acc[ct] = (f32x16){0.f};
#pragma unroll
            for (int s_ = 0; s_ < 4; ++s_) {
                const bf16x8 a = *(const LAS bf16x8*)(VT + (vt * 32 + r32) * 72 + s_ * 16 + hi * 8);
#pragma unroll
                for (int ct = 0; ct < 4; ++ct) {
                    const bf16x8 bb = *(const LAS bf16x8*)(KT + (dir * 128 + ct * 32 + r32) * 72 + s_ * 16 + hi * 8);
                    acc[ct] = __builtin_amdgcn_mfma_f32_32x32x16_bf16(a, bb, acc[ct], 0, 0, 0);
                }
            }
            unsigned char* dst = (unsigned char*)ST + ((size_t)((bh * 2 + dir) * NCH) + chunk_n(m, dir)) * 16384;
#pragma unroll
            for (int ct = 0; ct < 4; ++ct)
#pragma unroll
                for (int r = 0; r < 16; ++r) { const float sv = __builtin_amdgcn_fmed3f(acc[ct][r], -448.f, 448.f); dst[(vt * 32 + crow(r, hi)) * 128 + ct * 32 + r32] = (unsigned char)__builtin_amdgcn_cvt_pk_fp8_f32(sv, sv, 0, false); }
        }
    }
    __syncthreads();
}
__device__ __forceinline__ void hgrn_scan(const Params& p) {
    unsigned char* ws = lws(p.ws);
    unsigned char* ST = ws + WS_ST; const float* DEC = (const float*)(ws + WS_DEC);
    for (int gid = lbid() * 512 + ltid(); gid < NSTREAM * 2048; gid += gridDim.x * 512) {
        const int stream = gid >> 11, rem = gid & 2047, c8 = (rem & 15) * 8;
        unsigned char* sp = ST + (size_t)stream * NCH * 16384 + (rem >> 4) * 128 + c8;
        const float* dp = DEC + (size_t)stream * NCH * 128 + c8;
        float S[8] = {0.f, 0.f, 0.f, 0.f, 0.f, 0.f, 0.f, 0.f};
        for (int n0 = 0; n0 < NCH; n0 += 4) {
            u32x2 uw[4]; f32x4 d0[4], d1[4];
#pragma unroll
            for (int i = 0; i < 4; ++i) { uw[i] = *(const u32x2*)(sp + (size_t)(n0 + i) * 16384); d0[i] = *(const f32x4*)(dp + (n0 + i) * 128); d1[i] = *(const f32x4*)(dp + (n0 + i) * 128 + 4); }
#pragma unroll
            for (int i = 0; i < 4; ++i) {
                *(u32x2*)(sp + (size_t)(n0 + i) * 16384) = (u32x2){pack4_fp8(S[0], S[1], S[2], S[3]), pack4_fp8(S[4], S[5], S[6], S[7])};
                const f32x2 u0 = __builtin_amdgcn_cvt_pk_f32_fp8((int)uw[i].x, false), u1 = __builtin_amdgcn_cvt_pk_f32_fp8((int)uw[i].x, true);
                const f32x2 u2 = __builtin_amdgcn_cvt_pk_f32_fp8((int)uw[i].y, false), u3 = __builtin_amdgcn_cvt_pk_f32_fp8((int)uw[i].y, true);
                S[0] = d0[i][0] * S[0] + u0[0]; S[1] = d0[i][1] * S[1] + u0[1]; S[2] = d0[i][2] * S[2] + u1[0]; S[3] = d0[i][3] * S[3] + u1[1];
                S[4] = d1[i][0] * S[4] + u2[0]; S[5] = d1[i][1] * S[5] + u2[1]; S[6] = d1[i][2] * S[6] + u3[0]; S[7] = d1[i][3] * S[7] + u3[1];
            }
        }
    }
}
__device__ __forceinline__ void hgrn_out(const Params& p, int l, bool last, LAS unsigned char* lds) {
    unsigned char* ws = lws(p.ws);
    const int tid = ltid(), wid = tid >> 6, lane = tid & 63, r32 = lane & 31, hi = lane >> 5;
    const bf16_t* LF = (const bf16_t*)(ws + WS_LF); const bf16_t* IH = (const bf16_t*)(ws + WS_IH); const bf16_t* QH = (const bf16_t*)(ws + WS_QH);
    const bf16_t* GH = (const bf16_t*)(ws + WS_GH); const bf16_t* ST = (const bf16_t*)(ws + WS_ST); bf16_t* YA = (bf16_t*)(ws + WS_PYA);
    const float* hgn = p.in[10] + l * 128;
    constexpr int LQ = 136;
    LAS bf16_t* Qt = (LAS bf16_t*)lds;
    LAS bf16_t* Kt = Qt + 64 * LQ;
    LAS bf16_t* Qi = Kt + 64 * LQ;
    LAS bf16_t* VT = Qi + 64 * LQ;
    LAS float* OB = (LAS float*)(lds + 3 * 64 * LQ * 2 + 128 * 72 * 2);
    LAS bf16_t* RQ = (LAS bf16_t*)(lds + 3 * 64 * LQ * 2 + 128 * 72 * 2 + 64 * 132 * 4);
    LAS bf16_t* RL_ = RQ + 64 * LQ;
    LAS float* SEG = (LAS float*)(RL_ + 64 * LQ);
    for (int u = lbid(); u < NB * 8 * NCH; u += gridDim.x) {
        const int m = u % NCH, bh = u / NCH, b = bh >> 3, h = bh & 7, r0 = chunk_row0(b, m);
        if (last && m < 4) continue;
        __syncthreads();
        u32x4 lfr[2][2], ghr[2];
        { const int grow = tid >> 3, gseg = (tid & 7) * 16; const size_t goff = (size_t)(r0 + grow) * 1024 + h * 128 + gseg;
          ghr[0] = *(const u32x4*)(GH + goff); ghr[1] = *(const u32x4*)(GH + goff + 8); }
#pragma unroll
        for (int i = 0; i < 2; ++i) {
            const int id = tid + 512 * i, row = id >> 4, c8 = (id & 15) * 8;
            lfr[0][i] = *(const u32x4*)(LF + (size_t)(r0 + row) * 1024 + h * 128 + c8);
            lfr[1][i] = *(const u32x4*)(LF + (size_t)ROWS * 1024 + (size_t)(r0 + row) * 1024 + h * 128 + c8);
            *(LAS u32x4*)(RQ + row * LQ + c8) = *(const u32x4*)(QH + (size_t)(r0 + row) * 1024 + h * 128 + c8);
            const u32x4 vv = *(const u32x4*)(IH + (size_t)(r0 + row) * 1024 + h * 128 + c8);
#pragma unroll
            for (int e = 0; e < 4; ++e) { VT[(c8 + 2 * e) * 72 + row] = (bf16_t)(vv[e] & 0xffffu); VT[(c8 + 2 * e + 1) * 72 + row] = (bf16_t)(vv[e] >> 16); }
        }
        f32x16 o = (f32x16){0.f};
        const int I = wid >> 2, vt = wid & 3;
        for (int dir = 0; dir < 2; ++dir) {
            __syncthreads();
#pragma unroll
            for (int i = 0; i < 2; ++i) {
                const int id = tid + 512 * i, row = id >> 4, c8 = (id & 15) * 8;
                *(LAS u32x4*)(RL_ + row * LQ + c8) = dir ? lfr[1][i] : lfr[0][i];
            }
            const unsigned char* Sg = (const unsigned char*)ST + ((size_t)((bh * 2 + dir) * NCH) + chunk_n(m, dir)) * 16384 + (size_t)(vt * 32 + r32) * 128 + hi * 8;
            u32x2 sraw[8];
#pragma unroll
            for (int s = 0; s < 8; ++s) sraw[s] = *(const u32x2*)(Sg + s * 16);
            bf16x8 sf[8];
#pragma unroll
            for (int s = 0; s < 8; ++s) {
                const f32x2 u0 = __builtin_amdgcn_cvt_pk_f32_fp8((int)sraw[s].x, false), u1 = __builtin_amdgcn_cvt_pk_f32_fp8((int)sraw[s].x, true);
                const f32x2 u2 = __builtin_amdgcn_cvt_pk_f32_fp8((int)sraw[s].y, false), u3 = __builtin_amdgcn_cvt_pk_f32_fp8((int)sraw[s].y, true);
                u32x4 w; w.x = cvt_pk_bf16(u0[0], u0[1]); w.y = cvt_pk_bf16(u1[0], u1[1]); w.z = cvt_pk_bf16(u2[0], u2[1]); w.w = cvt_pk_bf16(u3[0], u3[1]);
                sf[s] = *reinterpret_cast<bf16x8*>(&w);
            }
            __syncthreads();
            const int c = tid & 127, seg = tid >> 7;
            float lf[16]; float tot = 0.f;
#pragma unroll
            for (int r = 0; r < 16; ++r) { lf[r] = bf2f(RL_[(seg * 16 + r) * LQ + c]); tot += lf[r]; }
            SEG[seg * 128 + c] = tot;
            __syncthreads();
            {
                const float s0 = SEG[c], s1 = SEG[128 + c], s2 = SEG[256 + c], s3 = SEG[384 + c];
                const float bmid = dir ? (s2 + s3) : (s0 + s1);
                float run;
                if (dir == 0) run = (seg > 0 ? s0 : 0.f) + (seg > 1 ? s1 : 0.f) + (seg > 2 ? s2 : 0.f);
                else          run = (seg < 3 ? s3 : 0.f) + (seg < 2 ? s2 : 0.f) + (seg < 1 ? s1 : 0.f);
#pragma unroll
                for (int rr = 0; rr < 16; ++rr) {
                    const int r = dir ? 15 - rr : rr, row = seg * 16 + r;
                    const float lv = dir ? lf[15 - rr] : lf[rr];
                    const float q = bf2f(RQ[row * LQ + c]);
                    run += lv;
                    const float k = 1.f - __expf(lv);
                    const float dq = fminf(fmaxf(run - bmid, -80.f), 80.f);
                    Qt[row * LQ + c] = f2bf(q * __expf(dq));
                    Kt[row * LQ + c] = f2bf(k * __expf(-dq));
                    Qi[row * LQ + c] = f2bf(q * __expf(run));
                }
            }
            __syncthreads();
            for (int Jt = 0; Jt < 2; ++Jt) {
                const bool use = dir ? (Jt >= I) : (Jt <= I);
                if (!use) continue;
                f32x16 X = (f32x16){0.f};
#pragma unroll
                for (int s = 0; s < 8; ++s) {
                    const bf16x8 ka = *(const LAS bf16x8*)(Kt + (Jt * 32 + r32) * LQ + s * 16 + hi * 8);
                    const bf16x8 qb = *(const LAS bf16x8*)(Qt + (I * 32 + r32) * LQ + s * 16 + hi * 8);
                    X = __builtin_amdgcn_mfma_f32_32x32x16_bf16(ka, qb, X, 0, 0, 0);
                }
                if (Jt == I) {
#pragma unroll
                    for (int r = 0; r < 16; ++r) { const bool keep = dir ? (crow(r, hi) >= r32) : (crow(r, hi) <= r32); X[r] = keep ? X[r] : 0.f; }
                }
#pragma unroll
                for (int s2 = 0; s2 < 2; ++s2) {
                    u32x4 pw; pw.x = cvt_pk_bf16(X[8 * s2 + 0], X[8 * s2 + 1]); pw.y = cvt_pk_bf16(X[8 * s2 + 2], X[8 * s2 + 3]); pw.z = cvt_pk_bf16(X[8 * s2 + 4], X[8 * s2 + 5]); pw.w = cvt_pk_bf16(X[8 * s2 + 6], X[8 * s2 + 7]);
                    const int j0 = Jt * 32 + 16 * s2 + 4 * hi;
                    const u32x2 v0 = *(const LAS u32x2*)(VT + (vt * 32 + r32) * 72 + j0), v1 = *(const LAS u32x2*)(VT + (vt * 32 + r32) * 72 + j0 + 8);
                    u32x4 vw; vw.x = v0.x; vw.y = v0.y; vw.z = v1.x; vw.w = v1.y;
                    o = __builtin_amdgcn_mfma_f32_32x32x16_bf16(*(bf16x8*)&pw, *(bf16x8*)&vw, o, 0, 0, 0);
                }
            }
#pragma unroll
            for (int s = 0; s < 8; ++s) {
                const bf16x8 qa = *(const LAS bf16x8*)(Qi + (I * 32 + r32) * LQ + s * 16 + hi * 8);
                o = __builtin_amdgcn_mfma_f32_32x32x16_bf16(qa, sf[s], o, 0, 0, 0);
            }
        }
#pragma unroll
        for (int r = 0; r < 16; ++r) OB[(I * 32 + crow(r, hi)) * 132 + vt * 32 + r32] = o[r];
        __syncthreads();
        {
            const int row = tid >> 3, seg = (tid & 7) * 16;
            float ov[16]; float ss = 0.f;
#pragma unroll
            for (int e = 0; e < 16; ++e) { ov[e] = OB[row * 132 + seg + e]; ss += ov[e] * ov[e]; }
            ss += __shfl_xor(ss, 1); ss += __shfl_xor(ss, 2); ss += __shfl_xor(ss, 4);
            const float rstd = rsqrtf(ss * (1.f / 128.f) + RMS_EPS);
            const size_t off = (size_t)(r0 + row) * 1024 + h * 128 + seg;
            const u32x4 g0 = ghr[0], g1 = ghr[1];
            float y[16];
#pragma unroll
            for (int e = 0; e < 4; ++e) {
                y[2 * e] = ov[2 * e] * rstd * hgn[seg + 2 * e] * bflo(g0[e]); y[2 * e + 1] = ov[2 * e + 1] * rstd * hgn[seg + 2 * e + 1] * bfhi(g0[e]);
                y[8 + 2 * e] = ov[8 + 2 * e] * rstd * hgn[seg + 8 + 2 * e] * bflo(g1[e]); y[8 + 2 * e + 1] = ov[8 + 2 * e + 1] * rstd * hgn[seg + 8 + 2 * e + 1] * bfhi(g1[e]);
            }
            u32x4 w0;
            w0.x = pack4_fp8(y[0] * 8.f, y[1] * 8.f, y[2] * 8.f, y[3] * 8.f); w0.y = pack4_fp8(y[4] * 8.f, y[5] * 8.f, y[6] * 8.f, y[7] * 8.f);
            w0.z = pack4_fp8(y[8] * 8.f, y[9] * 8.f, y[10] * 8.f, y[11] * 8.f); w0.w = pack4_fp8(y[12] * 8.f, y[13] * 8.f, y[14] * 8.f, y[15] * 8.f);
            *(u32x4*)((unsigned char*)YA + (size_t)(r0 + row) * 2048 + h * 128 + seg) = w0;
        }
    }
    __syncthreads();
}

namespace att {
constexpr int SHM_V = 64 * 128 * 2, SHM_K = 64 * 192 * 2;
constexpr float SCALE = 0.07216878364870323f;
constexpr float THR = 8.f;
#define KSWZ(row, c16) ((row) * 384 + ((((c16) ^ (((row) >> 1) & 7))) << 4))
#define SBAR() __builtin_amdgcn_sched_barrier(0)
__device__ __forceinline__ void partialSM(f32x16& p0, f32x16& p1, float& m_reg, float& mn, float& alpha) {
    constexpr float C = SCALE * 1.4426950408889634f;
    float pmax = p0[0];
#pragma unroll
    for (int r = 1; r < 16; ++r) pmax = fmaxf(pmax, p0[r]);
#pragma unroll
    for (int r = 0; r < 16; ++r) pmax = fmaxf(pmax, p1[r]);
    { auto rr = __builtin_amdgcn_permlane32_swap(__float_as_uint(pmax), __float_as_uint(pmax), false, false);
      pmax = fmaxf(__uint_as_float(rr[0]), __uint_as_float(rr[1])); }
    if (__builtin_expect(__all(pmax - m_reg <= THR / SCALE), 1)) { mn = m_reg; alpha = 1.f; }
    else { mn = fmaxf(m_reg, pmax); alpha = __builtin_amdgcn_exp2f((m_reg - mn) * C); m_reg = mn; }
    const float mnC = -mn * C;
#pragma unroll
    for (int r = 0; r < 16; ++r) p0[r] = fmaf(p0[r], C, mnC);
#pragma unroll
    for (int r = 0; r < 16; ++r) p1[r] = fmaf(p1[r], C, mnC);
#pragma unroll
    for (int r = 0; r < 16; ++r) p0[r] = __builtin_amdgcn_exp2f(p0[r]);
}
__device__ __forceinline__ void finishSM(f32x16& p0, f32x16& p1, float alpha, float& l_reg, bf16x8& pa0, bf16x8& pa1, bf16x8& pa2, bf16x8& pa3) {
#pragma unroll
    for (int r = 0; r < 16; ++r) p1[r] = __builtin_amdgcn_exp2f(p1[r]);
    float ps = 0;
#pragma unroll
    for (int r = 0; r < 16; ++r) ps += p0[r];
#pragma unroll
    for (int r = 0; r < 16; ++r) ps += p1[r];
    { auto rr = __builtin_amdgcn_permlane32_swap(__float_as_uint(ps), __float_as_uint(ps), false, false);
      ps = __uint_as_float(rr[0]) + __uint_as_float(rr[1]); }
    l_reg = l_reg * alpha + ps;
#define PK4(P, BASE, OUT) do { unsigned a0 = cvt_pk_bf16(P[BASE + 0], P[BASE + 1]), a1 = cvt_pk_bf16(P[BASE + 2], P[BASE + 3]);   \
    unsigned b0 = cvt_pk_bf16(P[BASE + 4], P[BASE + 5]), b1 = cvt_pk_bf16(P[BASE + 6], P[BASE + 7]);                              \
    auto r0 = __builtin_amdgcn_permlane32_swap(a0, b0, false, false); auto r1 = __builtin_amdgcn_permlane32_swap(a1, b1, false, false); \
    u32x4 w = {r0[0], r1[0], r0[1], r1[1]}; OUT = *reinterpret_cast<bf16x8*>(&w); } while (0)
    PK4(p0, 0, pa0); PK4(p0, 8, pa1); PK4(p1, 0, pa2); PK4(p1, 8, pa3);
#undef PK4
}
__device__ __forceinline__ void qkt(f32x16& p0, f32x16& p1, const LAS char* Ks, const bf16x8* qr, int r32, int hi) {
    p0 = f32x16{}; p1 = f32x16{};
#pragma unroll
    for (int d0 = 0; d0 < 12; ++d0) { const int c16 = d0 * 2 + hi;
        const bf16x8 b0 = *reinterpret_cast<const LAS bf16x8*>(Ks + KSWZ(r32, c16));
        const bf16x8 b1 = *reinterpret_cast<const LAS bf16x8*>(Ks + KSWZ(32 + r32, c16));
        p0 = __builtin_amdgcn_mfma_f32_32x32x16_bf16(b0, qr[d0], p0, 0, 0, 0);
        p1 = __builtin_amdgcn_mfma_f32_32x32x16_bf16(b1, qr[d0], p1, 0, 0, 0); }
}
__device__ __forceinline__ int v_st(int k, int c) { const int kk = (k & ~0xC) | ((k & 4) << 1) | ((k & 8) >> 1); return ((kk >> 3) * 4 + (c >> 5)) * 512 + ((kk & 7) * 32 + (c & 31)) * 2; }
__device__ __forceinline__ int v_rd_base(int lane) { return ((lane & 3) << 3) | (((lane >> 2) & 3) << 6) | (((lane >> 4) & 1) << 5) | (((lane >> 5) & 1) << 8); }
constexpr int v_rd_off(int d0, int ks, int half) { return d0 * 512 + ks * 4096 + half * 2048; }
template <int OFF> __device__ __forceinline__ s16x4 tr_read(int vb) {
    s16x4 r; asm volatile("ds_read_b64_tr_b16 %0, %1 offset:%2" : "=&v"(r) : "v"(vb), "i"(OFF) : "memory"); return r;
}
template <int D0> __device__ __forceinline__ void pv_one(f32x16& od, int vb, bf16x8 pa0, bf16x8 pa1, bf16x8 pa2, bf16x8 pa3) {
    const s16x4 l0 = tr_read<v_rd_off(D0, 0, 0)>(vb), h0 = tr_read<v_rd_off(D0, 0, 1)>(vb), l1 = tr_read<v_rd_off(D0, 1, 0)>(vb), h1 = tr_read<v_rd_off(D0, 1, 1)>(vb);
    const s16x4 l2 = tr_read<v_rd_off(D0, 2, 0)>(vb), h2 = tr_read<v_rd_off(D0, 2, 1)>(vb), l3 = tr_read<v_rd_off(D0, 3, 0)>(vb), h3 = tr_read<v_rd_off(D0, 3, 1)>(vb);
    asm volatile("s_waitcnt lgkmcnt(0)" ::: "memory"); SBAR();
#define PK(L, H) (bf16x8){L[0], L[1], L[2], L[3], H[0], H[1], H[2], H[3]}
    od = __builtin_amdgcn_mfma_f32_32x32x16_bf16(pa0, PK(l0, h0), od, 0, 0, 0);
    od = __builtin_amdgcn_mfma_f32_32x32x16_bf16(pa1, PK(l1, h1), od, 0, 0, 0);
    od = __builtin_amdgcn_mfma_f32_32x32x16_bf16(pa2, PK(l2, h2), od, 0, 0, 0);
    od = __builtin_amdgcn_mfma_f32_32x32x16_bf16(pa3, PK(l3, h3), od, 0, 0, 0);
#undef PK
}
__device__ __forceinline__ void pv_d0(f32x16* o, int vb, bf16x8 pa0, bf16x8 pa1, bf16x8 pa2, bf16x8 pa3) {
    pv_one<0>(o[0], vb, pa0, pa1, pa2, pa3); pv_one<1>(o[1], vb, pa0, pa1, pa2, pa3); pv_one<2>(o[2], vb, pa0, pa1, pa2, pa3); pv_one<3>(o[3], vb, pa0, pa1, pa2, pa3);
}
constexpr int SHM_KV = SHM_K + SHM_V;
__device__ __forceinline__ void attn_unit(const bf16_t* __restrict__ Q, const bf16_t* __restrict__ KV, const bf16_t* __restrict__ KROPE, bf16_t* __restrict__ O, const float* __restrict__ RT,
                                          int q0, int h, int ctx0, int lat0, int nctx, int nkeys, int rope_t0, LAS char* lds) {
    const int tid = ltid(), wid = __builtin_amdgcn_readfirstlane(tid >> 6), lane = tid & 63, r32 = lane & 31, hi = lane >> 5;
    LAS float* wsm = (LAS float*)(lds + 3 * SHM_KV) + wid * 64; LAS float* li_l = wsm; LAS float* al_l = wsm + 32;
    const int vrb = v_rd_base(lane);
    int koff[3]; bool krope[3]; int voff[2];
#pragma unroll
    for (int i = 0; i < 3; ++i) { const int L = (wid + 8 * i) * 64 + lane, row = L / 24, c16 = (L % 24) ^ ((row >> 1) & 7);
        krope[i] = c16 >= 16; koff[i] = krope[i] ? row * 64 + (c16 - 16) * 8 : row * 4096 + c16 * 8; }
#pragma unroll
    for (int i = 0; i < 2; ++i) { const int L = (wid + 8 * i) * 64 + lane, st = L >> 5, w = L & 31, kk = (st >> 2) * 8 + (w >> 2);
        const int k = (kk & ~0xC) | ((kk & 4) << 1) | ((kk & 8) >> 1), c = (st & 3) * 32 + (w & 3) * 8; voff[i] = k * 4096 + 128 + c; }
    const bf16_t* KVh = KV + h * 256;
#define KVROW(k0) (((k0) < nctx) ? (ctx0 + (k0)) : (lat0 + (k0) - nctx))
#define DMA_TILE(t) do { const int _rb = KVROW((t) * 64); const bf16_t* _kv = KVh + (size_t)_rb * 4096; const bf16_t* _kr = KROPE + (size_t)_rb * 64; \
    LAS char* _kb = lds + ((t) % 3) * SHM_KV; \
    _Pragma("unroll") for (int _i = 0; _i < 3; ++_i) __builtin_amdgcn_global_load_lds((const unsigned*)((krope[_i] ? _kr : _kv) + koff[_i]), (LAS unsigned*)(_kb + (wid + 8 * _i) * 1024), 16, 0, 0); \
    _Pragma("unroll") for (int _i = 0; _i < 2; ++_i) __builtin_amdgcn_global_load_lds((const unsigned*)(_kv + voff[_i]), (LAS unsigned*)(_kb + SHM_K + (wid + 8 * _i) * 1024), 16, 0, 0); } while (0)
#define KBUF(t) (lds + ((t) % 3) * SHM_KV)
#define VBASE(t) ((int)(uintptr_t)(lds + ((t) % 3) * SHM_KV + SHM_K) + vrb)
#define LANDED() do { asm volatile("s_waitcnt vmcnt(0)" ::: "memory"); __syncthreads(); } while (0)
#define RESC(a) do { if (__any((a) < 1.f)) { if (hi == 0) al_l[r32] = (a); asm volatile("s_waitcnt lgkmcnt(0)" ::: "memory"); \
    _Pragma("unroll") for (int d = 0; d < 4; ++d) _Pragma("unroll") for (int r = 0; r < 16; ++r) o[d][r] *= al_l[crow(r, hi)]; } } while (0)
    f32x16 pA0, pA1, pB0, pB1; float mnA, mnB, alA, alB; bf16x8 pa0, pa1, pa2, pa3; const int NT = nkeys / 64;
    __syncthreads();
    DMA_TILE(0); DMA_TILE(1);
    float m_reg = -1e30f, l_reg = 0; f32x16 o[4] = {}; bf16x8 qr[12];
    const bf16_t* Qw = Q + (size_t)(q0 + wid * 32 + r32) * 3072 + h * 192 + hi * 8;
#pragma unroll
    for (int d0 = 0; d0 < 12; ++d0) qr[d0] = *reinterpret_cast<const bf16x8*>(Qw + d0 * 16);
    if (rope_t0 >= 0) {
        const int t = rope_t0 + wid * 32 + r32;
#pragma unroll
        for (int part = 0; part < 2; ++part) {
            const int pos = part ? (t & 63) : (t >> 6);
            const u32x4 x1 = *reinterpret_cast<u32x4*>(&qr[8 + 2 * part]), x2 = *reinterpret_cast<u32x4*>(&qr[9 + 2 * part]);
            float a[8], bq[8], o1[8], o2[8];
#pragma unroll
            for (int e = 0; e < 4; ++e) { a[2 * e] = bflo(x1[e]); a[2 * e + 1] = bfhi(x1[e]); bq[2 * e] = bflo(x2[e]); bq[2 * e + 1] = bfhi(x2[e]); }
#pragma unroll
            for (int e = 0; e < 8; ++e) { const f32x2 cssn = *(const f32x2*)(RT + (pos * 16 + hi * 8 + e) * 2); o1[e] = a[e] * cssn.x - bq[e] * cssn.y; o2[e] = bq[e] * cssn.x + a[e] * cssn.y; }
            u32x4 w1, w2;
            w1.x = cvt_pk_bf16(o1[0], o1[1]); w1.y = cvt_pk_bf16(o1[2], o1[3]); w1.z = cvt_pk_bf16(o1[4], o1[5]); w1.w = cvt_pk_bf16(o1[6], o1[7]);
            w2.x = cvt_pk_bf16(o2[0], o2[1]); w2.y = cvt_pk_bf16(o2[2], o2[3]); w2.z = cvt_pk_bf16(o2[4], o2[5]); w2.w = cvt_pk_bf16(o2[6], o2[7]);
            qr[8 + 2 * part] = *reinterpret_cast<bf16x8*>(&w1); qr[9 + 2 * part] = *reinterpret_cast<bf16x8*>(&w2);
        }
    }
    LANDED();
    qkt(pA0, pA1, KBUF(0), qr, r32, hi); partialSM(pA0, pA1, m_reg, mnA, alA);
    LANDED();
#define STEP(c0, c1, mnc, alc, p0_, p1_, alp, j, more) do { \
    if (more) DMA_TILE((j) + 1); \
    SBAR(); qkt(c0, c1, KBUF(j), qr, r32, hi); \
    finishSM(p0_, p1_, alp, l_reg, pa0, pa1, pa2, pa3); SBAR(); \
    pv_d0(o, VBASE((j) - 1), pa0, pa1, pa2, pa3); partialSM(c0, c1, m_reg, mnc, alc); \
    RESC(alc); LANDED(); } while (0)
    int j = 1;
    for (; j + 1 < NT; j += 2) {
        STEP(pB0, pB1, mnB, alB, pA0, pA1, alA, j, true);
        STEP(pA0, pA1, mnA, alA, pB0, pB1, alB, j + 1, true);
    }
    STEP(pB0, pB1, mnB, alB, pA0, pA1, alA, j, false);
    finishSM(pB0, pB1, alB, l_reg, pa0, pa1, pa2, pa3); SBAR();
    pv_d0(o, VBASE(j), pa0, pa1, pa2, pa3);
    if (hi == 0) li_l[r32] = l_reg; asm volatile("s_waitcnt lgkmcnt(0)" ::: "memory");
    float rli[16];
#pragma unroll
    for (int r = 0; r < 16; ++r) rli[r] = __builtin_amdgcn_rcpf(li_l[crow(r, hi)]);
    unsigned char* Ow = (unsigned char*)O + (size_t)(q0 + wid * 32) * (2 * D) + h * 128;
#pragma unroll
    for (int r = 0; r < 16; ++r) { const int orow = crow(r, hi); const float rs = rli[r] * 16.f;
#pragma unroll
        for (int d0 = 0; d0 < 4; ++d0) { const float val = __builtin_amdgcn_fmed3f(o[d0][r] * rs, -448.f, 448.f); Ow[(size_t)orow * (2 * D) + d0 * 32 + r32] = (unsigned char)__builtin_amdgcn_cvt_pk_fp8_f32(val, val, 0, false); } }
#undef KVROW
#undef DMA_TILE
#undef KBUF
#undef VBASE
#undef LANDED
#undef RESC
#undef STEP
}
}

__device__ __forceinline__ void phase_attention(const Params& p, bool last, LAS unsigned char* lds) {
    unsigned char* ws = lws(p.ws);
    const bf16_t* Q = (const bf16_t*)(ws + WS_Q); const bf16_t* KV = (const bf16_t*)(ws + WS_KV); const bf16_t* KROPE = (const bf16_t*)(ws + WS_KROPE);
    bf16_t* O = (bf16_t*)(ws + WS_YC); const float* RT = (const float*)(ws + WS_RT);
    const int nctxu = last ? 0 : 64, total = nctxu + 1024;
    for (int u = lbid(); u < total; u += gridDim.x) {
        if (u < nctxu) {
            const int b = u >> 4, h = u & 15;
            att::attn_unit(Q, KV, KROPE, O, RT, RL + b * 256, h, RL + b * 256, 0, 256, 256, -1, (LAS char*)lds);
        } else {
            int v = u - nctxu;
            if (gridDim.x == 256) {
                const int k = v >> 8, c = v & 255;
                v = (((k << 4) + ((c & 7) << 1) + (c >> 7)) << 4) | ((c >> 3) & 15);
            }
            const int qb = v & 15, h = (v >> 4) & 15, b = v >> 8;
            att::attn_unit(Q, KV, KROPE, O, RT, b * 4096 + qb * 256, h, RL + b * 256, b * 4096, 256, 4352, qb * 256, (LAS char*)lds);
        }
    }
    __syncthreads();
}

__device__ __forceinline__ void ins16(float (&a)[16], float x) {
#pragma unroll
    for (int k = 0; k < 16; ++k) { const float t = fmaxf(a[k], x); x = fminf(a[k], x); a[k] = t; }
}
__device__ __forceinline__ void phase_peer_select(const Params& p, int nrows, LAS unsigned char* lds, int row0 = 0, int nb = 0) {
    unsigned char* ws = lws(p.ws);
    const int tid = ltid(), wid = tid >> 6, lane = tid & 63, r32 = lane & 31, hi = lane >> 5;
    const bf16_t* PQ = (const bf16_t*)(ws + WS_PQ); const bf16_t* KEYS = (const bf16_t*)(ws + WS_KEYS);
    int* IDX = (int*)(ws + WS_IDX); float* GATE = (float*)(ws + WS_GATE);
    const int nwu = (nrows / 32) * 8;
    for (int wu = (row0 / 32) * 8 + lbid() * 8 + wid; wu < nwu; wu += (nb ? nb : (int)gridDim.x) * 8) {
        const int h = wu & 7, tb = wu >> 3, row = tb * 32 + r32;
        float top[2][16];
#pragma unroll
        for (int pp = 0; pp < 2; ++pp) {
            bf16x8 qb[8];
#pragma unroll
            for (int s = 0; s < 8; ++s) qb[s] = *(const bf16x8*)(PQ + (size_t)row * D + h * 256 + pp * 128 + s * 16 + hi * 8);
            float a[16];
#pragma unroll
            for (int k = 0; k < 16; ++k) a[k] = -INFINITY;
#pragma unroll 1
            for (int kt = 0; kt < 4; ++kt) {
                f32x16 acc = (f32x16){0.f};
                const bf16_t* kp = KEYS + ((size_t)(pp * 8 + h) * 128 + kt * 32 + r32) * 128 + hi * 8;
#pragma unroll
                for (int s = 0; s < 8; ++s) acc = __builtin_amdgcn_mfma_f32_32x32x16_bf16(*(const bf16x8*)(kp + s * 16), qb[s], acc, 0, 0, 0);
#pragma unroll
                for (int r = 0; r < 16; ++r) {
                    const unsigned key = kt * 32 + crow(r, hi);
                    ins16(a, __uint_as_float((__float_as_uint(acc[r]) & ~0x7Fu) | key));
                }
            }
            float o[16];
#pragma unroll
            for (int k = 0; k < 16; ++k) o[k] = __shfl_xor(a[k], 32);
#pragma unroll
            for (int k = 0; k < 16; ++k) ins16(a, o[k]);
#pragma unroll
            for (int k = 0; k < 16; ++k) top[pp][k] = a[k];
        }
        LAS int* lut = (LAS int*)lds + wid * 2048 + lane;
#pragma unroll
        for (int k = 0; k < 16; ++k) { lut[k * 64] = (int)(__float_as_uint(top[0][k]) & 0x7Fu); lut[(16 + k) * 64] = (int)(__float_as_uint(top[1][k]) & 0x7Fu); }
        float best[16]; int bid[16];
#pragma unroll
        for (int k = 0; k < 16; ++k) best[k] = -INFINITY;
#pragma unroll
        for (int i = 0; i < 16; ++i)
#pragma unroll
            for (int j = 0; j < 16; ++j) {
                if ((i + 1) * (j + 1) <= 16) {
                    const float v = __uint_as_float(__float_as_uint(top[0][i]) & ~0x7Fu) + __uint_as_float(__float_as_uint(top[1][j]) & ~0x7Fu);
                    ins16(best, __uint_as_float((__float_as_uint(v) & ~0xFFu) | (unsigned)(i * 16 + j)));
                }
            }
        asm volatile("s_waitcnt lgkmcnt(0)" ::: "memory");
#pragma unroll
        for (int k = 0; k < 16; ++k) {
            const unsigned code = __float_as_uint(best[k]) & 0xFFu;
            bid[k] = lut[(code >> 4) * 64] * 128 + lut[(16 + (code & 15u)) * 64];
            best[k] = __uint_as_float(__float_as_uint(best[k]) & ~0xFFu);
        }
        float e[16], sum = 0.f;
#pragma unroll
        for (int k = 0; k < 16; ++k) { e[k] = __expf(best[k] - best[0]); sum += e[k]; }
        const float inv = 1.f / sum;
        if (hi == 0) {
#pragma unroll
            for (int k4 = 0; k4 < 4; ++k4) {
                *(int4*)(IDX + (size_t)row * 128 + h * 16 + k4 * 4) = make_int4(bid[k4 * 4], bid[k4 * 4 + 1], bid[k4 * 4 + 2], bid[k4 * 4 + 3]);
                *(f32x4*)(GATE + (size_t)row * 128 + h * 16 + k4 * 4) = (f32x4){e[k4 * 4] * inv, e[k4 * 4 + 1] * inv, e[k4 * 4 + 2] * inv, e[k4 * 4 + 3] * inv};
            }
        }
    }
}

typedef _Float16 f16x2 __attribute__((ext_vector_type(2)));
__device__ __forceinline__ float dot32_fp4(const u32x4 w, const f16x2* h) {
    float s0 = 0.f, s1 = 0.f, s2 = 0.f, s3 = 0.f;
#define DOT_D(d, acc) { acc = __builtin_amdgcn_fdot2(__builtin_bit_cast(f16x2, __builtin_amdgcn_cvt_scalef32_pk_f16_fp4(w[d], 1.0f, 0)), h[4 * d + 0], acc, false); \
    acc = __builtin_amdgcn_fdot2(__builtin_bit_cast(f16x2, __builtin_amdgcn_cvt_scalef32_pk_f16_fp4(w[d], 1.0f, 1)), h[4 * d + 1], acc, false); \
    acc = __builtin_amdgcn_fdot2(__builtin_bit_cast(f16x2, __builtin_amdgcn_cvt_scalef32_pk_f16_fp4(w[d], 1.0f, 2)), h[4 * d + 2], acc, false); \
    acc = __builtin_amdgcn_fdot2(__builtin_bit_cast(f16x2, __builtin_amdgcn_cvt_scalef32_pk_f16_fp4(w[d], 1.0f, 3)), h[4 * d + 3], acc, false); }
    DOT_D(0, s0) DOT_D(1, s1) DOT_D(2, s2) DOT_D(3, s3)
#undef DOT_D
    return (s0 + s1) + (s2 + s3);
}
__device__ __forceinline__ float dot32_i4(const u32x4 w, const unsigned (&ha)[4], const unsigned (&hb)[4]) {
    int hi = __builtin_amdgcn_sdot8((int)w[0], (int)ha[0], 0, false), lo = __builtin_amdgcn_sdot8((int)w[0], (int)hb[0], 0, false);
#pragma unroll
    for (int d = 1; d < 4; ++d) { hi = __builtin_amdgcn_sdot8((int)w[d], (int)ha[d], hi, false); lo = __builtin_amdgcn_sdot8((int)w[d], (int)hb[d], lo, false); }
    return (float)((hi << 4) + lo);
}
__device__ __forceinline__ void axpy32_fp4(f16x2* o, const u32x4 w, const f16x2 a) {
#define AXPY_B(d, b) o[4 * d + b] = __builtin_elementwise_fma(__builtin_bit_cast(f16x2, __builtin_amdgcn_cvt_scalef32_pk_f16_fp4(w[d], 1.0f, b)), a, o[4 * d + b]);
#pragma unroll
    for (int d = 0; d < 4; ++d) { AXPY_B(d, 0) AXPY_B(d, 1) AXPY_B(d, 2) AXPY_B(d, 3) }
#undef AXPY_B
}
__device__ __forceinline__ float reduce8(const float (&v)[8], int lane) {
    const bool h5 = lane & 32, h4 = lane & 16, h3 = lane & 8;
    float a[4];
#pragma unroll
    for (int i = 0; i < 4; ++i) a[i] = (h5 ? v[4 + i] : v[i]) + __shfl_xor(h5 ? v[i] : v[4 + i], 32);
    float b[2];
#pragma unroll
    for (int i = 0; i < 2; ++i) b[i] = (h4 ? a[2 + i] : a[i]) + __shfl_xor(h4 ? a[i] : a[2 + i], 16);
    float c = (h3 ? b[1] : b[0]) + __shfl_xor(h3 ? b[0] : b[1], 8);
    c += __shfl_xor(c, 4); c += __shfl_xor(c, 2); c += __shfl_xor(c, 1);
    return c;
}
__device__ __forceinline__ float reduce4(const float (&v)[4], int lane) {
    return row_sum16(swap_add16(swap_add32(v[0], v[2]), swap_add32(v[1], v[3])));
}
struct RowMap { int a0, sA, nA, b0, sB, n; __device__ __forceinline__ int operator()(int v) const { return v < nA ? a0 + v * sA : b0 + (v - nA) * sB; } };
__device__ __forceinline__ void phase_peer_gather(const Params& p, int l, bool last, const RowMap rm, LAS unsigned char* lds, int dry = 0) {
    unsigned char* ws = lws(p.ws);
    const int tid = ltid(), wid = tid >> 6, lane = tid & 63;
    const unsigned char* UT4 = ws + WS_UT; const unsigned char* VT4 = ws + WS_VT;
    const int* IDX = (const int*)(ws + WS_IDX); const float* GATE = (const float*)(ws + WS_GATE);
    const float* modl = (const float*)(ws + WS_MOD) + (size_t)l * 5 * NMOD;
    LAS float* actw = (LAS float*)lds + wid * 128;
    const int pself = ((lane >> 5) & 1) * 2 + ((lane >> 4) & 1);
#define ROWIN(r, IA, IB, GA, GB) do { IA = IDX[(size_t)(r) * 128 + lane]; IB = IDX[(size_t)(r) * 128 + 64 + lane]; GA = GATE[(size_t)(r) * 128 + lane]; GB = GATE[(size_t)(r) * 128 + 64 + lane]; } while (0)
#define XLOAD(r, XR) do { const float* _xp = ((r) >= RL) ? (const float*)(ws + WS_XC) + (size_t)((r) - RL) * D : p.out + (size_t)(r) * D; _Pragma("unroll") for (int q = 0; q < 8; ++q) XR[q] = *(const f32x4*)(_xp + lane * 32 + q * 4); } while (0)
    int idxA = 0, idxB = 0; float gA = 0.f, gB = 0.f;
    f32x4 xrow[8];
    int row = rm(0);
    if (rm.n > 0) { ROWIN(row, idxA, idxB, gA, gB); XLOAD(row, xrow); }
    for (int v = 0; v < rm.n; ++v) {
        const bool isc = row >= RL;
        const int mrow = isc ? 4 : (row >> 12);
#define GSEL(g, A, B) ((int)(((unsigned)(A) & (((g) < 16) ? 0xFFFFFFFFu : 0u)) | ((unsigned)(B) & (((g) < 16) ? 0u : 0xFFFFFFFFu))))
#define TLOAD(buf, g, T4) do { const int _si = GSEL(g, idxA, idxB); _Pragma("unroll") for (int q = 0; q < 4; ++q) { const int _e = __builtin_amdgcn_readlane(_si, ((g) * 4 + q) & 63); buf[q] = *(const GAS u32x4*)((const GAS unsigned char*)(T4) + (size_t)_e * 1024 + (unsigned)(lane * 16)); } } while (0)
        u32x4 b0[4], b1[4], b2[4], b3[4], b4[4], b5[4];
        TLOAD(b0, 0, UT4); TLOAD(b1, 1, UT4); TLOAD(b2, 2, UT4); TLOAD(b3, 3, UT4); TLOAD(b4, 4, UT4);
        unsigned ha[4], hb[4]; float kact, halfsq;
        {
            float ssx = 0.f;
#pragma unroll
            for (int q = 0; q < 8; ++q)
#pragma unroll
                for (int e = 0; e < 4; ++e) ssx += xrow[q][e] * xrow[q][e];
            ssx = wave_sum(ssx);
            const float rstd2 = rsqrtf(ssx * (1.f / D) + RMS_EPS);
            const float* g2p = p.in[7] + l * D + lane * 32; const float* scp = modl + (size_t)mrow * NMOD + 4 * D + lane * 32; const float* shp = modl + (size_t)mrow * NMOD + 3 * D + lane * 32;
            float hv[32]; float am = 0.f;
#pragma unroll
            for (int q = 0; q < 8; ++q) {
                const f32x4 g2 = *(const f32x4*)(g2p + q * 4), sc = *(const f32x4*)(scp + q * 4), sh = *(const f32x4*)(shp + q * 4);
#pragma unroll
                for (int e = 0; e < 4; ++e) { const float hval = xrow[q][e] * rstd2 * g2[e] * (1.f + sc[e]) + sh[e]; hv[q * 4 + e] = hval; am = fmaxf(am, fabsf(hval)); }
            }
            am = wave_max(am);
            const float hs = am > 0.f ? 119.f / am : 0.f;
            int sq = 0;
#pragma unroll
            for (int d = 0; d < 4; ++d) {
                unsigned A = 0u, Bn = 0u;
#pragma unroll
                for (int i = 0; i < 8; ++i) {
                    const int q0 = __float2int_rn(hv[d * 8 + i] * hs);
                    sq += q0;
                    Bn |= ((unsigned)q0 & 15u) << (4 * i);
                    A |= ((unsigned)((q0 + 8) >> 4) & 15u) << (4 * i);
                }
                ha[d] = A; hb[d] = Bn;
            }
            halfsq = 0.5f * wave_sum((float)sq);
            kact = am * (1.f / (119.f * U_IDELTA));
        }
#define UCOMP(buf, g) do { float part[4]; if (dry == 2) { _Pragma("unroll") for (int q = 0; q < 4; ++q) part[q] = __uint_as_float(buf[q].x ^ buf[q].y ^ buf[q].z ^ buf[q].w); } else _Pragma("unroll") for (int q = 0; q < 4; ++q) part[q] = dot32_i4(buf[q], ha, hb); \
        const float _r = reduce4(part, lane); if ((lane & 15) == 0) actw[(g) * 4 + pself] = (_r + halfsq) * kact; } while (0)
        {
#pragma unroll 1
            for (int g = 0; g < 30; g += 6) {
                TLOAD(b5, g + 5, UT4); UCOMP(b0, g);
                TLOAD(b0, g + 6, UT4); UCOMP(b1, g + 1);
                TLOAD(b1, g + 7, UT4); UCOMP(b2, g + 2);
                if (g + 8 < 32) TLOAD(b2, g + 8, UT4);
                UCOMP(b3, g + 3);
                if (g + 9 < 32) TLOAD(b3, g + 9, UT4);
                UCOMP(b4, g + 4);
                if (g + 10 < 32) TLOAD(b4, g + 10, UT4);
                UCOMP(b5, g + 5);
            }
            UCOMP(b0, 30); UCOMP(b1, 31);
        }
        u32x4 vb0[4], vb1[4], vb2[4];
        TLOAD(vb0, 0, VT4); TLOAD(vb1, 1, VT4);
        asm volatile("s_waitcnt lgkmcnt(0)" ::: "memory");
        const float aA = actw[lane], aB = actw[64 + lane];
        const float wA = gA * 0.5f * aA * (1.f + erff(aA * 0.70710678118654752f)) * (1.f / V_SCALE), wB = gB * 0.5f * aB * (1.f + erff(aB * 0.70710678118654752f)) * (1.f / V_SCALE);
        const int whA = (int)__builtin_bit_cast(unsigned, (f16x2){(_Float16)wA, (_Float16)wA}), whB = (int)__builtin_bit_cast(unsigned, (f16x2){(_Float16)wB, (_Float16)wB});
#define VCOMP(buf, g) do { if (dry == 2) { _Pragma("unroll") for (int q = 0; q < 4; ++q) out[q] += __uint_as_float(buf[q].x ^ buf[q].y ^ buf[q].z ^ buf[q].w); } else { const int _sw = GSEL(g, whA, whB); _Pragma("unroll") for (int q = 0; q < 4; ++q) { const f16x2 _w2 = __builtin_bit_cast(f16x2, (unsigned)__builtin_amdgcn_readlane(_sw, ((g) * 4 + q) & 63)); axpy32_fp4(oh, buf[q], _w2); } } } while (0)
        float* xr = isc ? (float*)(ws + WS_XC) + (size_t)(row - RL) * D : p.out + (size_t)row * D;
        const float* gp = modl + (size_t)mrow * NMOD + 5 * D;
        f32x4 grow[8];
#pragma unroll
        for (int q = 0; q < 8; ++q) grow[q] = *(const f32x4*)(gp + lane * 32 + q * 4);
        float out[32]; f16x2 oh[16];
#pragma unroll
        for (int e = 0; e < 16; ++e) oh[e] = (f16x2){(_Float16)0.f, (_Float16)0.f};
#pragma unroll
        for (int e = 0; e < 4; ++e) out[e] = 0.f;
        {
#pragma unroll 1
            for (int g = 0; g < 30; g += 3) {
                TLOAD(vb2, g + 2, VT4); VCOMP(vb0, g);
                TLOAD(vb0, g + 3, VT4); VCOMP(vb1, g + 1);
                TLOAD(vb1, g + 4, VT4); VCOMP(vb2, g + 2);
            }
            VCOMP(vb0, 30); VCOMP(vb1, 31);
        }
        if (dry != 2) {
#pragma unroll
            for (int e = 0; e < 16; ++e) { out[2 * e] = (float)oh[e].x; out[2 * e + 1] = (float)oh[e].y; }
        }
#undef GSEL
#undef TLOAD
#undef UCOMP
#undef VCOMP
        float x[32]; float ss = 0.f;
#pragma unroll
        for (int q = 0; q < 8; ++q) {
            const f32x4 xv = xrow[q], gv = grow[q];
#pragma unroll
            for (int e = 0; e < 4; ++e) { const float t = xv[e] + gv[e] * out[q * 4 + e]; x[q * 4 + e] = t; ss += t * t; }
        }
        ss = wave_sum(ss);
        const float rstd = rsqrtf(ss * (1.f / D) + RMS_EPS);
        int nia = 0, nib = 0; float nga = 0.f, ngb = 0.f;
        const bool more = v + 1 < rm.n;
        const int nrow = rm(v + 1);
        if (more) { ROWIN(nrow, nia, nib, nga, ngb); XLOAD(nrow, xrow); }
#define ROWNEXT() do { idxA = nia; idxB = nib; gA = nga; gB = ngb; row = nrow; } while (0)
        if (dry) { if (rstd == 123.456f) xr[lane] = rstd; ROWNEXT(); continue; }
        if (last) {
            const float* fn = p.in[25];
#pragma unroll
            for (int q = 0; q < 8; ++q) {
                const int c = lane * 32 + q * 4;
                const f32x4 f0 = *(const f32x4*)(fn + c);
                f32x4 o0;
#pragma unroll
                for (int e = 0; e < 4; ++e) o0[e] = x[q * 4 + e] * rstd * f0[e];
                *(f32x4*)(xr + c) = o0;
            }
        } else {
            const float* modn = (const float*)(ws + WS_MOD) + (size_t)(l + 1) * 5 * NMOD + (size_t)mrow * NMOD;
            const float* gain = p.in[6] + (l + 1) * D;
            bf16_t* hrow = (bf16_t*)(ws + WS_H) + (size_t)row * D;
#pragma unroll
            for (int q2 = 0; q2 < 4; ++q2) {
                float o[8];
#pragma unroll
                for (int q = 0; q < 2; ++q) {
                    const int c = lane * 32 + q2 * 8 + q * 4;
                    *(f32x4*)(xr + c) = (f32x4){x[q2 * 8 + q * 4], x[q2 * 8 + q * 4 + 1], x[q2 * 8 + q * 4 + 2], x[q2 * 8 + q * 4 + 3]};
                    const f32x4 g = *(const f32x4*)(gain + c), sh = *(const f32x4*)(modn + c), sc = *(const f32x4*)(modn + D + c);
#pragma unroll
                    for (int e = 0; e < 4; ++e) o[q * 4 + e] = x[q2 * 8 + q * 4 + e] * rstd * g[e] * (1.f + sc[e]) + sh[e];
                }
                u32x4 w0;
                w0.x = cvt_pk_bf16(o[0], o[1]); w0.y = cvt_pk_bf16(o[2], o[3]); w0.z = cvt_pk_bf16(o[4], o[5]); w0.w = cvt_pk_bf16(o[6], o[7]);
                *(u32x4*)(hrow + lane * 32 + q2 * 8) = w0;
                *(u32x2*)(ws + WS_H8 + (size_t)row * D + lane * 32 + q2 * 8) = (u32x2){pack4_fp8(o[0], o[1], o[2], o[3]), pack4_fp8(o[4], o[5], o[6], o[7])};
            }
        }
        ROWNEXT();
    }
#undef ROWIN
#undef XLOAD
#undef ROWNEXT
}

#ifdef DIAG_SCAN
__device__ __forceinline__ void dscan_bf16(const void* ptr, size_t nelem, unsigned* word, unsigned k) {
    const u32x4* q = (const u32x4*)ptr; const size_t n8 = nelem / 8; bool bad = false;
    for (size_t i = (size_t)lbid() * 512 + ltid(); i < n8; i += (size_t)gridDim.x * 512) {
        const u32x4 w = q[i];
#pragma unroll
        for (int e = 0; e < 4; ++e) { bad |= ((w[e] & 0x7F80u) == 0x7F80u); bad |= ((w[e] & 0x7F800000u) == 0x7F800000u); }
    }
    if (bad) atomicMax(word, 1000u - k);
}
__device__ __forceinline__ void dscan_f32(const void* ptr, size_t nelem, unsigned* word, unsigned k) {
    const unsigned* q = (const unsigned*)ptr; bool bad = false;
    for (size_t i = (size_t)lbid() * 512 + ltid(); i < nelem; i += (size_t)gridDim.x * 512) bad |= ((q[i] & 0x7F800000u) == 0x7F800000u);
    if (bad) atomicMax(word, 1000u - k);
}
#define DSB(off, n, k) if ((k) < 11) dscan_bf16(ws + (off), (size_t)(n), (unsigned*)(ws + WS_CTL) + 8192, (unsigned)(l * 16 + (k)))
#define DSF(off, n, k) if ((k) < 11) dscan_f32(ws + (off), (size_t)(n), (unsigned*)(ws + WS_CTL) + 8192, (unsigned)(l * 16 + (k)))
#else
#define DSB(off, n, k) do {} while (0)
#define DSF(off, n, k) do {} while (0)
#endif
__global__ void __launch_bounds__(512, 2) fwd_kernel(Params p) {
    extern __shared__ __attribute__((aligned(16))) unsigned char lds_raw[];
    LAS unsigned char* lds = (LAS unsigned char*)lds_raw;
    unsigned char* ws = p.ws;
    const int G = gridDim.x;
#if MK_ONE_LAUNCH
    if (threadIdx.x < 4) ((LAS unsigned*)(lds + LDS_BARW))[threadIdx.x] = 0u;
    __syncthreads();
    XcdBarrier bar = xcd_barrier_post((unsigned*)(ws + WS_CTL), (volatile LAS unsigned*)(lds + LDS_BARW));
#define GRID_BAR() xcd_barrier(bar)
#else
#define GRID_BAR() do {} while (0)
#endif
    const int lo = p.ph_lo, hi = p.ph_hi;
#define IN(k) (lo <= (k) && (k) < hi)
#define SEAM(k) do { if (IN(k) && IN((k) + 1)) { GRID_BAR(); if (PROBE_DUP == 20) GRID_BAR(); } } while (0)
    for (int l = 0; l < 2; ++l) {
        unsigned char* const ws = lws(p.ws);
        const bool last = (l == 1);
        const int base = l * NPH;
        const int nrows = last ? RL : ROWS;
        const float* modl = (const float*)(ws + WS_MOD) + (size_t)l * 5 * NMOD;
        const float* xin_l = (l == 0) ? p.in[0] : p.out;
        const float* xin_c = (l == 0) ? p.in[2] : (const float*)(ws + WS_XC);
        if (PH_ON(0) && IN(base + 0)) { DUP(0) phase_convert(p, l, lds); }
        SEAM(base + 0);
        if (PH_ON(1) && IN(base + 1)) { DSF(WS_MOD, 2 * 5 * NMOD, 1); DSB(WS_WIN, (WS_H - WS_WIN) / 2, 2); }
        if (PH_ON(1) && IN(base + 1) && l == 0) { phase_modulate(xin_l, xin_c, p.in[6] + l * D, modl, 0, 1, (bf16_t*)(ws + WS_H), ws + WS_H8, ROWS); }
        if (l == 0) SEAM(base + 1);
        if (PH_ON(2) && IN(base + 2)) {
            DSB(WS_H, (size_t)ROWS * D, 3);
            DUP(2) {
            if (SUB_ON(8)) {
                pg8::Gemm g{ws + WS_H8, ws + WS_WIN8, ROWS, NIN8, D, D, D, 0};
                pg8::StaticOrder S;
                if (!last) { S.init(ROWS, NIN8, G, lbid());
                    if (G == 256) S.set_tail(7, 80, 176); }
                else { S.init(RL, NIN8, G, lbid()); S.set_extra(4 * 3, 3, 6, 32);
                    if (G == 256) S.set_tail(7, 48, 208); }
                EpiWin8 E{ws};
                pg8::gemm_phase<true>(lds, g, S, E); }
            if (SUB_ON(9)) {
                pg8::Gemm g{ws + WS_H, ws + WS_WINF, ROWS, NINF, 2 * D, 2 * D, 2 * D, 0};
                pg8::StaticOrder S;
                if (!last) S.init(ROWS, NINF, G, lbid());
                else { S.init(RL, NINF, G, lbid()); S.set_extra(4 * 12, 12, 4, 0); }
                EpiLF E{ws, (const float*)(ws + WS_LB) + l * 4096};
                pg8::gemm_phase<false>(lds, g, S, E); }
            }
        }
        SEAM(base + 2);
        if (PH_ON(3) && IN(base + 3)) { DSB(WS_QH, (WS_GT - WS_QH) / 2, 4); DSB(WS_GT, (size_t)ROWS * 6144, 5); DSF(WS_KR, (size_t)ROWS * 64, 6); }
        if (PH_ON(3) && IN(base + 3)) { DUP(3) { if (SUB_ON(0)) { phase_misc(p, nrows); phase_cb(p, modl); } } DUP(13) { if (SUB_ON(1)) hgrn_local(p, lds); } }
        SEAM(base + 3);
        if (PH_ON(4) && IN(base + 4)) {
            DSF(WS_RSTD, 2 * ROWS, 7); DSB(WS_KROPE, (size_t)ROWS * 64, 7); DSB(WS_PYA, (size_t)nrows * 1024, 7); DSB(WS_ST, (size_t)NSTREAM * NCH * 16384, 8); DSF(WS_DEC, (size_t)NSTREAM * NCH * 128, 8);
            __syncthreads();
            if (SUB_ON(4)) hgrn_scan(p);
            DUP(4) {
            if (SUB_ON(5)) {   pg8::Gemm g{ws + WS_CQ8, ws + WS_WUQ, nrows, 3072, 512, 512, 512, 0};
                pg8::StaticOrder S; S.init(nrows, 3072, G, lbid());
                EpiScale<1> E{(bf16_t*)(ws + WS_Q), 3072, (const float*)(ws + WS_RSTD), 1.f / 32.f};
                pg8::gemm_phase<true>(lds, g, S, E); }
            if (SUB_ON(6)) {   pg8::Gemm g{ws + WS_CKV8, ws + WS_WUKV, ROWS, 4096, 512, 512, 512, 0};
                pg8::StaticOrder S; S.init(ROWS, 4096, G, (lbid() + G - 48) % G);
                EpiScale<1> E{(bf16_t*)(ws + WS_KV), 4096, (const float*)(ws + WS_RSTD) + ROWS, 1.f / 32.f};
                pg8::gemm_phase<true>(lds, g, S, E); }
            if (SUB_ON(7)) {   pg8::Gemm g{ws + WS_PYA, ws + WS_POOLT, nrows, 1024, 512, 2048, 512, 512};
                pg8::StaticOrder S; S.init(nrows, 1024, G, (lbid() + G - 112) % G);
                EpiScale<2> E{(bf16_t*)(ws + WS_YB), 1024, p.in[12] + l * 1024};
                pg8::gemm_phase<false>(lds, g, S, E); }
            }
        }
        SEAM(base + 4);
        if (PH_ON(5) && IN(base + 5)) { DSB(WS_Q, (size_t)nrows * 3072, 9); DSB(WS_KV, (size_t)ROWS * 4096, 9); DSB(WS_YB, (size_t)nrows * 1024, 9); DSB(WS_ST, (size_t)NSTREAM * NCH * 16384, 9); }
        if (PH_ON(5) && IN(base + 5)) { DUP(5) { if (SUB_ON(2)) phase_attention(p, last, lds); } DUP(15) { if (SUB_ON(3)) hgrn_out(p, l, last, lds); } }
        SEAM(base + 5);
        const bool side = CTX_SIDE && !last && G > 2 * NSUBC;
        const int nr6 = side ? RL : nrows;
        if (PH_ON(6) && IN(base + 6)) DUP(6) {
            {   pg8::Gemm g{ws + WS_PYA, ws + WS_WA, nr6, D, 1024, 2048, 1024, 0};
                pg8::StaticOrder S; S.init(nr6, D, G, lbid());
                EpiMerge<0> E{(bf16_t*)(ws + WS_M), (const bf16_t*)(ws + WS_GT), 0, 1.f / 256.f};
                pg8::gemm_phase<true>(lds, g, S, E); }
            {   pg8::Gemm g{ws + WS_YB, ws + WS_WB, nr6, D, 1024, 2048, 1024, 0};
                pg8::StaticOrder S; S.init(nr6, D, G, lbid());
                EpiMerge<1> E{(bf16_t*)(ws + WS_M), (const bf16_t*)(ws + WS_GT), D, 1.f / 128.f};
                pg8::gemm_phase<true>(lds, g, S, E); }
            {   pg8::Gemm g{ws + WS_YC, ws + WS_WC, nr6, D, D, 2 * D, D, 0};
                pg8::StaticOrder S; S.init(nr6, D, G, lbid());
                EpiMerge<1> E{(bf16_t*)(ws + WS_M), (const bf16_t*)(ws + WS_GT), 2 * D, 1.f / 512.f};
                pg8::gemm_phase<true>(lds, g, S, E); }
        }
        SEAM(base + 6);
        if (PH_ON(7) && IN(base + 7)) {
            pg8::Gemm g{ws + WS_M, ws + WS_WO, nr6, D, 2 * D, 2 * D, 2 * D, 0};
            pg8::StaticOrder S; S.init(nr6, D, G, lbid());
            EpiResid E{xin_l, xin_c, p.out, (float*)(ws + WS_XC), modl, p.in[7] + l * D, (bf16_t*)(ws + WS_H), (float*)(ws + WS_SS)};
            for (int _d = 0; _d < ((PROBE_DUP == 7 && l == 0) ? 2 : 1); ++_d) pg8::gemm_phase<false>(lds, g, S, E);
        }
        SEAM(base + 7);
        if (PH_ON(9) && IN(base + 9)) {
            pg8::Gemm g{ws + WS_H, ws + WS_WQ, nr6, D, 2 * D, 2 * D, 2 * D, 0};
            pg8::StaticOrder S; S.init(nr6, D, G, lbid());
            EpiPeerQ E{(bf16_t*)(ws + WS_PQ), (const float*)(ws + WS_SS), (const float*)(ws + WS_CB)};
            DUP(9) pg8::gemm_phase<false>(lds, g, S, E);
        }
        SEAM(base + 9);
        if (PH_ON(10) && IN(base + 10)) { DUP(10) phase_peer_select(p, nr6, lds); }
        SEAM(base + 10);
        if (PH_ON(11) && IN(base + 11)) {
            RowMap rm;
            const int wv = __builtin_amdgcn_readfirstlane(ltid() >> 6);
            if (side) {
                const int W = (G - NSUBC) * 8, L1 = (RL / W) * W;
                if (lbid() < NSUBC) {
                    unsigned char* wsc = lws(p.ws);
                    unsigned* barw = (unsigned*)(wsc + WS_CTL); unsigned tgt = 0u;
                    constexpr int NC = ROWS - RL, PM0 = RL / 256;
                    {   pg8::Gemm g{wsc + WS_PYA, wsc + WS_WA, NC, D, 1024, 2048, 1024, 0};
                        pg8::StaticOrder S; S.init(NC, D, NSUBC, lbid()); S.pm0 = PM0;
                        EpiMerge<0> E{(bf16_t*)(wsc + WS_M), (const bf16_t*)(wsc + WS_GT), 0, 1.f / 256.f};
                        pg8::gemm_phase<true>(lds, g, S, E); }
                    {   pg8::Gemm g{wsc + WS_YB, wsc + WS_WB, NC, D, 1024, 2048, 1024, 0};
                        pg8::StaticOrder S; S.init(NC, D, NSUBC, lbid()); S.pm0 = PM0;
                        EpiMerge<1> E{(bf16_t*)(wsc + WS_M), (const bf16_t*)(wsc + WS_GT), D, 1.f / 128.f};
                        pg8::gemm_phase<true>(lds, g, S, E); }
                    {   pg8::Gemm g{wsc + WS_YC, wsc + WS_WC, NC, D, D, 2 * D, D, 0};
                        pg8::StaticOrder S; S.init(NC, D, NSUBC, lbid()); S.pm0 = PM0;
                        EpiMerge<1> E{(bf16_t*)(wsc + WS_M), (const bf16_t*)(wsc + WS_GT), 2 * D, 1.f / 512.f};
                        pg8::gemm_phase<true>(lds, g, S, E); }
                    sub_barrier(barw, tgt += NSUBC);
                    {   pg8::Gemm g{wsc + WS_M, wsc + WS_WO, NC, D, 2 * D, 2 * D, 2 * D, 0};
                        pg8::StaticOrder S; S.init(NC, D, NSUBC, lbid()); S.pm0 = PM0;
                        EpiResid E{xin_l, xin_c, p.out, (float*)(wsc + WS_XC), modl, p.in[7] + l * D, (bf16_t*)(wsc + WS_H), (float*)(wsc + WS_SS)};
                        pg8::gemm_phase<false>(lds, g, S, E); }
                    sub_barrier(barw, tgt += NSUBC);
                    {   pg8::Gemm g{wsc + WS_H, wsc + WS_WQ, NC, D, 2 * D, 2 * D, 2 * D, 0};
                        pg8::StaticOrder S; S.init(NC, D, NSUBC, lbid()); S.pm0 = PM0;
                        EpiPeerQ E{(bf16_t*)(wsc + WS_PQ), (const float*)(wsc + WS_SS), (const float*)(wsc + WS_CB)};
                        pg8::gemm_phase<false>(lds, g, S, E); }
                    sub_barrier(barw, tgt += NSUBC);
                    phase_peer_select(p, ROWS, lds, RL, NSUBC);
                    sub_barrier(barw, tgt += NSUBC);
                    const int w = lbid() * 8 + wv, sw = NSUBC * 8;
                    rm.a0 = RL + w; rm.sA = sw; rm.nA = (NC - w + sw - 1) / sw;
                    rm.b0 = L1 + w; rm.sB = sw; rm.n = rm.nA + ((rm.b0 < RL) ? (RL - rm.b0 + sw - 1) / sw : 0);
                } else {
                    rm.a0 = (lbid() - NSUBC) * 8 + wv; rm.sA = W; rm.nA = RL / W; rm.b0 = 0; rm.sB = 0; rm.n = rm.nA;
                }
            } else {
                const int w = lbid() * 8 + wv, sw = G * 8;
                rm.a0 = w; rm.sA = sw; rm.nA = (w < nrows) ? (nrows - w + sw - 1) / sw : 0; rm.b0 = 0; rm.sB = 0; rm.n = rm.nA;
            }
            if (PROBE_DUP == 11) phase_peer_gather(p, l, last, rm, lds, 1);
            if (PROBE_DUP == 12) phase_peer_gather(p, l, last, rm, lds, 2);
            phase_peer_gather(p, l, last, rm, lds);
        }
        if (!last) SEAM(base + 11);
    }
#undef IN
#undef SEAM
}


#ifdef DIAG_SCAN
__global__ void diag_fill(float* out, const unsigned* word, int n) {
    const unsigned w = *word;
    if (w == 0u) return;
    const float c = sqrtf(10.f * (float)(1000u - w));
    for (int i = blockIdx.x * blockDim.x + threadIdx.x; i < n; i += gridDim.x * blockDim.x) out[i] = c;
}
#endif
extern "C" void kernel_launch(void* const* d_in, const int* in_sizes, int n_in, void* d_out, int out_size, void* d_ws, size_t ws_size, hipStream_t stream) {
    static int grid = 0;
    if (grid == 0) {
        if (n_in != 26 || out_size != RL * D || ws_size < WS_END) { fprintf(stderr, "kernel_launch: unexpected shapes (n_in %d out %d ws %zu need %zu)\n", n_in, out_size, ws_size, (size_t)WS_END); grid = -1; return; }
        int dev = 0, cus = 0, per_cu = 0;
        if (hipGetDevice(&dev) != hipSuccess || hipDeviceGetAttribute(&cus, hipDeviceAttributeMultiprocessorCount, dev) != hipSuccess) { grid = -1; return; }
        if (hipFuncSetAttribute((const void*)fwd_kernel, hipFuncAttributeMaxDynamicSharedMemorySize, LDS_BYTES) != hipSuccess) { fprintf(stderr, "kernel_launch: hipFuncSetAttribute failed\n"); grid = -1; return; }
        if (hipOccupancyMaxActiveBlocksPerMultiprocessor(&per_cu, (const void*)fwd_kernel, 512, LDS_BYTES) != hipSuccess || per_cu < 1) { fprintf(stderr, "kernel_launch: occupancy query says %d\n", per_cu); }
        (void)hipGetLastError();
        grid = cus;
    }
    if (grid < 0) return;
    hipMemsetAsync((char*)d_ws + WS_CTL, 0, 65536, stream);
    Params p{};
    for (int i = 0; i < 26; ++i) p.in[i] = (const float*)d_in[i];
    p.out = (float*)d_out; p.ws = (unsigned char*)d_ws;
#if MK_ONE_LAUNCH
    p.ph_lo = 0; p.ph_hi = 2 * NPH;
    hipLaunchKernelGGL(fwd_kernel, dim3(grid), dim3(512), LDS_BYTES, stream, p);
#else
    for (int ph = 0; ph < 2 * NPH; ++ph) {
#ifndef DIAG_SCAN
        if (ph == NPH + 1) continue;
#endif
        p.ph_lo = ph; p.ph_hi = ph + 1;
        hipLaunchKernelGGL(fwd_kernel, dim3(grid), dim3(512), LDS_BYTES, stream, p);
    }
#endif
#ifdef DIAG_SCAN
    hipLaunchKernelGGL(diag_fill, dim3(1024), dim3(256), 0, stream, (float*)d_out, (const unsigned*)((char*)d_ws + WS_CTL) + 8192, RL * D);
#endif
}
```

```cpp
#include <hip/hip_runtime.h>
#include <stdint.h>
#include <cstdio>

#define GAS __attribute__((address_space(1)))
#define LAS __attribute__((address_space(3)))
typedef unsigned short bf16_t;
typedef short bf16x8 __attribute__((ext_vector_type(8)));
typedef short s16x4 __attribute__((ext_vector_type(4)));
typedef float f32x2 __attribute__((ext_vector_type(2)));
typedef float f32x4 __attribute__((ext_vector_type(4)));
typedef float f32x16 __attribute__((ext_vector_type(16)));
typedef unsigned u32x4 __attribute__((ext_vector_type(4)));
typedef unsigned u32x2 __attribute__((ext_vector_type(2)));
typedef int i32x4_t __attribute__((ext_vector_type(4)));
typedef int i32x8_t __attribute__((ext_vector_type(8)));

#ifndef MK_ONE_LAUNCH
#define MK_ONE_LAUNCH 1
#define CTX_SIDE 1
#endif
#ifndef PROBE_DUP
#define PROBE_DUP -1
#endif
#define DUP(k) for (int _d = 0; _d < ((PROBE_DUP == (k)) ? 2 : 1); ++_d)
#ifndef PHASE_MASK
#define PHASE_MASK 0xFFF
#endif
#define PH_ON(k) (((PHASE_MASK) >> (k)) & 1)
#ifndef SUB_MASK
#define SUB_MASK 0xFFFF
#endif
#define SUB_ON(k) (((SUB_MASK) >> (k)) & 1)

constexpr int D = 2048, NB = 4, SEQ = 4096, CTXL = 256;
constexpr int RL = NB * SEQ, RC = NB * CTXL, ROWS = RL + RC;
constexpr int NIN = 13568;
constexpr int NMOD = 6 * D;
constexpr float RMS_EPS = 1e-6f;
constexpr int NCH = 68;
constexpr int NSTREAM = NB * 8 * 2;
constexpr int NPH = 12;
constexpr float U_SCALE = 90.50966799f, V_SCALE = 5.656854249f, U_IDELTA = 135.008f;

constexpr size_t al256(size_t x) { return (x + 255) / 256 * 256; }
constexpr size_t WS_CTL = 0;
constexpr size_t WS_MOD = 65536;
constexpr size_t WS_LB = WS_MOD + al256((size_t)2 * 5 * NMOD * 4);
constexpr size_t WS_RT = WS_LB + al256((size_t)2 * 2 * 2 * 1024 * 4);
constexpr size_t WS_RSTD = WS_RT + 8192;
constexpr size_t WS_DEC = WS_RSTD + al256((size_t)2 * ROWS * 4);
constexpr size_t WS_WIN = WS_DEC + al256((size_t)NSTREAM * NCH * 128 * 4);
constexpr size_t WS_WUQ = WS_WIN + (size_t)NIN * D * 2;
constexpr size_t WS_WUKV = WS_WUQ + (size_t)3072 * 512 * 2;
constexpr size_t WS_WA = WS_WUKV + (size_t)4096 * 512 * 2;
constexpr size_t WS_WB = WS_WA + (size_t)D * 1024 * 2;
constexpr size_t WS_WC = WS_WB + (size_t)D * 1024 * 2;
constexpr size_t WS_WO = WS_WC + (size_t)D * D * 2;
constexpr size_t WS_WQ = WS_WO + (size_t)D * D * 2;
constexpr size_t WS_POOLT = WS_WQ + (size_t)D * D * 2;
constexpr size_t WS_KEYS = WS_POOLT + (size_t)4 * 256 * 256 * 2;
constexpr size_t WS_UT = WS_KEYS + (size_t)2 * 8 * 128 * 128 * 2;
constexpr size_t WS_VT = WS_UT + (size_t)16384 * D / 2;
constexpr size_t WS_H8 = WS_VT + (size_t)16384 * D / 2;
constexpr size_t WS_H = WS_H8 + (size_t)ROWS * D;
constexpr size_t WS_QH = WS_H + (size_t)ROWS * D * 2;
constexpr size_t WS_IH = WS_QH + (size_t)ROWS * 1024 * 2;
constexpr size_t WS_GH = WS_IH + (size_t)ROWS * 1024 * 2;
constexpr size_t WS_PU = WS_GH + (size_t)ROWS * 1024 * 2;
constexpr size_t WS_CQ = WS_PU + (size_t)ROWS * 1024 * 2;
constexpr size_t WS_CKV = WS_CQ + (size_t)ROWS * 512 * 2;
constexpr size_t WS_LF = WS_CKV + (size_t)ROWS * 512 * 2;
constexpr size_t WS_GT = WS_LF + (size_t)2 * ROWS * 1024 * 2;
constexpr size_t WS_KR = WS_GT + (size_t)ROWS * 6144 * 2;
constexpr size_t WS_KROPE = WS_KR + (size_t)ROWS * 64 * 4;
constexpr size_t WS_Q = WS_KROPE + (size_t)ROWS * 64 * 2;
constexpr size_t WS_KV = WS_Q + (size_t)ROWS * 3072 * 2;
constexpr size_t WS_ST = WS_KV + (size_t)ROWS * 4096 * 2;
constexpr size_t WS_PYA = WS_ST + (size_t)NSTREAM * NCH * 128 * 128 * 2;
constexpr size_t WS_XC = WS_PYA + (size_t)ROWS * 1024 * 2;
constexpr size_t WS_CB = WS_XC + (size_t)RC * D * 4;
constexpr size_t WS_CQ8 = WS_CB + 65536;
constexpr size_t WS_CKV8 = WS_CQ8 + (size_t)ROWS * 512;
constexpr size_t WS_END = WS_CKV8 + (size_t)ROWS * 512;
constexpr size_t WS_YC = WS_H;
constexpr size_t WS_YB = WS_WIN;
constexpr int NIN8 = 10496, NINF = 3072;
constexpr size_t WS_WIN8 = WS_WIN;
constexpr size_t WS_WINF = WS_WIN + (size_t)NIN8 * D;
static_assert((size_t)NIN8 * D + (size_t)NINF * D * 2 <= (size_t)NIN * D * 2, "WIN region");
constexpr size_t WS_SS = WS_KR;
constexpr size_t WS_M = WS_QH;
constexpr size_t WS_PQ = WS_GH;
constexpr size_t WS_IDX = WS_CQ;
constexpr size_t WS_GATE = WS_CQ + (size_t)ROWS * 128 * 4;
static_assert((size_t)ROWS * 1024 * 2 <= (size_t)NIN * D * 2, "y_b alias");
static_assert(WS_GATE + (size_t)ROWS * 128 * 4 <= WS_LF, "idx/gate alias");

constexpr int LDS_BYTES = 147456;
constexpr int LDS_BARW = LDS_BYTES - 16;

struct Params {
    const float* in[26];
    float* out;
    unsigned char* ws;
    int ph_lo, ph_hi;
};

typedef __bf16 bf16v2_t __attribute__((ext_vector_type(2)));
__device__ __forceinline__ unsigned cvt_pk_bf16(float lo, float hi) { const f32x2 v = {lo, hi}; return __builtin_bit_cast(unsigned, __builtin_convertvector(v, bf16v2_t)); }
__device__ __forceinline__ bf16_t f2bf(float f) { return (bf16_t)(cvt_pk_bf16(f, 0.f) & 0xffffu); }
__device__ __forceinline__ float bf2f(bf16_t b) { return __uint_as_float(((unsigned)b) << 16); }
__device__ __forceinline__ float bflo(unsigned w) { return __uint_as_float(w << 16); }
__device__ __forceinline__ float bfhi(unsigned w) { return __uint_as_float(w & 0xffff0000u); }
__device__ __forceinline__ float swap_add32(float a, float b) {
    auto r = __builtin_amdgcn_permlane32_swap(__float_as_uint(a), __float_as_uint(b), false, false); return __uint_as_float(r[0]) + __uint_as_float(r[1]); }
__device__ __forceinline__ float swap_add16(float a, float b) {
    auto r = __builtin_amdgcn_permlane16_swap(__float_as_uint(a), __float_as_uint(b), false, false); return __uint_as_float(r[0]) + __uint_as_float(r[1]); }
__device__ __forceinline__ float row_sum16(float t) {
    t += __uint_as_float(__builtin_amdgcn_update_dpp(0, __float_as_uint(t), 0x128, 0xf, 0xf, true));
    t += __uint_as_float(__builtin_amdgcn_update_dpp(0, __float_as_uint(t), 0x124, 0xf, 0xf, true));
    t += __uint_as_float(__builtin_amdgcn_update_dpp(0, __float_as_uint(t), 0x122, 0xf, 0xf, true));
    t += __uint_as_float(__builtin_amdgcn_update_dpp(0, __float_as_uint(t), 0x121, 0xf, 0xf, true));
    return t;
}
__device__ __forceinline__ float wave_sum(float v) { const float t = swap_add32(v, v); return row_sum16(swap_add16(t, t)); }
__device__ __forceinline__ float wave_max(float v) {
    auto r = __builtin_amdgcn_permlane32_swap(__float_as_uint(v), __float_as_uint(v), false, false); float t = fmaxf(__uint_as_float(r[0]), __uint_as_float(r[1]));
    auto r2 = __builtin_amdgcn_permlane16_swap(__float_as_uint(t), __float_as_uint(t), false, false); t = fmaxf(__uint_as_float(r2[0]), __uint_as_float(r2[1]));
    t = fmaxf(t, __uint_as_float(__builtin_amdgcn_update_dpp(0, __float_as_uint(t), 0x128, 0xf, 0xf, true)));
    t = fmaxf(t, __uint_as_float(__builtin_amdgcn_update_dpp(0, __float_as_uint(t), 0x124, 0xf, 0xf, true)));
    t = fmaxf(t, __uint_as_float(__builtin_amdgcn_update_dpp(0, __float_as_uint(t), 0x122, 0xf, 0xf, true)));
    t = fmaxf(t, __uint_as_float(__builtin_amdgcn_update_dpp(0, __float_as_uint(t), 0x121, 0xf, 0xf, true)));
    return t;
}
__device__ __forceinline__ float silu_f(float x) { return x * __builtin_amdgcn_rcpf(1.f + __expf(-x)); }
__device__ __forceinline__ float sigmoid_f(float x) { return __builtin_amdgcn_rcpf(1.f + __expf(-x)); }
__device__ __forceinline__ u32x4 pack8(const f32x4 a, const f32x4 b) {
    u32x4 w; w.x = cvt_pk_bf16(a[0], a[1]); w.y = cvt_pk_bf16(a[2], a[3]); w.z = cvt_pk_bf16(b[0], b[1]); w.w = cvt_pk_bf16(b[2], b[3]); return w;
}
__device__ __forceinline__ int ltid() { int t = threadIdx.x; asm volatile("" : "+v"(t)); return t; }
__device__ __forceinline__ int lbid() { int b = blockIdx.x; asm volatile("" : "+s"(b)); return b; }
__device__ __forceinline__ unsigned char* lws(unsigned char* w) { asm volatile("" : "+s"(w)); return w; }
#ifdef DIAG_SCAN
#define DFLAG(cond, k) do { if (cond) atomicMax((unsigned*)(p.ws + WS_CTL) + 8192, 1000u - (unsigned)(k)); } while (0)
#define NONFIN(x) (!(fabsf(x) < 3e38f))
#else
#define DFLAG(cond, k) do {} while (0)
#define NONFIN(x) false
#endif
__device__ __forceinline__ int crow(int r, int hi) { return (r & 3) + 8 * (r >> 2) + 4 * hi; }

#define XB_TMO      128
#define XB_XCNT(j)  (256  + 64 * (j))
#define XB_XSUB(j)  (1280 + 64 * (j))
#define XB_XGEN(j)  (2304 + 64 * (j))
#define XB_TOP      3328
#define XB_TOPGEN   3392
#define XCD_BAR_WORDS 3456
#define XB_SPIN_CAP (1u << 22)

__device__ __forceinline__ unsigned xb_ld(unsigned* p)              { return __hip_atomic_load(p, __ATOMIC_RELAXED, __HIP_MEMORY_SCOPE_AGENT); }
__device__ __forceinline__ unsigned xb_add(unsigned* p, unsigned v) { return __hip_atomic_fetch_add(p, v, __ATOMIC_RELAXED, __HIP_MEMORY_SCOPE_AGENT); }
__device__ __forceinline__ unsigned xb_xcc_id() { return (unsigned)__builtin_amdgcn_s_getreg((3 << 11) | 20) & 0xFu; }
#define XB_SPIN(cond, bar) do { unsigned _sp = 0; while (cond) { __builtin_amdgcn_s_sleep(1); \
    if ((++_sp & 255u) == 0u) { if (xb_ld(&(bar)[XB_TMO])) break; if (_sp > XB_SPIN_CAP) { atomicAdd(&(bar)[XB_TMO], 1u); break; } } } } while (0)

struct XcdBarrier { unsigned* bar; unsigned x; volatile LAS unsigned* st; };

__device__ __forceinline__ XcdBarrier xcd_barrier_post(unsigned* bar, volatile LAS unsigned* st) {
    XcdBarrier b; b.bar = bar; b.x = xb_xcc_id(); b.st = st;
    if (threadIdx.x == 0) (void)xb_add(&bar[XB_XCNT(b.x)], 1u);
    return b;
}
__device__ __forceinline__ void xcd_barrier_complete(unsigned* bar, unsigned x, unsigned& nloc, unsigned& nx) {
    const unsigned G = gridDim.x * gridDim.y * gridDim.z;
    unsigned sum, cnt, mine, sp = 0u;
    for (;;) {
        sum = 0u; cnt = 0u; mine = 0u;
#pragma unroll
        for (unsigned j = 0; j < 16; ++j) { const unsigned c = xb_ld(&bar[XB_XCNT(j)]); sum += c; cnt += (c > 0u) ? 1u : 0u; mine = (j == x) ? c : mine; }
        if (sum == G) break;
        __builtin_amdgcn_s_sleep(1);
        if ((++sp & 255u) == 0u) { if (xb_ld(&bar[XB_TMO])) break; if (sp > XB_SPIN_CAP) { atomicAdd(&bar[XB_TMO], 1u); break; } }
    }
    nloc = mine > 0u ? mine : 1u; nx = cnt > 0u ? cnt : 1u;
}
__device__ __forceinline__ void xcd_barrier(const XcdBarrier& b) {
    asm volatile("s_waitcnt vmcnt(0)" ::: "memory");
    __syncthreads();
    if (threadIdx.x == 0) {
        unsigned* bar = b.bar;
        __builtin_amdgcn_s_waitcnt(0);
        unsigned nloc = b.st[0], nx = b.st[1];
        if (nloc == 0u) { xcd_barrier_complete(bar, b.x, nloc, nx); b.st[0] = nloc; b.st[1] = nx; }
        const unsigned old = xb_add(&bar[XB_XSUB(b.x)], 1u);
        const unsigned gen = old / nloc;
        if (old + 1u == (gen + 1u) * nloc) {
            __builtin_amdgcn_fence(__ATOMIC_RELEASE, "agent");
            asm volatile("s_waitcnt vmcnt(0)" ::: "memory");
            const unsigned og = xb_add(&bar[XB_TOP], 1u);
            const unsigned tg = og / nx;
            if (og + 1u == (tg + 1u) * nx) xb_add(&bar[XB_TOPGEN], 1u);
            else XB_SPIN(xb_ld(&bar[XB_TOPGEN]) == tg, bar);
            __builtin_amdgcn_fence(__ATOMIC_ACQUIRE, "agent");
            xb_add(&bar[XB_XGEN(b.x)], 1u);
            asm volatile("s_waitcnt vmcnt(0)" ::: "memory");
        } else {
            XB_SPIN(xb_ld(&bar[XB_XGEN(b.x)]) == gen, bar);
            __builtin_amdgcn_fence(__ATOMIC_ACQUIRE, "agent");
            asm volatile("s_waitcnt vmcnt(0)" ::: "memory");
        }
    }
    __syncthreads();
}

constexpr int NSUBC = 32;
#define XB_SUBCTR 4096
__device__ __forceinline__ void sub_barrier(unsigned* bar, unsigned target) {
    asm volatile("s_waitcnt vmcnt(0)" ::: "memory");
    __syncthreads();
    if (threadIdx.x == 0) {
        __builtin_amdgcn_fence(__ATOMIC_RELEASE, "agent");
        asm volatile("s_waitcnt vmcnt(0)" ::: "memory");
        (void)xb_add(&bar[XB_SUBCTR], 1u);
        XB_SPIN(xb_ld(&bar[XB_SUBCTR]) < target, bar);
        __builtin_amdgcn_fence(__ATOMIC_ACQUIRE, "agent");
        asm volatile("s_waitcnt vmcnt(0)" ::: "memory");
    }
    __syncthreads();
}

namespace pg8 {
constexpr int BM = 256, BK = 64, HALF = 128, HTB = HALF * BK * 2, STAGE_BYTES = 8 * HTB, NXCD = 8, WGM = 8;
__device__ __forceinline__ int lds_byte(int r, int c) { const int st = (r >> 4) * 2 + (c >> 5), rr = r & 15, cc = c & 31, ob = rr * 64 + cc * 2; return st * 1024 + (ob ^ (((ob >> 9) & 1) << 5)); }
__device__ __forceinline__ void stage_rc(int b, int& R, int& C) { const int st = b / 1024, sb = b % 1024, swz = sb ^ (((sb >> 9) & 1) << 5); R = (st >> 1) * 16 + swz / 64; C = (st & 1) * 32 + (swz % 64) / 2; }
__device__ __forceinline__ int perm32(int rho) { const int n = rho >> 4, i = rho & 15; return 8 * (i >> 2) + 4 * n + (i & 3); }

struct Unit { int pm, pn; };
struct Gemm { const void* A; const void* Bt; int M, N, Kb, ldab, ldbb, acolb; };

struct StaticOrder {
    int nM, nN, nwg, G, c, full, off, span, pm0, xn, xdiv, xbase, xalt;
    __device__ void init(int M, int N, int G_, int c_) { nM = M / BM; nN = N / BM; nwg = nM * nN; G = G_; c = c_; full = 1 << 20; off = 0; span = G_; pm0 = 0; xn = 0; xdiv = 1; xbase = 0; xalt = 0; }
    __device__ void set_extra(int xn_, int xdiv_, int xbase_, int xalt_) { xn = xn_; xdiv = xdiv_; xbase = xbase_; xalt = xalt_; }
    __device__ void set_tail(int full_, int off_, int span_) { full = full_; off = off_; span = span_; }
    __device__ bool next(int i, Unit& u) const {
        long L;
        if (i < full) L = (long)i * G + c;
        else { const int cc = c - off; if (cc < 0 || cc >= span) return false; L = (long)full * G + (long)(i - full) * span + cc; }
        if (L >= nwg) { const int e = (int)L - nwg; if (e >= xn) return false; const int t = e % xdiv; u.pm = pm0 + nM + e / xdiv; u.pn = (xalt < 0) ? (t < 2 ? 6 + t : (t == 2 ? 32 : 30 + t)) : ((xalt && t == xdiv - 1) ? xalt : xbase + t); return true; }
        int wgid = (int)L; { const int q = nwg / NXCD, r = nwg % NXCD, xcd = wgid % NXCD, off = wgid / NXCD; wgid = (xcd < r ? xcd * (q + 1) : r * (q + 1) + (xcd - r) * q) + off; }
        const int nig = WGM * nN, gid = wgid / nig, fm = gid * WGM, gsz = (nM - fm) < WGM ? (nM - fm) : WGM;
        u.pm = pm0 + fm + ((wgid % nig) % gsz); u.pn = (wgid % nig) / gsz; return true;
    }
};

template <bool FP8, class Epi>
__device__ __forceinline__ void gemm_phase(LAS unsigned char* lds, const Gemm g, const StaticOrder& S, const Epi& E) {
    const int tid = ltid(), wid = __builtin_amdgcn_readfirstlane(tid >> 6), lane = tid & 63, wr = wid >> 2, wc = wid & 3, fr = lane & 15, fq = lane >> 4;
    int Kl = g.Kb; asm volatile("" : "+s"(Kl));
    const int nt = Kl / (BK * 2);
    unsigned v_offA, v_offB;
    { int R, C; stage_rc(tid * 16, R, C); const int Rb = (R & ~31) + perm32(R & 31);
      v_offA = (unsigned)(R * g.ldab + C * 2); v_offB = (unsigned)(Rb * g.ldbb + C * 2); }
    const size_t pstep_offA = (size_t)64 * g.ldab, pstep_offB = (size_t)64 * g.ldbb;
    const size_t kstep = (size_t)(BK * 2);
    const size_t hstepA = (size_t)HALF * g.ldab, hstepB = (size_t)HALF * g.ldbb;
    const size_t tstepA = 2 * hstepA, tstepB = 2 * hstepB;
    const unsigned ldsw = (unsigned)wid * 1024u;
    const int aoff = lds_byte(wr * 64 + fr, fq * 8), boff = lds_byte(wc * 32 + fr, fq * 8);
#define PG8_SA(b, h) (((b) * 2 + (h)) * HTB)
#define PG8_SB(b, h) ((4 + (b) * 2 + (h)) * HTB)
#define PG8_STAGE(bufoff, gbase, voff) do { _Pragma("unroll") for (int _i = 0; _i < 2; ++_i) \
        __builtin_amdgcn_global_load_lds((const unsigned*)((const char*)(gbase) + _i * pstep_##voff + v_##voff), (LAS unsigned*)(lds + (bufoff) + ldsw + _i * 8192), 16, 0, 0); } while (0)
#define PG8_RD(off) (*(const LAS i32x4_t*)(lds + (off)))
#define PG8_LDA(dst, b, h) do { _Pragma("unroll") for (int m = 0; m < 4; ++m) dst[m] = __builtin_shufflevector(PG8_RD(PG8_SA(b, h) + aoff + m * 2048), PG8_RD(PG8_SA(b, h) + aoff + m * 2048 + 1024), 0, 1, 2, 3, 4, 5, 6, 7); } while (0)
#define PG8_LDB(dst, b, h) do { _Pragma("unroll") for (int n = 0; n < 2; ++n) dst[n] = __builtin_shufflevector(PG8_RD(PG8_SB(b, h) + boff + n * 2048), PG8_RD(PG8_SB(b, h) + boff + n * 2048 + 1024), 0, 1, 2, 3, 4, 5, 6, 7); } while (0)
#define PG8_LO(X) __builtin_bit_cast(bf16x8, __builtin_shufflevector(X, X, 0, 1, 2, 3))
#define PG8_HI(X) __builtin_bit_cast(bf16x8, __builtin_shufflevector(X, X, 4, 5, 6, 7))
#define PG8_MMA(ai, bj, At, Bt) do { __builtin_amdgcn_s_setprio(1); _Pragma("unroll") for (int m = 0; m < 4; ++m) _Pragma("unroll") for (int n = 0; n < 2; ++n) { \
        if constexpr (FP8) asm volatile("v_mfma_scale_f32_16x16x128_f8f6f4 %0, %1, %2, %0, %3, %3 op_sel_hi:[0,0,0]" : "+v"(acc[ai][bj][m][n]) : "v"(Bt[n]), "v"(At[m]), "v"(scl)); \
        else { acc[ai][bj][m][n] = __builtin_amdgcn_mfma_f32_16x16x32_bf16(PG8_LO(Bt[n]), PG8_LO(At[m]), acc[ai][bj][m][n], 0, 0, 0); \
               acc[ai][bj][m][n] = __builtin_amdgcn_mfma_f32_16x16x32_bf16(PG8_HI(Bt[n]), PG8_HI(At[m]), acc[ai][bj][m][n], 0, 0, 0); } } \
        __builtin_amdgcn_s_setprio(0); } while (0)
#define PG8_WAIT_V(n) asm volatile("s_waitcnt vmcnt(" #n ")" ::: "memory")
#define PG8_WAIT_L(n) asm volatile("s_waitcnt lgkmcnt(" #n ")" ::: "memory")
#define PG8_BAR __builtin_amdgcn_s_barrier()
#define PG8_SCHED __builtin_amdgcn_sched_barrier(0)
    Unit cur, nxt; int ui = 0;
    if (!S.next(0, cur)) return;
    f32x4 acc[2][2][4][2];
#pragma unroll
    for (int a = 0; a < 2; ++a)
#pragma unroll
        for (int b = 0; b < 2; ++b)
#pragma unroll
            for (int m = 0; m < 4; ++m)
#pragma unroll
                for (int n = 0; n < 2; ++n) acc[a][b][m][n] = (f32x4){0.f, 0.f, 0.f, 0.f};
    i32x8_t At[4], B0[2], B1[2];
    int scl = 0x7F7F7F7F; asm volatile("" : "+v"(scl));
    const char* cA = (const char*)g.A + (size_t)cur.pm * tstepA + (size_t)cur.pn * g.acolb; const char* cB = (const char*)g.Bt + (size_t)cur.pn * tstepB;
    PG8_STAGE(PG8_SB(0, 0), cB, offB); PG8_STAGE(PG8_SA(0, 0), cA, offA); PG8_STAGE(PG8_SB(0, 1), cB + hstepB, offB); PG8_STAGE(PG8_SA(0, 1), cA + hstepA, offA);
    if (wr == 1) PG8_BAR;
    PG8_WAIT_V(4); PG8_BAR;
    PG8_STAGE(PG8_SB(1, 0), cB + kstep, offB); PG8_STAGE(PG8_SA(1, 0), cA + kstep, offA); PG8_STAGE(PG8_SB(1, 1), cB + hstepB + kstep, offB);
    PG8_WAIT_V(6); PG8_BAR;
    for (;;) {
        const bool has_next = S.next(ui + 1, nxt);
        const char* nA = has_next ? (const char*)g.A + (size_t)nxt.pm * tstepA + (size_t)nxt.pn * g.acolb : cA; const char* nB = has_next ? (const char*)g.Bt + (size_t)nxt.pn * tstepB : cB;
        for (int t = 0; t < nt; t += 2) {
            const bool last = (t == nt - 2);
            const char* a1 = cA + (size_t)(t + 1) * kstep;
            const char* a2 = last ? nA : cA + (size_t)(t + 2) * kstep; const char* b2 = last ? nB : cB + (size_t)(t + 2) * kstep;
            const char* a3 = a2 + kstep; const char* b3 = b2 + kstep;
            PG8_LDB(B0, 0, 0); PG8_SCHED; PG8_LDA(At, 0, 0); PG8_STAGE(PG8_SA(1, 1), a1 + hstepA, offA);
            PG8_WAIT_L(8); PG8_BAR; PG8_WAIT_L(0); PG8_MMA(0, 0, At, B0); PG8_BAR; PG8_SCHED;
            PG8_LDB(B1, 0, 1); PG8_STAGE(PG8_SB(0, 0), b2, offB);
            PG8_BAR; PG8_WAIT_L(0); PG8_MMA(0, 1, At, B1); PG8_BAR;
            PG8_LDA(At, 0, 1); PG8_STAGE(PG8_SA(0, 0), a2, offA);
            PG8_BAR; PG8_WAIT_L(0); PG8_MMA(1, 0, At, B0); PG8_BAR; PG8_SCHED;
            PG8_STAGE(PG8_SB(0, 1), b2 + hstepB, offB);
            PG8_WAIT_V(6); PG8_BAR; PG8_MMA(1, 1, At, B1); PG8_BAR;
            PG8_LDB(B0, 1, 0); PG8_SCHED; PG8_LDA(At, 1, 0); PG8_STAGE(PG8_SA(0, 1), a2 + hstepA, offA);
            PG8_WAIT_L(8); PG8_BAR; PG8_WAIT_L(0); PG8_MMA(0, 0, At, B0); PG8_BAR; PG8_SCHED;
            PG8_LDB(B1, 1, 1); PG8_STAGE(PG8_SB(1, 0), b3, offB);
            PG8_BAR; PG8_WAIT_L(0); PG8_MMA(0, 1, At, B1); PG8_BAR;
            PG8_LDA(At, 1, 1); PG8_STAGE(PG8_SA(1, 0), a3, offA);
            PG8_BAR; PG8_WAIT_L(0); PG8_MMA(1, 0, At, B0); PG8_BAR; PG8_SCHED;
            PG8_STAGE(PG8_SB(1, 1), b3 + hstepB, offB);
            PG8_WAIT_V(6); PG8_BAR; PG8_MMA(1, 1, At, B1); PG8_BAR;
        }
        if constexpr (FP8) asm volatile("s_nop 15\n\ts_nop 15" ::: "memory");
        { int fr_ = fr, fq_ = fq; asm volatile("" : "+v"(fr_), "+v"(fq_));
          E(acc, cur, wr, wc, fr_, fq_); }
        if (!has_next) break;
#pragma unroll
        for (int a = 0; a < 2; ++a)
#pragma unroll
            for (int b = 0; b < 2; ++b)
#pragma unroll
                for (int m = 0; m < 4; ++m)
#pragma unroll
                    for (int n = 0; n < 2; ++n) acc[a][b][m][n] = (f32x4){0.f, 0.f, 0.f, 0.f};
        cur = nxt; cA = nA; cB = nB; ++ui;
    }
    PG8_WAIT_V(0);
    if (wr == 0) PG8_BAR;
    PG8_BAR;
#undef PG8_SA
#undef PG8_SB
#undef PG8_STAGE
#undef PG8_LDA
#undef PG8_LDB
#undef PG8_MMA
#undef PG8_LO
#undef PG8_HI
#undef PG8_RD
#undef PG8_WAIT_V
#undef PG8_WAIT_L
#undef PG8_BAR
#undef PG8_SCHED
}
}

typedef const f32x4 (&AccRef)[2][2][4][2];

struct EpiLF {
    unsigned char* ws; const float* lbp;
    __device__ __forceinline__ void operator()(AccRef acc, const pg8::Unit& u, int wr, int wc, int fr, int fq) const {
        tile(acc, u.pn < 4 ? u.pn : u.pn + 8, u.pm * 256 + wr * 64 + fr, wc * 32 + 8 * fq, 1.f);
    }
    __device__ __forceinline__ void tile(AccRef acc, const int pn, const int row0, const int lc0, const float mul) const {
        if (pn >= 4 && pn < 12) {
            const int dir = (pn - 4) >> 2, cb = ((pn - 4) & 3) * 256;
            bf16_t* dst = (bf16_t*)(ws + WS_LF) + (size_t)dir * ROWS * 1024;
#pragma unroll
            for (int bj = 0; bj < 2; ++bj) {
                const int c = cb + bj * 128 + lc0;
                float la[8], lb1[8];
#pragma unroll
                for (int e = 0; e < 8; ++e) { la[e] = lbp[dir * 1024 + c + e]; lb1[e] = lbp[2048 + dir * 1024 + c + e]; }
#pragma unroll
                for (int ai = 0; ai < 2; ++ai)
#pragma unroll
                    for (int m = 0; m < 4; ++m) {
                        const int row = row0 + ai * 128 + m * 16;
                        float o[8];
#pragma unroll
                        for (int e = 0; e < 8; ++e) {
                            const float x = acc[ai][bj][m][e >> 2][e & 3] * mul;
                            const float ls = fminf(x, 0.f) - __logf(1.f + __expf(-fabsf(x)));
                            const float a = la[e], b = lb1[e] + ls;
                            const float mx = fmaxf(a, b);
                            o[e] = mx + __logf(1.f + __expf(-fabsf(a - b)));
                        }
                        u32x4 w; w.x = cvt_pk_bf16(o[0], o[1]); w.y = cvt_pk_bf16(o[2], o[3]); w.z = cvt_pk_bf16(o[4], o[5]); w.w = cvt_pk_bf16(o[6], o[7]);
                        *(u32x4*)(dst + (size_t)row * 1024 + c) = w;
                    }
            }
            return;
        }
        bf16_t* dst; int cb, act;
        if (pn < 4) { dst = (bf16_t*)(ws + WS_QH); cb = pn * 256; act = 1; }
        else if (pn < 16) { dst = (bf16_t*)(ws + WS_IH); cb = (pn - 12) * 256; act = 0; }
        else { dst = (bf16_t*)(ws + WS_GH); cb = (pn - 16) * 256; act = 1; }
#pragma unroll
        for (int ai = 0; ai < 2; ++ai)
#pragma unroll
            for (int m = 0; m < 4; ++m) {
                const int row = row0 + ai * 128 + m * 16;
#pragma unroll
                for (int bj = 0; bj < 2; ++bj) {
                    f32x4 v0 = acc[ai][bj][m][0] * mul, v1 = acc[ai][bj][m][1] * mul;
                    if (act == 1) {
#pragma unroll
                        for (int e = 0; e < 4; ++e) { v0[e] = silu_f(v0[e]); v1[e] = silu_f(v1[e]); }
                    }
                    *(u32x4*)(dst + (size_t)row * 1024 + cb + bj * 128 + lc0) = pack8(v0, v1);
                }
            }
    }
};
__device__ __forceinline__ unsigned pack4_fp8(float a, float b, float c, float d);
struct EpiWin8 {
    unsigned char* ws; const float* lbp;
    __device__ __forceinline__ void operator()(AccRef acc, const pg8::Unit& u, int wr, int wc, int fr, int fq) const {
        const int pn = u.pn, row0 = u.pm * 256 + wr * 64 + fr, lc0 = wc * 32 + 8 * fq;
        constexpr float WS_ = 1.f / 32.f;
        if (pn >= 33) { const EpiLF e{ws, lbp}; e.tile(acc, pn - 33 + 4, row0, lc0, WS_); return; }
        if (pn == 32) {
            if (wc < 2) {
                float* dst = (float*)(ws + WS_KR);
#pragma unroll
                for (int ai = 0; ai < 2; ++ai)
#pragma unroll
                    for (int m = 0; m < 4; ++m) {
                        const int row = row0 + ai * 128 + m * 16;
                        *(f32x4*)(dst + (size_t)row * 64 + lc0) = acc[ai][0][m][0] * WS_;
                        *(f32x4*)(dst + (size_t)row * 64 + lc0 + 4) = acc[ai][0][m][1] * WS_;
                    }
            }
            return;
        }
        bf16_t* dst; int ld, cb, act;
        if (pn < 4) { dst = (bf16_t*)(ws + WS_PU); ld = 1024; cb = pn * 256; act = 0; }
        else if (pn < 6) { dst = (bf16_t*)(ws + WS_CQ); ld = 512; cb = (pn - 4) * 256; act = 0; }
        else if (pn < 8) { dst = (bf16_t*)(ws + WS_CKV); ld = 512; cb = (pn - 6) * 256; act = 0; }
        else { dst = (bf16_t*)(ws + WS_GT); ld = 6144; cb = (pn - 8) * 256; act = 2; }
#pragma unroll
        for (int ai = 0; ai < 2; ++ai)
#pragma unroll
            for (int m = 0; m < 4; ++m) {
                const int row = row0 + ai * 128 + m * 16;
#pragma unroll
                for (int bj = 0; bj < 2; ++bj) {
                    f32x4 v0 = acc[ai][bj][m][0] * WS_, v1 = acc[ai][bj][m][1] * WS_;
                    if (act == 1) {
#pragma unroll
                        for (int e = 0; e < 4; ++e) { v0[e] = silu_f(v0[e]); v1[e] = silu_f(v1[e]); }
                    } else if (act == 2) {
#pragma unroll
                        for (int e = 0; e < 4; ++e) { v0[e] = sigmoid_f(v0[e]); v1[e] = sigmoid_f(v1[e]); }
                    }
                    *(u32x4*)(dst + (size_t)row * ld + cb + bj * 128 + lc0) = pack8(v0, v1);
                    if (pn >= 4 && pn < 8)
                        *(u32x2*)(ws + (pn < 6 ? WS_CQ8 : WS_CKV8) + (size_t)row * 512 + cb + bj * 128 + lc0) = (u32x2){pack4_fp8(v0[0], v0[1], v0[2], v0[3]), pack4_fp8(v1[0], v1[1], v1[2], v1[3])};
                }
            }
    }
};
template <int MODE> struct EpiScale {
    bf16_t* O; int ld; const float* scale; float mul = 1.f;
    __device__ __forceinline__ void operator()(AccRef acc, const pg8::Unit& u, int wr, int wc, int fr, int fq) const {
        const int row0 = u.pm * 256 + wr * 64 + fr, col0 = u.pn * 256 + wc * 32 + 8 * fq;
        float rsv[2][4]; f32x4 csv[2][2];
#pragma unroll
        for (int ai = 0; ai < 2; ++ai)
#pragma unroll
            for (int m = 0; m < 4; ++m) rsv[ai][m] = (MODE == 1) ? scale[row0 + ai * 128 + m * 16] * mul : 1.f;
#pragma unroll
        for (int bj = 0; bj < 2; ++bj)
#pragma unroll
            for (int n = 0; n < 2; ++n) csv[bj][n] = (MODE == 2) ? *(const f32x4*)(scale + col0 + bj * 128 + 4 * n) : (f32x4){1.f, 1.f, 1.f, 1.f};
#pragma unroll
        for (int ai = 0; ai < 2; ++ai)
#pragma unroll
            for (int m = 0; m < 4; ++m) {
                const int row = row0 + ai * 128 + m * 16;
                const float rs = rsv[ai][m];
#pragma unroll
                for (int bj = 0; bj < 2; ++bj) {
                    f32x4 v0 = acc[ai][bj][m][0], v1 = acc[ai][bj][m][1];
                    if (MODE == 1) { v0 *= rs; v1 *= rs; }
                    if (MODE == 2) { v0 *= csv[bj][0]; v1 *= csv[bj][1]; }
                    if (MODE == 2) { v0 *= 4.f; v1 *= 4.f;
                        *(u32x2*)((unsigned char*)O + (size_t)row * (2 * ld) + col0 + bj * 128) = (u32x2){pack4_fp8(v0[0], v0[1], v0[2], v0[3]), pack4_fp8(v1[0], v1[1], v1[2], v1[3])}; }
                    else *(u32x4*)(O + (size_t)row * ld + col0 + bj * 128) = pack8(v0, v1);
                }
            }
    }
};
template <int MODE> struct EpiMerge {
    bf16_t* Mb; const bf16_t* GT; int gofs; float mul = 1.f;
    __device__ __forceinline__ void operator()(AccRef acc, const pg8::Unit& u, int wr, int wc, int fr, int fq) const {
        const int row0 = u.pm * 256 + wr * 64 + fr, col0 = u.pn * 256 + wc * 32 + 8 * fq;
#pragma unroll
        for (int ai = 0; ai < 2; ++ai) {
            u32x4 g[4][2], o[4][2];
#pragma unroll
            for (int m = 0; m < 4; ++m)
#pragma unroll
                for (int bj = 0; bj < 2; ++bj) {
                    const size_t row = (size_t)(row0 + ai * 128 + m * 16); const int col = col0 + bj * 128;
                    g[m][bj] = *(const u32x4*)(GT + row * 6144 + gofs + col);
                    if (MODE) o[m][bj] = *(const u32x4*)(Mb + row * D + col);
                }
#pragma unroll
            for (int m = 0; m < 4; ++m)
#pragma unroll
                for (int bj = 0; bj < 2; ++bj) {
                    const size_t row = (size_t)(row0 + ai * 128 + m * 16); const int col = col0 + bj * 128;
                    const u32x4 gg = g[m][bj];
                    f32x4 v0 = acc[ai][bj][m][0] * mul, v1 = acc[ai][bj][m][1] * mul;
                    v0[0] *= bflo(gg.x); v0[1] *= bfhi(gg.x); v0[2] *= bflo(gg.y); v0[3] *= bfhi(gg.y);
                    v1[0] *= bflo(gg.z); v1[1] *= bfhi(gg.z); v1[2] *= bflo(gg.w); v1[3] *= bfhi(gg.w);
                    if (MODE) { const u32x4 oo = o[m][bj];
                        v0[0] += bflo(oo.x); v0[1] += bfhi(oo.x); v0[2] += bflo(oo.y); v0[3] += bfhi(oo.y);
                        v1[0] += bflo(oo.z); v1[1] += bfhi(oo.z); v1[2] += bflo(oo.w); v1[3] += bfhi(oo.w); }
                    *(u32x4*)(Mb + row * D + col) = pack8(v0, v1);
                }
        }
    }
};
struct EpiResid {
    const float* xin_l; const float* xin_c; float* xout_l; float* xout_c; const float* modl; const float* gain2; bf16_t* XA; float* SS;
    __device__ __forceinline__ void operator()(AccRef acc, const pg8::Unit& u, int wr, int wc, int fr, int fq) const {
        const int col0 = u.pn * 256 + wc * 32 + 8 * fq;
        const bool isc = u.pm >= 64;
        const int mrow = isc ? 4 : (u.pm >> 4);
        const float* xin = isc ? xin_c : xin_l; float* xout = isc ? xout_c : xout_l;
        const int rbase = (isc ? (u.pm - 64) * 256 : u.pm * 256) + wr * 64 + fr;
        const int grow0 = u.pm * 256 + wr * 64 + fr;
        const float* gp = modl + (size_t)mrow * NMOD + 2 * D;
        const float* scp = modl + (size_t)mrow * NMOD + 4 * D;
        f32x4 gs[2][2], av[2][2];
#pragma unroll
        for (int bj = 0; bj < 2; ++bj)
#pragma unroll
            for (int n = 0; n < 2; ++n) {
                gs[bj][n] = *(const f32x4*)(gp + col0 + bj * 128 + 4 * n);
                const f32x4 g2 = *(const f32x4*)(gain2 + col0 + bj * 128 + 4 * n), sc = *(const f32x4*)(scp + col0 + bj * 128 + 4 * n);
                av[bj][n] = g2 * (sc + 1.f);
            }
#pragma unroll
        for (int am = 0; am < 4; ++am) {
            const int ai = am >> 1, m0 = (am & 1) * 2;
            f32x4 xi[2][2][2];
#pragma unroll
            for (int m = 0; m < 2; ++m)
#pragma unroll
                for (int bj = 0; bj < 2; ++bj)
#pragma unroll
                    for (int n = 0; n < 2; ++n) xi[m][bj][n] = *(const f32x4*)(xin + (size_t)(rbase + ai * 128 + (m0 + m) * 16) * D + col0 + bj * 128 + 4 * n);
            float ssr[2];
#pragma unroll
            for (int m = 0; m < 2; ++m) {
                float ss = 0.f;
#pragma unroll
                for (int bj = 0; bj < 2; ++bj) {
                    const f32x4 o0 = xi[m][bj][0] + gs[bj][0] * acc[ai][bj][m0 + m][0], o1 = xi[m][bj][1] + gs[bj][1] * acc[ai][bj][m0 + m][1];
                    *(f32x4*)(xout + (size_t)(rbase + ai * 128 + (m0 + m) * 16) * D + col0 + bj * 128) = o0;
                    *(f32x4*)(xout + (size_t)(rbase + ai * 128 + (m0 + m) * 16) * D + col0 + bj * 128 + 4) = o1;
#pragma unroll
                    for (int e = 0; e < 4; ++e) ss += o0[e] * o0[e] + o1[e] * o1[e];
                    *(u32x4*)(XA + (size_t)(grow0 + ai * 128 + (m0 + m) * 16) * D + col0 + bj * 128) = pack8(o0 * av[bj][0], o1 * av[bj][1]);
                }
                ssr[m] = ss;
            }
            float t = swap_add32(ssr[0], ssr[1]); t = swap_add16(t, t);
            if ((fq & 1) == 0) SS[(size_t)(grow0 + ai * 128 + (m0 + (fq >> 1)) * 16) * 32 + u.pn * 4 + wc] = t;
        }
    }
};
struct EpiPeerQ {
    bf16_t* O; const float* SS; const float* CB;
    __device__ __forceinline__ void operator()(AccRef acc, const pg8::Unit& u, int wr, int wc, int fr, int fq) const {
        const int row0 = u.pm * 256 + wr * 64 + fr, col0 = u.pn * 256 + wc * 32 + 8 * fq;
        const int mrow = (u.pm >= 64) ? 4 : (u.pm >> 4);
        float rs[2][4]; f32x4 cbv[2][2];
#pragma unroll
        for (int ai = 0; ai < 2; ++ai)
#pragma unroll
            for (int m = 0; m < 4; ++m) {
                const float* sp = SS + (size_t)(row0 + ai * 128 + m * 16) * 32 + fq * 8;
                const f32x4 s0 = *(const f32x4*)sp, s1 = *(const f32x4*)(sp + 4);
                rs[ai][m] = ((s0[0] + s0[1]) + (s0[2] + s0[3])) + ((s1[0] + s1[1]) + (s1[2] + s1[3]));
            }
#pragma unroll
        for (int bj = 0; bj < 2; ++bj)
#pragma unroll
            for (int n = 0; n < 2; ++n) cbv[bj][n] = *(const f32x4*)(CB + (size_t)mrow * D + col0 + bj * 128 + 4 * n);
#pragma unroll
        for (int ai = 0; ai < 2; ++ai)
#pragma unroll
            for (int m = 0; m < 4; ++m) { float t = swap_add32(rs[ai][m], rs[ai][m]); t = swap_add16(t, t); rs[ai][m] = rsqrtf(t * (1.f / D) + RMS_EPS); }
#pragma unroll
        for (int ai = 0; ai < 2; ++ai)
#pragma unroll
            for (int m = 0; m < 4; ++m) {
                const int row = row0 + ai * 128 + m * 16;
                const float r = rs[ai][m];
#pragma unroll
                for (int bj = 0; bj < 2; ++bj)
                    *(u32x4*)(O + (size_t)row * D + col0 + bj * 128) = pack8(acc[ai][bj][m][0] * r + cbv[bj][0], acc[ai][bj][m][1] * r + cbv[bj][1]);
            }
    }
};

struct TJob { const float* src; int ldsrc; void* dst; int K, N; const float* kscale; int winmap; float oscale; };
__device__ __forceinline__ void tjob_load(const TJob& j, int t, int nkt, int tid, f32x4& a, f32x4& b) {
    const int kt = t % nkt, ntl = t / nkt, n0 = ntl * 64, k0 = kt * 64;
    int s0 = n0; bool zero = false;
    if (j.winmap == 1) { if (n0 < 2048) s0 = n0 + 5120; else if (n0 < 8192) s0 = n0 - 2048 + 7232; else if (n0 < 8256) s0 = n0 - 8192 + 7168; else if (n0 < 8448) zero = true; else s0 = n0 - 8448 + 1024; }
    if (j.winmap == 2) s0 = (n0 < 1024) ? n0 : n0 + 2048;
    if (j.winmap == 3) s0 = n0;
    const int kk = tid >> 3, cc = (tid & 7) * 8;
    a = (f32x4){0.f, 0.f, 0.f, 0.f}; b = a;
    if (!zero) { const float* sp = j.src + (size_t)(k0 + kk) * j.ldsrc + s0 + cc; a = *(const f32x4*)sp; b = *(const f32x4*)(sp + 4); }
    if (j.kscale) { const float s = j.kscale[k0 + kk]; a *= s; b *= s; }
}
__device__ __forceinline__ void tjob_run(const TJob& j, LAS float* tile  ) {
    const int tid = ltid(), nkt = j.K / 64, nnt = j.N / 64, ntile = nkt * nnt;
    int t = lbid();
    f32x4 a, b, a2, b2;
    if (t < ntile) tjob_load(j, t, nkt, tid, a, b);
    if (t + (int)gridDim.x < ntile) tjob_load(j, t + gridDim.x, nkt, tid, a2, b2);
    for (; t < ntile; t += gridDim.x) {
        const int kt = t % nkt, ntl = t / nkt;
        const int n0 = ntl * 64, k0 = kt * 64;
        __syncthreads();
        {
            const int kk = tid >> 3, cc = (tid & 7) * 8;
#pragma unroll
            for (int e = 0; e < 4; ++e) { tile[kk * 65 + cc + e] = a[e]; tile[kk * 65 + cc + 4 + e] = b[e]; }
        }
        __syncthreads();
        a = a2; b = b2;
        if (t + 2 * (int)gridDim.x < ntile) tjob_load(j, t + 2 * gridDim.x, nkt, tid, a2, b2);
        {
            const int nn = tid >> 3, kc = (tid & 7) * 8;
            float v[8];
#pragma unroll
            for (int e = 0; e < 8; ++e) v[e] = tile[(kc + e) * 65 + nn];
            if (j.winmap == 1 || j.winmap == 3) {
                int t0 = __builtin_amdgcn_cvt_pk_fp8_f32(v[0] * j.oscale, v[1] * j.oscale, 0, false); t0 = __builtin_amdgcn_cvt_pk_fp8_f32(v[2] * j.oscale, v[3] * j.oscale, t0, true);
                int t1 = __builtin_amdgcn_cvt_pk_fp8_f32(v[4] * j.oscale, v[5] * j.oscale, 0, false); t1 = __builtin_amdgcn_cvt_pk_fp8_f32(v[6] * j.oscale, v[7] * j.oscale, t1, true);
                *(u32x2*)((unsigned char*)j.dst + (size_t)(n0 + nn) * j.K + k0 + kc) = (u32x2){(unsigned)t0, (unsigned)t1};
            } else {
                u32x4 w; w.x = cvt_pk_bf16(v[0], v[1]); w.y = cvt_pk_bf16(v[2], v[3]); w.z = cvt_pk_bf16(v[4], v[5]); w.w = cvt_pk_bf16(v[6], v[7]);
                *(u32x4*)((bf16_t*)j.dst + (size_t)(n0 + nn) * j.K + k0 + kc) = w;
            }
        }
    }
    __syncthreads();
}
__device__ __forceinline__ void cvt_plain(const float* src, bf16_t* dst, size_t n8) {
    for (size_t i = (size_t)lbid() * 512 + ltid(); i < n8; i += (size_t)gridDim.x * 512) {
        const f32x4 a = *(const f32x4*)(src + i * 8), b = *(const f32x4*)(src + i * 8 + 4);
        *(u32x4*)(dst + i * 8) = pack8(a, b);
    }
}

__device__ __forceinline__ u32x4 fp4_pack32(const f32x4 (&x)[8], float scale) {
    u32x4 w;
#pragma unroll
    for (int d = 0; d < 4; ++d) {
        const f32x4 a = x[2 * d] * scale, b = x[2 * d + 1] * scale;
        unsigned t = 0u;
        t = __builtin_amdgcn_cvt_scalef32_pk_fp4_f32(t, a[0], a[1], 1.0f, 0);
        t = __builtin_amdgcn_cvt_scalef32_pk_fp4_f32(t, a[2], a[3], 1.0f, 1);
        t = __builtin_amdgcn_cvt_scalef32_pk_fp4_f32(t, b[0], b[1], 1.0f, 2);
        t = __builtin_amdgcn_cvt_scalef32_pk_fp4_f32(t, b[2], b[3], 1.0f, 3);
        w[d] = t;
    }
    return w;
}
__device__ __forceinline__ u32x4 i4_pack32(const f32x4 (&x)[8], float scale) {
    u32x4 w;
#pragma unroll
    for (int d = 0; d < 4; ++d) {
        unsigned t = 0u;
#pragma unroll
        for (int i = 0; i < 8; ++i) {
            const float v = (i < 4) ? x[2 * d][i & 3] : x[2 * d + 1][i & 3];
            const int n = __float2int_rn(__builtin_amdgcn_fmed3f(v * scale - 0.5f, -8.f, 7.f));
            t |= ((unsigned)n & 15u) << (4 * i);
        }
        w[d] = t;
    }
    return w;
}
template <bool I4>
__device__ __forceinline__ void cvt_fp4(const float* src, unsigned char* dst, size_t n32, float scale) {
    const size_t stride = (size_t)gridDim.x * 512;
    for (size_t i = (size_t)lbid() * 512 + ltid(); i < n32; i += 2 * stride) {
        const size_t i2 = i + stride; const bool two = i2 < n32;
        f32x4 x[8], y[8];
#pragma unroll
        for (int q = 0; q < 8; ++q) x[q] = *(const f32x4*)(src + i * 32 + q * 4);
        if (two) {
#pragma unroll
            for (int q = 0; q < 8; ++q) y[q] = *(const f32x4*)(src + i2 * 32 + q * 4);
        }
        *(u32x4*)(dst + i * 16) = I4 ? i4_pack32(x, scale) : fp4_pack32(x, scale);
        if (two) *(u32x4*)(dst + i2 * 16) = I4 ? i4_pack32(y, scale) : fp4_pack32(y, scale);
    }
}
__device__ __forceinline__ void phase_convert(const Params& p, int l, LAS unsigned char* lds) {
    unsigned char* ws = lws(p.ws);
    LAS float* tile = (LAS float*)lds;
    const int tid = ltid();
    if (l == 0) {
        LAS float* sc = (LAS float*)(lds + 32768);
        LAS float* red = (LAS float*)(lds + 32768 + 5 * 2048 * 4);
        for (int i = tid; i < 5 * 2048; i += 512) { const int r = i >> 11, k = i & 2047; const float v = (r < 4) ? p.in[1][r * 2048 + k] : p.in[3][k]; sc[i] = silu_f(v); }
        __syncthreads();
        const int wid = tid >> 6, lane = tid & 63;
        for (int task = lbid(); task < 2 * NMOD / 128; task += gridDim.x) {
            const int ll = task / (NMOD / 128), n0 = (task % (NMOD / 128)) * 128;
            const float* W = p.in[4] + (size_t)ll * D * NMOD + n0 + 2 * lane;
            const int kb = wid * 256;
            f32x2 a0 = {0.f, 0.f}, a1 = a0, a2 = a0, a3 = a0, a4 = a0;
#pragma unroll 16
            for (int k = 0; k < 256; ++k) { const f32x2 w = *(const f32x2*)(W + (size_t)(kb + k) * NMOD);
                a0 += sc[kb + k] * w; a1 += sc[2048 + kb + k] * w; a2 += sc[4096 + kb + k] * w; a3 += sc[6144 + kb + k] * w; a4 += sc[8192 + kb + k] * w; }
            *(LAS f32x2*)(red + (wid * 5 + 0) * 128 + 2 * lane) = a0; *(LAS f32x2*)(red + (wid * 5 + 1) * 128 + 2 * lane) = a1; *(LAS f32x2*)(red + (wid * 5 + 2) * 128 + 2 * lane) = a2;
            *(LAS f32x2*)(red + (wid * 5 + 3) * 128 + 2 * lane) = a3; *(LAS f32x2*)(red + (wid * 5 + 4) * 128 + 2 * lane) = a4;
            __syncthreads();
            for (int i = tid; i < 640; i += 512) { const int r = i >> 7, c = i & 127; float sm = 0.f;
#pragma unroll
                for (int w = 0; w < 8; ++w) sm += red[(w * 5 + r) * 128 + c];
                ((float*)(ws + WS_MOD))[((size_t)ll * 5 + r) * NMOD + n0 + c] = sm + p.in[5][ll * NMOD + n0 + c]; }
            __syncthreads();
        }
        for (int i = lbid() * 512 + tid; i < 2048; i += gridDim.x * 512) {
            float* LB = (float*)(ws + WS_LB);
            const float x0 = p.in[9][i], x1 = p.in[9][2048 + i];
            const float dlt = x1 - x0;
            const float ls1 = fminf(dlt, 0.f) - log1pf(expf(-fabsf(dlt)));
            const float ls0 = fminf(-dlt, 0.f) - log1pf(expf(-fabsf(dlt)));
            LB[i] = -INFINITY; LB[2048 + i] = 0.f;
            LB[4096 + i] = ls1; LB[4096 + 2048 + i] = ls0;
        }
        for (int i = lbid() * 512 + tid; i < 1024; i += gridDim.x * 512) {
            const int pos = i >> 4, jf = i & 15;
            const float fr = powf(10000.f, -(float)jf / 16.f);
            const float ang = (float)pos * fr;
            float* RT = (float*)(ws + WS_RT);
            RT[i * 2] = cosf(ang); RT[i * 2 + 1] = sinf(ang);
        }
    }
    { TJob j{p.in[8] + (size_t)l * D * 13376, 13376, ws + WS_WIN8, D, NIN8, nullptr, 1, 32.f}; tjob_run(j, tile); }
    { TJob j{p.in[8] + (size_t)l * D * 13376, 13376, ws + WS_WINF, D, NINF, nullptr, 2, 1.f}; tjob_run(j, tile); }
    { TJob j{p.in[14] + (size_t)l * 512 * 3072, 3072, ws + WS_WUQ, 512, 3072, p.in[13] + l * 512, 3, 32.f}; tjob_run(j, tile); }
    { TJob j{p.in[16] + (size_t)l * 512 * 4096, 4096, ws + WS_WUKV, 512, 4096, p.in[15] + l * 512, 3, 32.f}; tjob_run(j, tile); }
    { TJob j{p.in[17] + (size_t)l * 1024 * D, D, ws + WS_WA, 1024, D, nullptr, 3, 32.f}; tjob_run(j, tile); }
    { TJob j{p.in[18] + (size_t)l * 1024 * D, D, ws + WS_WB, 1024, D, nullptr, 3, 32.f}; tjob_run(j, tile); }
    { TJob j{p.in[19] + (size_t)l * D * D, D, ws + WS_WC, D, D, nullptr, 3, 32.f}; tjob_run(j, tile); }
    { TJob j{p.in[20] + (size_t)l * D * D, D, (bf16_t*)(ws + WS_WO), D, D, nullptr, 0, 1.f}; tjob_run(j, tile); }
    { TJob j{p.in[21] + (size_t)l * D * D, D, (bf16_t*)(ws + WS_WQ), D, D, nullptr, 0, 1.f}; tjob_run(j, tile); }
    for (int g = 0; g < 4; ++g) { TJob j{p.in[11] + ((size_t)l * 4 + g) * 65536, 256, (bf16_t*)(ws + WS_POOLT) + (size_t)g * 65536, 256, 256, nullptr, 0, 1.f}; tjob_run(j, tile); }
    cvt_plain(p.in[22] + (size_t)l * 2 * 8 * 128 * 128, (bf16_t*)(ws + WS_KEYS), (size_t)2 * 8 * 128 * 128 / 8);
    cvt_fp4<true>(p.in[23] + (size_t)l * 16384 * D, ws + WS_UT, (size_t)16384 * D / 32, U_IDELTA);
    cvt_fp4<false>(p.in[24] + (size_t)l * 16384 * D, ws + WS_VT, (size_t)16384 * D / 32, V_SCALE);
}

__device__ __forceinline__ unsigned pack4_fp8(float a, float b, float c, float d) {
    a = __builtin_amdgcn_fmed3f(a, -448.f, 448.f); b = __builtin_amdgcn_fmed3f(b, -448.f, 448.f); c = __builtin_amdgcn_fmed3f(c, -448.f, 448.f); d = __builtin_amdgcn_fmed3f(d, -448.f, 448.f);
    int t = __builtin_amdgcn_cvt_pk_fp8_f32(a, b, 0, false); return (unsigned)__builtin_amdgcn_cvt_pk_fp8_f32(c, d, t, true); }
__device__ __forceinline__ void modulate_store(const float (&x)[32], float rstd, const float* gain, const float* shift, const float* scale, bf16_t* hrow, unsigned char* h8row, int lane) {
#pragma unroll
    for (int j = 0; j < 4; ++j) {
        const int c = (j * 64 + lane) * 8;
        float o[8];
#pragma unroll
        for (int h4 = 0; h4 < 2; ++h4) {
            const f32x4 g = *(const f32x4*)(gain + c + 4 * h4), sh = *(const f32x4*)(shift + c + 4 * h4), sc = *(const f32x4*)(scale + c + 4 * h4);
#pragma unroll
            for (int e = 0; e < 4; ++e) o[h4 * 4 + e] = x[j * 8 + h4 * 4 + e] * rstd * g[e] * (1.f + sc[e]) + sh[e];
        }
        u32x4 w; w.x = cvt_pk_bf16(o[0], o[1]); w.y = cvt_pk_bf16(o[2], o[3]); w.z = cvt_pk_bf16(o[4], o[5]); w.w = cvt_pk_bf16(o[6], o[7]);
        *(u32x4*)(hrow + c) = w;
        if (h8row) *(u32x2*)(h8row + c) = (u32x2){pack4_fp8(o[0], o[1], o[2], o[3]), pack4_fp8(o[4], o[5], o[6], o[7])};
    }
}
__device__ __forceinline__ void load_row32(const float* xr, float (&x)[32], int lane) {
#pragma unroll
    for (int j = 0; j < 4; ++j) {
        const f32x4 a = *(const f32x4*)(xr + (j * 64 + lane) * 8), b = *(const f32x4*)(xr + (j * 64 + lane) * 8 + 4);
#pragma unroll
        for (int e = 0; e < 4; ++e) { x[j * 8 + e] = a[e]; x[j * 8 + 4 + e] = b[e]; }
    }
}
__device__ __forceinline__ void phase_modulate(const float* xl, const float* xc, const float* gain, const float* modl, int shift_i, int scale_i, bf16_t* H, unsigned char* H8, int nrows, int row0 = 0, int nb = 0) {
    const int tid_ = ltid(); const int wid = tid_ >> 6, lane = tid_ & 63;
    const int rstride = (nb ? nb : (int)gridDim.x) * 8;
    int row = row0 + lbid() * 8 + wid;
    float xn[32];
    if (row < nrows) load_row32((row >= RL) ? xc + (size_t)(row - RL) * D : xl + (size_t)row * D, xn, lane);
    for (; row < nrows; row += rstride) {
        const bool isc = row >= RL;
        const int mrow = isc ? 4 : (row >> 12);
        float x[32];
#pragma unroll
        for (int e = 0; e < 32; ++e) x[e] = xn[e];
        { const int nr = row + rstride;
          if (nr < nrows) load_row32((nr >= RL) ? xc + (size_t)(nr - RL) * D : xl + (size_t)nr * D, xn, lane); }
        float ss = 0.f;
#pragma unroll
        for (int e = 0; e < 32; ++e) ss += x[e] * x[e];
        ss = wave_sum(ss);
        const float rstd = rsqrtf(ss * (1.f / D) + RMS_EPS);
        modulate_store(x, rstd, gain, modl + (size_t)mrow * NMOD + shift_i * D, modl + (size_t)mrow * NMOD + scale_i * D, H + (size_t)row * D, H8 ? H8 + (size_t)row * D : nullptr, lane);
    }
}

__device__ __forceinline__ void phase_misc(const Params& p, int nrows) {
    unsigned char* ws = lws(p.ws);
    const int tid_ = ltid(); const int wid = tid_ >> 6, lane = tid_ & 63;
    const bf16_t* CQ = (const bf16_t*)(ws + WS_CQ); const bf16_t* CKV = (const bf16_t*)(ws + WS_CKV);
    const bf16_t* PU = (const bf16_t*)(ws + WS_PU); bf16_t* PO = (bf16_t*)(ws + WS_PYA);
    float* RS = (float*)(ws + WS_RSTD); const float* KR = (const float*)(ws + WS_KR); bf16_t* KROPE = (bf16_t*)(ws + WS_KROPE);
    const float* RT = (const float*)(ws + WS_RT);
    for (int row = lbid() * 8 + wid; row < ROWS; row += gridDim.x * 8) {
        const u32x4 a = *(const u32x4*)(CQ + (size_t)row * 512 + lane * 8), b = *(const u32x4*)(CKV + (size_t)row * 512 + lane * 8);
        const float xv = KR[(size_t)row * 64 + lane], xp = KR[(size_t)row * 64 + (lane ^ 16)];
        float cs = 1.f, sn = 0.f;
        if (row < RL) { const int t = row & 4095, part = lane >> 5, pos = part ? (t & 63) : (t >> 6), jf = lane & 15; cs = RT[(pos * 16 + jf) * 2]; sn = RT[(pos * 16 + jf) * 2 + 1]; }
        if (row < nrows) {
            const int seq0 = (row < RL) ? (row & ~4095) : (RL + ((row - RL) & ~255)), L = (row < RL) ? 4096 : 256, t = row - seq0;
            u32x4 w0[4], w1[16], me[2];
            float inv[2];
#pragma unroll
            for (int j = 0; j < 2; ++j) {
                const int ch = (j * 64 + lane) * 8, g = ch >> 8, half = 1 << g;
                int lo = t - half, hi = t + half; lo = lo < 0 ? 0 : lo; hi = hi > L ? L : hi;
                inv[j] = 1.f / (float)(hi - lo);
                me[j] = *(const u32x4*)(PU + (size_t)row * 1024 + ch);
                if (j == 0) {
#pragma unroll
                    for (int i = 0; i < 4; ++i) { int r = t - half + i; r = r < 0 ? 0 : (r >= L ? L - 1 : r); w0[i] = *(const u32x4*)(PU + (size_t)(seq0 + r) * 1024 + ch); }
                } else {
#pragma unroll
                    for (int i = 0; i < 16; ++i) { int r = t - half + i; r = r < 0 ? 0 : (r >= L ? L - 1 : r); w1[i] = *(const u32x4*)(PU + (size_t)(seq0 + r) * 1024 + ch); }
                }
            }
#pragma unroll
            for (int j = 0; j < 2; ++j) {
                const int ch = (j * 64 + lane) * 8, g = ch >> 8, half = 1 << g;
                float sacc[8] = {0.f, 0.f, 0.f, 0.f, 0.f, 0.f, 0.f, 0.f};
#pragma unroll
                for (int i = 0; i < (j == 0 ? 4 : 16); ++i) {
                    const int r = t - half + i; const bool ok = (i < 2 * half) && r >= 0 && r < L;
                    const u32x4 w = (j == 0) ? w0[i < 4 ? i : 0] : w1[i];
#pragma unroll
                    for (int e = 0; e < 4; ++e) { sacc[2 * e] += ok ? bflo(w[e]) : 0.f; sacc[2 * e + 1] += ok ? bfhi(w[e]) : 0.f; }
                }
                float o[8];
#pragma unroll
                for (int e = 0; e < 4; ++e) { o[2 * e] = sacc[2 * e] * inv[j] - bflo(me[j][e]); o[2 * e + 1] = sacc[2 * e + 1] * inv[j] - bfhi(me[j][e]); }
                u32x4 w; w.x = cvt_pk_bf16(o[0], o[1]); w.y = cvt_pk_bf16(o[2], o[3]); w.z = cvt_pk_bf16(o[4], o[5]); w.w = cvt_pk_bf16(o[6], o[7]);
                *(u32x4*)(PO + (size_t)row * 1024 + ch) = w;
            }
        }
        {
            float sa = 0.f, sb = 0.f;
#pragma unroll
            for (int e = 0; e < 4; ++e) { const float l0 = bflo(a[e]), h0 = bfhi(a[e]), l1 = bflo(b[e]), h1 = bfhi(b[e]); sa += l0 * l0 + h0 * h0; sb += l1 * l1 + h1 * h1; }
            sa = wave_sum(sa); sb = wave_sum(sb);
            if (lane == 0) { RS[row] = rsqrtf(sa * (1.f / 512.f) + RMS_EPS); RS[ROWS + row] = rsqrtf(sb * (1.f / 512.f) + RMS_EPS); }
        }
        {
            float o = xv;
            if (row < RL) o = (lane & 16) ? (xv * cs + xp * sn) : (xv * cs - xp * sn);
            KROPE[(size_t)row * 64 + lane] = f2bf(o);
        }
    }
}

__device__ __forceinline__ int chunk_row0(int b, int m) { return (m < 4) ? (RL + b * 256 + m * 64) : (b * 4096 + (m - 4) * 64); }
__device__ __forceinline__ int chunk_n(int m, int dir) { return dir ? ((m < 4) ? 3 - m : 71 - m) : m; }

__device__ __forceinline__ void phase_cb(const Params& p, const float* modl) {
    unsigned char* ws = lws(p.ws);
    const int tid = ltid(), wid = tid >> 6, lane = tid & 63;
    const bf16_t* WQ = (const bf16_t*)(ws + WS_WQ); float* CB = (float*)(ws + WS_CB);
    for (int n = lbid() * 8 + wid; n < D; n += gridDim.x * 8) {
        float w[32];
#pragma unroll
        for (int q = 0; q < 4; ++q) { const u32x4 ww = *(const u32x4*)(WQ + (size_t)n * D + lane * 32 + q * 8);
#pragma unroll
            for (int e = 0; e < 4; ++e) { w[q * 8 + 2 * e] = bflo(ww[e]); w[q * 8 + 2 * e + 1] = bfhi(ww[e]); } }
        float acc5[5];
#pragma unroll
        for (int b = 0; b < 5; ++b) {
            const float* sh = modl + (size_t)b * NMOD + 3 * D + lane * 32;
            float a = 0.f;
#pragma unroll
            for (int q = 0; q < 8; ++q) { const f32x4 sv = *(const f32x4*)(sh + q * 4);
#pragma unroll
                for (int e = 0; e < 4; ++e) a += sv[e] * w[q * 4 + e]; }
            acc5[b] = wave_sum(a);
        }
        if (lane < 5) CB[(size_t)lane * D + n] = (lane == 0) ? acc5[0] : (lane == 1) ? acc5[1] : (lane == 2) ? acc5[2] : (lane == 3) ? acc5[3] : acc5[4];
    }
}
__device__ __forceinline__ void hgrn_local(const Params& p, LAS unsigned char* lds) {
    unsigned char* ws = lws(p.ws);
    const int tid = ltid(), wid = tid >> 6, lane = tid & 63, r32 = lane & 31, hi = lane >> 5;
    const bf16_t* LF = (const bf16_t*)(ws + WS_LF); const bf16_t* IH = (const bf16_t*)(ws + WS_IH);
    bf16_t* ST = (bf16_t*)(ws + WS_ST); float* DEC = (float*)(ws + WS_DEC);
    constexpr int LQ = 136;
    LAS bf16_t* KT = (LAS bf16_t*)lds;
    LAS bf16_t* VT = (LAS bf16_t*)(lds + 2 * 128 * 72 * 2);
    LAS bf16_t* RLF = (LAS bf16_t*)(lds + 3 * 128 * 72 * 2);
    LAS float* SEG = (LAS float*)(lds + 3 * 128 * 72 * 2 + 2 * 64 * LQ * 2);
    for (int u = lbid(); u < NB * 8 * NCH; u += gridDim.x) {
        const int m = u % NCH, bh = u / NCH, b = bh >> 3, h = bh & 7, r0 = chunk_row0(b, m);
        __syncthreads();
#pragma unroll
        for (int i = 0; i < 2; ++i) {
            const int id = tid + 512 * i, row = id >> 4, c8 = (id & 15) * 8;
            const size_t g = (size_t)(r0 + row) * 1024 + h * 128 + c8;
            const u32x4 l0 = *(const u32x4*)(LF + g), l1 = *(const u32x4*)(LF + (size_t)ROWS * 1024 + g), vv = *(const u32x4*)(IH + g);
            *(LAS u32x4*)(RLF + row * LQ + c8) = l0; *(LAS u32x4*)(RLF + (64 + row) * LQ + c8) = l1;
#pragma unroll
            for (int e = 0; e < 4; ++e) { VT[(c8 + 2 * e) * 72 + row] = (bf16_t)(vv[e] & 0xffffu); VT[(c8 + 2 * e + 1) * 72 + row] = (bf16_t)(vv[e] >> 16); }
        }
        __syncthreads();
        const int c = tid & 127, seg = tid >> 7;
        float lf[2][16];
#pragma unroll
        for (int d = 0; d < 2; ++d) { float tot = 0.f;
#pragma unroll
            for (int r = 0; r < 16; ++r) { lf[d][r] = bf2f(RLF[(d * 64 + seg * 16 + r) * LQ + c]); tot += lf[d][r]; }
            SEG[(d * 4 + seg) * 128 + c] = tot; }
        __syncthreads();
#pragma unroll
        for (int d = 0; d < 2; ++d) {
            const float s0 = SEG[(d * 4 + 0) * 128 + c], s1 = SEG[(d * 4 + 1) * 128 + c], s2 = SEG[(d * 4 + 2) * 128 + c], s3 = SEG[(d * 4 + 3) * 128 + c];
            float run = (d == 0) ? ((seg < 3 ? s3 : 0.f) + (seg < 2 ? s2 : 0.f) + (seg < 1 ? s1 : 0.f))
                                 : ((seg > 0 ? s0 : 0.f) + (seg > 1 ? s1 : 0.f) + (seg > 2 ? s2 : 0.f));
            LAS bf16_t* dst = KT + (d * 128 + c) * 72 + seg * 16;
#pragma unroll
            for (int rr = 0; rr < 16; ++rr) {
                const int r = (d == 0) ? 15 - rr : rr;
                const float lv = (d == 0) ? lf[0][15 - rr] : lf[1][rr];
                dst[r] = f2bf((1.f - __expf(lv)) * __expf(run));
                run += lv;
            }
            if (seg == 0) DEC[((size_t)((bh * 2 + d) * NCH) + chunk_n(m, d)) * 128 + c] = __expf(s0 + s1 + s2 + s3);
        }
        __syncthreads();
        {
            const int dir = wid >> 2, vt = wid & 3;
            f32x16 acc[4];
#pragma unroll
            for (int ct = 0; ct < 4; ++ct) acc[ct] = (f32x16){0.f};
#pragma unroll
            for (int s_ = 0; s_ < 4; ++s_) {
                const bf16x8 a = *(const LAS bf16x8*)(VT + (vt * 32 + r32) * 72 + s_ * 16 + hi * 8);
#pragma unroll
                for (int ct = 0; ct < 4; ++ct) {
                    const bf16x8 bb = *(const LAS bf16x8*)(KT + (dir * 128 + ct * 32 + r32) * 72 + s_ * 16 + hi * 8);
                    acc[ct] = __builtin_amdgcn_mfma_f32_32x32x16_bf16(a, bb, acc[ct], 0, 0, 0);
                }
            }
            unsigned char* dst = (unsigned char*)ST + ((size_t)((bh * 2 + dir) * NCH) + chunk_n(m, dir)) * 16384;
#pragma unroll
            for (int ct = 0; ct < 4; ++ct)
#pragma unroll
                for (int r = 0; r < 16; ++r) { const float sv = __builtin_amdgcn_fmed3f(acc[ct][r], -448.f, 448.f); dst[(vt * 32 + crow(r, hi)) * 128 + ct * 32 + r32] = (unsigned char)__builtin_amdgcn_cvt_pk_fp8_f32(sv, sv, 0, false); }
        }
    }
    __syncthreads();
}
__device__ __forceinline__ void hgrn_scan(const Params& p) {
    unsigned char* ws = lws(p.ws);
    unsigned char* ST = ws + WS_ST; const float* DEC = (const float*)(ws + WS_DEC);
    for (int gid = lbid() * 512 + ltid(); gid < NSTREAM * 2048; gid += gridDim.x * 512) {
        const int stream = gid >> 11, rem = gid & 2047, c8 = (rem & 15) * 8;
        unsigned char* sp = ST + (size_t)stream * NCH * 16384 + (rem >> 4) * 128 + c8;
        const float* dp = DEC + (size_t)stream * NCH * 128 + c8;
        float S[8] = {0.f, 0.f, 0.f, 0.f, 0.f, 0.f, 0.f, 0.f};
        for (int n0 = 0; n0 < NCH; n0 += 4) {
            u32x2 uw[4]; f32x4 d0[4], d1[4];
#pragma unroll
            for (int i = 0; i < 4; ++i) { uw[i] = *(const u32x2*)(sp + (size_t)(n0 + i) * 16384); d0[i] = *(const f32x4*)(dp + (n0 + i) * 128); d1[i] = *(const f32x4*)(dp + (n0 + i) * 128 + 4); }
#pragma unroll
            for (int i = 0; i < 4; ++i) {
                *(u32x2*)(sp + (size_t)(n0 + i) * 16384) = (u32x2){pack4_fp8(S[0], S[1], S[2], S[3]), pack4_fp8(S[4], S[5], S[6], S[7])};
                const f32x2 u0 = __builtin_amdgcn_cvt_pk_f32_fp8((int)uw[i].x, false), u1 = __builtin_amdgcn_cvt_pk_f32_fp8((int)uw[i].x, true);
                const f32x2 u2 = __builtin_amdgcn_cvt_pk_f32_fp8((int)uw[i].y, false), u3 = __builtin_amdgcn_cvt_pk_f32_fp8((int)uw[i].y, true);
                S[0] = d0[i][0] * S[0] + u0[0]; S[1] = d0[i][1] * S[1] + u0[1]; S[2] = d0[i][2] * S[2] + u1[0]; S[3] = d0[i][3] * S[3] + u1[1];
                S[4] = d1[i][0] * S[4] + u2[0]; S[5] = d1[i][1] * S[5] + u2[1]; S[6] = d1[i][2] * S[6] + u3[0]; S[7] = d1[i][3] * S[7] + u3[1];
            }
        }
    }
}
__device__ __forceinline__ void hgrn_out(const Params& p, int l, bool last, LAS unsigned char* lds) {
    unsigned char* ws = lws(p.ws);
    const int tid = ltid(), wid = tid >> 6, lane = tid & 63, r32 = lane & 31, hi = lane >> 5;
    const bf16_t* LF = (const bf16_t*)(ws + WS_LF); const bf16_t* IH = (const bf16_t*)(ws + WS_IH); const bf16_t* QH = (const bf16_t*)(ws + WS_QH);
    const bf16_t* GH = (const bf16_t*)(ws + WS_GH); const bf16_t* ST = (const bf16_t*)(ws + WS_ST); bf16_t* YA = (bf16_t*)(ws + WS_PYA);
    const float* hgn = p.in[10] + l * 128;
    constexpr int LQ = 136;
    LAS bf16_t* Qt = (LAS bf16_t*)lds;
    LAS bf16_t* Kt = Qt + 64 * LQ;
    LAS bf16_t* Qi = Kt + 64 * LQ;
    LAS bf16_t* VT = Qi + 64 * LQ;
    LAS float* OB = (LAS float*)(lds + 3 * 64 * LQ * 2 + 128 * 72 * 2);
    LAS bf16_t* RQ = (LAS bf16_t*)(lds + 3 * 64 * LQ * 2 + 128 * 72 * 2 + 64 * 132 * 4);
    LAS bf16_t* RL_ = RQ + 64 * LQ;
    LAS float* SEG = (LAS float*)(RL_ + 64 * LQ);
    for (int u = lbid(); u < NB * 8 * NCH; u += gridDim.x) {
        const int m = u % NCH, bh = u / NCH, b = bh >> 3, h = bh & 7, r0 = chunk_row0(b, m);
        if (last && m < 4) continue;
        __syncthreads();
        u32x4 lfr[2][2], ghr[2];
        { const int grow = tid >> 3, gseg = (tid & 7) * 16; const size_t goff = (size_t)(r0 + grow) * 1024 + h * 128 + gseg;
          ghr[0] = *(const u32x4*)(GH + goff); ghr[1] = *(const u32x4*)(GH + goff + 8); }
#pragma unroll
        for (int i = 0; i < 2; ++i) {
            const int id = tid + 512 * i, row = id >> 4, c8 = (id & 15) * 8;
            lfr[0][i] = *(const u32x4*)(LF + (size_t)(r0 + row) * 1024 + h * 128 + c8);
            lfr[1][i] = *(const u32x4*)(LF + (size_t)ROWS * 1024 + (size_t)(r0 + row) * 1024 + h * 128 + c8);
            *(LAS u32x4*)(RQ + row * LQ + c8) = *(const u32x4*)(QH + (size_t)(r0 + row) * 1024 + h * 128 + c8);
            const u32x4 vv = *(const u32x4*)(IH + (size_t)(r0 + row) * 1024 + h * 128 + c8);
#pragma unroll
            for (int e = 0; e < 4; ++e) { VT[(c8 + 2 * e) * 72 + row] = (bf16_t)(vv[e] & 0xffffu); VT[(c8 + 2 * e + 1) * 72 + row] = (bf16_t)(vv[e] >> 16); }
        }
        f32x16 o = (f32x16){0.f};
        const int I = wid >> 2, vt = wid & 3;
        for (int dir = 0; dir < 2; ++dir) {
            __syncthreads();
#pragma unroll
            for (int i = 0; i < 2; ++i) {
                const int id = tid + 512 * i, row = id >> 4, c8 = (id & 15) * 8;
                *(LAS u32x4*)(RL_ + row * LQ + c8) = dir ? lfr[1][i] : lfr[0][i];
            }
            const unsigned char* Sg = (const unsigned char*)ST + ((size_t)((bh * 2 + dir) * NCH) + chunk_n(m, dir)) * 16384 + (size_t)(vt * 32 + r32) * 128 + hi * 8;
            u32x2 sraw[8];
#pragma unroll
            for (int s = 0; s < 8; ++s) sraw[s] = *(const u32x2*)(Sg + s * 16);
            bf16x8 sf[8];
#pragma unroll
            for (int s = 0; s < 8; ++s) {
                const f32x2 u0 = __builtin_amdgcn_cvt_pk_f32_fp8((int)sraw[s].x, false), u1 = __builtin_amdgcn_cvt_pk_f32_fp8((int)sraw[s].x, true);
                const f32x2 u2 = __builtin_amdgcn_cvt_pk_f32_fp8((int)sraw[s].y, false), u3 = __builtin_amdgcn_cvt_pk_f32_fp8((int)sraw[s].y, true);
                u32x4 w; w.x = cvt_pk_bf16(u0[0], u0[1]); w.y = cvt_pk_bf16(u1[0], u1[1]); w.z = cvt_pk_bf16(u2[0], u2[1]); w.w = cvt_pk_bf16(u3[0], u3[1]);
                sf[s] = *reinterpret_cast<bf16x8*>(&w);
            }
            __syncthreads();
            const int c = tid & 127, seg = tid >> 7;
            float lf[16]; float tot = 0.f;
#pragma unroll
            for (int r = 0; r < 16; ++r) { lf[r] = bf2f(RL_[(seg * 16 + r) * LQ + c]); tot += lf[r]; }
            SEG[seg * 128 + c] = tot;
            __syncthreads();
            {
                const float s0 = SEG[c], s1 = SEG[128 + c], s2 = SEG[256 + c], s3 = SEG[384 + c];
                const float bmid = dir ? (s2 + s3) : (s0 + s1);
                float run;
                if (dir == 0) run = (seg > 0 ? s0 : 0.f) + (seg > 1 ? s1 : 0.f) + (seg > 2 ? s2 : 0.f);
                else          run = (seg < 3 ? s3 : 0.f) + (seg < 2 ? s2 : 0.f) + (seg < 1 ? s1 : 0.f);
#pragma unroll
                for (int rr = 0; rr < 16; ++rr) {
                    const int r = dir ? 15 - rr : rr, row = seg * 16 + r;
                    const float lv = dir ? lf[15 - rr] : lf[rr];
                    const float q = bf2f(RQ[row * LQ + c]);
                    run += lv;
                    const float k = 1.f - __expf(lv);
                    const float dq = fminf(fmaxf(run - bmid, -80.f), 80.f);
                    Qt[row * LQ + c] = f2bf(q * __expf(dq));
                    Kt[row * LQ + c] = f2bf(k * __expf(-dq));
                    Qi[row * LQ + c] = f2bf(q * __expf(run));
                }
            }
            __syncthreads();
            for (int Jt = 0; Jt < 2; ++Jt) {
                const bool use = dir ? (Jt >= I) : (Jt <= I);
                if (!use) continue;
                f32x16 X = (f32x16){0.f};
#pragma unroll
                for (int s = 0; s < 8; ++s) {
                    const bf16x8 ka = *(const LAS bf16x8*)(Kt + (Jt * 32 + r32) * LQ + s * 16 + hi * 8);
                    const bf16x8 qb = *(const LAS bf16x8*)(Qt + (I * 32 + r32) * LQ + s * 16 + hi * 8);
                    X = __builtin_amdgcn_mfma_f32_32x32x16_bf16(ka, qb, X, 0, 0, 0);
                }
                if (Jt == I) {
#pragma unroll
                    for (int r = 0; r < 16; ++r) { const bool keep = dir ? (crow(r, hi) >= r32) : (crow(r, hi) <= r32); X[r] = keep ? X[r] : 0.f; }
                }
#pragma unroll
                for (int s2 = 0; s2 < 2; ++s2) {
                    u32x4 pw; pw.x = cvt_pk_bf16(X[8 * s2 + 0], X[8 * s2 + 1]); pw.y = cvt_pk_bf16(X[8 * s2 + 2], X[8 * s2 + 3]); pw.z = cvt_pk_bf16(X[8 * s2 + 4], X[8 * s2 + 5]); pw.w = cvt_pk_bf16(X[8 * s2 + 6], X[8 * s2 + 7]);
                    const int j0 = Jt * 32 + 16 * s2 + 4 * hi;
                    const u32x2 v0 = *(const LAS u32x2*)(VT + (vt * 32 + r32) * 72 + j0), v1 = *(const LAS u32x2*)(VT + (vt * 32 + r32) * 72 + j0 + 8);
                    u32x4 vw; vw.x = v0.x; vw.y = v0.y; vw.z = v1.x; vw.w = v1.y;
                    o = __builtin_amdgcn_mfma_f32_32x32x16_bf16(*(bf16x8*)&pw, *(bf16x8*)&vw, o, 0, 0, 0);
                }
            }
#pragma unroll
            for (int s = 0; s < 8; ++s) {
                const bf16x8 qa = *(const LAS bf16x8*)(Qi + (I * 32 + r32) * LQ + s * 16 + hi * 8);
                o = __builtin_amdgcn_mfma_f32_32x32x16_bf16(qa, sf[s], o, 0, 0, 0);
            }
        }
#pragma unroll
        for (int r = 0; r < 16; ++r) OB[(I * 32 + crow(r, hi)) * 132 + vt * 32 + r32] = o[r];
        __syncthreads();
        {
            const int row = tid >> 3, seg = (tid & 7) * 16;
            float ov[16]; float ss = 0.f;
#pragma unroll
            for (int e = 0; e < 16; ++e) { ov[e] = OB[row * 132 + seg + e]; ss += ov[e] * ov[e]; }
            ss += __shfl_xor(ss, 1); ss += __shfl_xor(ss, 2); ss += __shfl_xor(ss, 4);
            const float rstd = rsqrtf(ss * (1.f / 128.f) + RMS_EPS);
            const size_t off = (size_t)(r0 + row) * 1024 + h * 128 + seg;
            const u32x4 g0 = ghr[0], g1 = ghr[1];
            float y[16];
#pragma unroll
            for (int e = 0; e < 4; ++e) {
                y[2 * e] = ov[2 * e] * rstd * hgn[seg + 2 * e] * bflo(g0[e]); y[2 * e + 1] = ov[2 * e + 1] * rstd * hgn[seg + 2 * e + 1] * bfhi(g0[e]);
                y[8 + 2 * e] = ov[8 + 2 * e] * rstd * hgn[seg + 8 + 2 * e] * bflo(g1[e]); y[8 + 2 * e + 1] = ov[8 + 2 * e + 1] * rstd * hgn[seg + 8 + 2 * e + 1] * bfhi(g1[e]);
            }
            u32x4 w0;
            w0.x = pack4_fp8(y[0] * 8.f, y[1] * 8.f, y[2] * 8.f, y[3] * 8.f); w0.y = pack4_fp8(y[4] * 8.f, y[5] * 8.f, y[6] * 8.f, y[7] * 8.f);
            w0.z = pack4_fp8(y[8] * 8.f, y[9] * 8.f, y[10] * 8.f, y[11] * 8.f); w0.w = pack4_fp8(y[12] * 8.f, y[13] * 8.f, y[14] * 8.f, y[15] * 8.f);
            *(u32x4*)((unsigned char*)YA + (size_t)(r0 + row) * 2048 + h * 128 + seg) = w0;
        }
    }
    __syncthreads();
}

namespace att {
constexpr int SHM_V = 64 * 128 * 2, SHM_K = 64 * 192 * 2;
constexpr float SCALE = 0.07216878364870323f;
constexpr float THR = 8.f;
#define KSWZ(row, c16) ((row) * 384 + ((((c16) ^ (((row) >> 1) & 7))) << 4))
#define SBAR() __builtin_amdgcn_sched_barrier(0)
__device__ __forceinline__ void partialSM(f32x16& p0, f32x16& p1, float& m_reg, float& mn, float& alpha) {
    constexpr float C = SCALE * 1.4426950408889634f;
    float pmax = p0[0];
#pragma unroll
    for (int r = 1; r < 16; ++r) pmax = fmaxf(pmax, p0[r]);
#pragma unroll
    for (int r = 0; r < 16; ++r) pmax = fmaxf(pmax, p1[r]);
    { auto rr = __builtin_amdgcn_permlane32_swap(__float_as_uint(pmax), __float_as_uint(pmax), false, false);
      pmax = fmaxf(__uint_as_float(rr[0]), __uint_as_float(rr[1])); }
    if (__builtin_expect(__all(pmax - m_reg <= THR / SCALE), 1)) { mn = m_reg; alpha = 1.f; }
    else { mn = fmaxf(m_reg, pmax); alpha = __builtin_amdgcn_exp2f((m_reg - mn) * C); m_reg = mn; }
    const float mnC = -mn * C;
#pragma unroll
    for (int r = 0; r < 16; ++r) p0[r] = fmaf(p0[r], C, mnC);
#pragma unroll
    for (int r = 0; r < 16; ++r) p1[r] = fmaf(p1[r], C, mnC);
#pragma unroll
    for (int r = 0; r < 16; ++r) p0[r] = __builtin_amdgcn_exp2f(p0[r]);
}
__device__ __forceinline__ void finishSM(f32x16& p0, f32x16& p1, float alpha, float& l_reg, bf16x8& pa0, bf16x8& pa1, bf16x8& pa2, bf16x8& pa3) {
#pragma unroll
    for (int r = 0; r < 16; ++r) p1[r] = __builtin_amdgcn_exp2f(p1[r]);
    float ps = 0;
#pragma unroll
    for (int r = 0; r < 16; ++r) ps += p0[r];
#pragma unroll
    for (int r = 0; r < 16; ++r) ps += p1[r];
    { auto rr = __builtin_amdgcn_permlane32_swap(__float_as_uint(ps), __float_as_uint(ps), false, false);
      ps = __uint_as_float(rr[0]) + __uint_as_float(rr[1]); }
    l_reg = l_reg * alpha + ps;
#define PK4(P, BASE, OUT) do { unsigned a0 = cvt_pk_bf16(P[BASE + 0], P[BASE + 1]), a1 = cvt_pk_bf16(P[BASE + 2], P[BASE + 3]);   \
    unsigned b0 = cvt_pk_bf16(P[BASE + 4], P[BASE + 5]), b1 = cvt_pk_bf16(P[BASE + 6], P[BASE + 7]);                              \
    auto r0 = __builtin_amdgcn_permlane32_swap(a0, b0, false, false); auto r1 = __builtin_amdgcn_permlane32_swap(a1, b1, false, false); \
    u32x4 w = {r0[0], r1[0], r0[1], r1[1]}; OUT = *reinterpret_cast<bf16x8*>(&w); } while (0)
    PK4(p0, 0, pa0); PK4(p0, 8, pa1); PK4(p1, 0, pa2); PK4(p1, 8, pa3);
#undef PK4
}
__device__ __forceinline__ void qkt(f32x16& p0, f32x16& p1, const LAS char* Ks, const bf16x8* qr, int r32, int hi) {
    p0 = f32x16{}; p1 = f32x16{};
#pragma unroll
    for (int d0 = 0; d0 < 12; ++d0) { const int c16 = d0 * 2 + hi;
        const bf16x8 b0 = *reinterpret_cast<const LAS bf16x8*>(Ks + KSWZ(r32, c16));
        const bf16x8 b1 = *reinterpret_cast<const LAS bf16x8*>(Ks + KSWZ(32 + r32, c16));
        p0 = __builtin_amdgcn_mfma_f32_32x32x16_bf16(b0, qr[d0], p0, 0, 0, 0);
        p1 = __builtin_amdgcn_mfma_f32_32x32x16_bf16(b1, qr[d0], p1, 0, 0, 0); }
}
__device__ __forceinline__ int v_st(int k, int c) { const int kk = (k & ~0xC) | ((k & 4) << 1) | ((k & 8) >> 1); return ((kk >> 3) * 4 + (c >> 5)) * 512 + ((kk & 7) * 32 + (c & 31)) * 2; }
__device__ __forceinline__ int v_rd_base(int lane) { return ((lane & 3) << 3) | (((lane >> 2) & 3) << 6) | (((lane >> 4) & 1) << 5) | (((lane >> 5) & 1) << 8); }
constexpr int v_rd_off(int d0, int ks, int half) { return d0 * 512 + ks * 4096 + half * 2048; }
template <int OFF> __device__ __forceinline__ s16x4 tr_read(int vb) {
    s16x4 r; asm volatile("ds_read_b64_tr_b16 %0, %1 offset:%2" : "=&v"(r) : "v"(vb), "i"(OFF) : "memory"); return r;
}
template <int D0> __device__ __forceinline__ void pv_one(f32x16& od, int vb, bf16x8 pa0, bf16x8 pa1, bf16x8 pa2, bf16x8 pa3) {
    const s16x4 l0 = tr_read<v_rd_off(D0, 0, 0)>(vb), h0 = tr_read<v_rd_off(D0, 0, 1)>(vb), l1 = tr_read<v_rd_off(D0, 1, 0)>(vb), h1 = tr_read<v_rd_off(D0, 1, 1)>(vb);
    const s16x4 l2 = tr_read<v_rd_off(D0, 2, 0)>(vb), h2 = tr_read<v_rd_off(D0, 2, 1)>(vb), l3 = tr_read<v_rd_off(D0, 3, 0)>(vb), h3 = tr_read<v_rd_off(D0, 3, 1)>(vb);
    asm volatile("s_waitcnt lgkmcnt(0)" ::: "memory"); SBAR();
#define PK(L, H) (bf16x8){L[0], L[1], L[2], L[3], H[0], H[1], H[2], H[3]}
    od = __builtin_amdgcn_mfma_f32_32x32x16_bf16(pa0, PK(l0, h0), od, 0, 0, 0);
    od = __builtin_amdgcn_mfma_f32_32x32x16_bf16(pa1, PK(l1, h1), od, 0, 0, 0);
    od = __builtin_amdgcn_mfma_f32_32x32x16_bf16(pa2, PK(l2, h2), od, 0, 0, 0);
    od = __builtin_amdgcn_mfma_f32_32x32x16_bf16(pa3, PK(l3, h3), od, 0, 0, 0);
#undef PK
}
__device__ __forceinline__ void pv_d0(f32x16* o, int vb, bf16x8 pa0, bf16x8 pa1, bf16x8 pa2, bf16x8 pa3) {
    pv_one<0>(o[0], vb, pa0, pa1, pa2, pa3); pv_one<1>(o[1], vb, pa0, pa1, pa2, pa3); pv_one<2>(o[2], vb, pa0, pa1, pa2, pa3); pv_one<3>(o[3], vb, pa0, pa1, pa2, pa3);
}
constexpr int SHM_KV = SHM_K + SHM_V;
__device__ __forceinline__ void attn_unit(const bf16_t* __restrict__ Q, const bf16_t* __restrict__ KV, const bf16_t* __restrict__ KROPE, bf16_t* __restrict__ O, const float* __restrict__ RT,
                                          int q0, int h, int ctx0, int lat0, int nctx, int nkeys, int rope_t0, LAS char* lds) {
    const int tid = ltid(), wid = __builtin_amdgcn_readfirstlane(tid >> 6), lane = tid & 63, r32 = lane & 31, hi = lane >> 5;
    LAS float* wsm = (LAS float*)(lds + 3 * SHM_KV) + wid * 64; LAS float* li_l = wsm; LAS float* al_l = wsm + 32;
    const int vrb = v_rd_base(lane);
    int koff[3]; bool krope[3]; int voff[2];
#pragma unroll
    for (int i = 0; i < 3; ++i) { const int L = (wid + 8 * i) * 64 + lane, row = L / 24, c16 = (L % 24) ^ ((row >> 1) & 7);
        krope[i] = c16 >= 16; koff[i] = krope[i] ? row * 64 + (c16 - 16) * 8 : row * 4096 + c16 * 8; }
#pragma unroll
    for (int i = 0; i < 2; ++i) { const int L = (wid + 8 * i) * 64 + lane, st = L >> 5, w = L & 31, kk = (st >> 2) * 8 + (w >> 2);
        const int k = (kk & ~0xC) | ((kk & 4) << 1) | ((kk & 8) >> 1), c = (st & 3) * 32 + (w & 3) * 8; voff[i] = k * 4096 + 128 + c; }
    const bf16_t* KVh = KV + h * 256;
#define KVROW(k0) (((k0) < nctx) ? (ctx0 + (k0)) : (lat0 + (k0) - nctx))
#define DMA_TILE(t) do { const int _rb = KVROW((t) * 64); const bf16_t* _kv = KVh + (size_t)_rb * 4096; const bf16_t* _kr = KROPE + (size_t)_rb * 64; \
    LAS char* _kb = lds + ((t) % 3) * SHM_KV; \
    _Pragma("unroll") for (int _i = 0; _i < 3; ++_i) __builtin_amdgcn_global_load_lds((const unsigned*)((krope[_i] ? _kr : _kv) + koff[_i]), (LAS unsigned*)(_kb + (wid + 8 * _i) * 1024), 16, 0, 0); \
    _Pragma("unroll") for (int _i = 0; _i < 2; ++_i) __builtin_amdgcn_global_load_lds((const unsigned*)(_kv + voff[_i]), (LAS unsigned*)(_kb + SHM_K + (wid + 8 * _i) * 1024), 16, 0, 0); } while (0)
#define KBUF(t) (lds + ((t) % 3) * SHM_KV)
#define VBASE(t) ((int)(uintptr_t)(lds + ((t) % 3) * SHM_KV + SHM_K) + vrb)
#define LANDED() do { asm volatile("s_waitcnt vmcnt(0)" ::: "memory"); __syncthreads(); } while (0)
#define RESC(a) do { if (__any((a) < 1.f)) { if (hi == 0) al_l[r32] = (a); asm volatile("s_waitcnt lgkmcnt(0)" ::: "memory"); \
    _Pragma("unroll") for (int d = 0; d < 4; ++d) _Pragma("unroll") for (int r = 0; r < 16; ++r) o[d][r] *= al_l[crow(r, hi)]; } } while (0)
    f32x16 pA0, pA1, pB0, pB1; float mnA, mnB, alA, alB; bf16x8 pa0, pa1, pa2, pa3; const int NT = nkeys / 64;
    __syncthreads();
    DMA_TILE(0); DMA_TILE(1);
    float m_reg = -1e30f, l_reg = 0; f32x16 o[4] = {}; bf16x8 qr[12];
    const bf16_t* Qw = Q + (size_t)(q0 + wid * 32 + r32) * 3072 + h * 192 + hi * 8;
#pragma unroll
    for (int d0 = 0; d0 < 12; ++d0) qr[d0] = *reinterpret_cast<const bf16x8*>(Qw + d0 * 16);
    if (rope_t0 >= 0) {
        const int t = rope_t0 + wid * 32 + r32;
#pragma unroll
        for (int part = 0; part < 2; ++part) {
            const int pos = part ? (t & 63) : (t >> 6);
            const u32x4 x1 = *reinterpret_cast<u32x4*>(&qr[8 + 2 * part]), x2 = *reinterpret_cast<u32x4*>(&qr[9 + 2 * part]);
            float a[8], bq[8], o1[8], o2[8];
#pragma unroll
            for (int e = 0; e < 4; ++e) { a[2 * e] = bflo(x1[e]); a[2 * e + 1] = bfhi(x1[e]); bq[2 * e] = bflo(x2[e]); bq[2 * e + 1] = bfhi(x2[e]); }
#pragma unroll
            for (int e = 0; e < 8; ++e) { const f32x2 cssn = *(const f32x2*)(RT + (pos * 16 + hi * 8 + e) * 2); o1[e] = a[e] * cssn.x - bq[e] * cssn.y; o2[e] = bq[e] * cssn.x + a[e] * cssn.y; }
            u32x4 w1, w2;
            w1.x = cvt_pk_bf16(o1[0], o1[1]); w1.y = cvt_pk_bf16(o1[2], o1[3]); w1.z = cvt_pk_bf16(o1[4], o1[5]); w1.w = cvt_pk_bf16(o1[6], o1[7]);
            w2.x = cvt_pk_bf16(o2[0], o2[1]); w2.y = cvt_pk_bf16(o2[2], o2[3]); w2.z = cvt_pk_bf16(o2[4], o2[5]); w2.w = cvt_pk_bf16(o2[6], o2[7]);
            qr[8 + 2 * part] = *reinterpret_cast<bf16x8*>(&w1); qr[9 + 2 * part] = *reinterpret_cast<bf16x8*>(&w2);
        }
    }
    LANDED();
    qkt(pA0, pA1, KBUF(0), qr, r32, hi); partialSM(pA0, pA1, m_reg, mnA, alA);
    LANDED();
#define STEP(c0, c1, mnc, alc, p0_, p1_, alp, j, more) do { \
    if (more) DMA_TILE((j) + 1); \
    SBAR(); qkt(c0, c1, KBUF(j), qr, r32, hi); \
    finishSM(p0_, p1_, alp, l_reg, pa0, pa1, pa2, pa3); SBAR(); \
    pv_d0(o, VBASE((j) - 1), pa0, pa1, pa2, pa3); partialSM(c0, c1, m_reg, mnc, alc); \
    RESC(alc); LANDED(); } while (0)
    int j = 1;
    for (; j + 1 < NT; j += 2) {
        STEP(pB0, pB1, mnB, alB, pA0, pA1, alA, j, true);
        STEP(pA0, pA1, mnA, alA, pB0, pB1, alB, j + 1, true);
    }
    STEP(pB0, pB1, mnB, alB, pA0, pA1, alA, j, false);
    finishSM(pB0, pB1, alB, l_reg, pa0, pa1, pa2, pa3); SBAR();
    pv_d0(o, VBASE(j), pa0, pa1, pa2, pa3);
    if (hi == 0) li_l[r32] = l_reg; asm volatile("s_waitcnt lgkmcnt(0)" ::: "memory");
    float rli[16];
#pragma unroll
    for (int r = 0; r < 16; ++r) rli[r] = __builtin_amdgcn_rcpf(li_l[crow(r, hi)]);
    unsigned char* Ow = (unsigned char*)O + (size_t)(q0 + wid * 32) * (2 * D) + h * 128;
#pragma unroll
    for (int r = 0; r < 16; ++r) { const int orow = crow(r, hi); const float rs = rli[r] * 16.f;
#pragma unroll
        for (int d0 = 0; d0 < 4; ++d0) { const float val = __builtin_amdgcn_fmed3f(o[d0][r] * rs, -448.f, 448.f); Ow[(size_t)orow * (2 * D) + d0 * 32 + r32] = (unsigned char)__builtin_amdgcn_cvt_pk_fp8_f32(val, val, 0, false); } }
#undef KVROW
#undef DMA_TILE
#undef KBUF
#undef VBASE
#undef LANDED
#undef RESC
#undef STEP
}
}

__device__ __forceinline__ void phase_attention(const Params& p, bool last, LAS unsigned char* lds) {
    unsigned char* ws = lws(p.ws);
    const bf16_t* Q = (const bf16_t*)(ws + WS_Q); const bf16_t* KV = (const bf16_t*)(ws + WS_KV); const bf16_t* KROPE = (const bf16_t*)(ws + WS_KROPE);
    bf16_t* O = (bf16_t*)(ws + WS_YC); const float* RT = (const float*)(ws + WS_RT);
    const int nctxu = last ? 0 : 64, total = nctxu + 1024;
    for (int u = lbid(); u < total; u += gridDim.x) {
        if (u < nctxu) {
            const int b = u >> 4, h = u & 15;
            att::attn_unit(Q, KV, KROPE, O, RT, RL + b * 256, h, RL + b * 256, 0, 256, 256, -1, (LAS char*)lds);
        } else {
            int v = u - nctxu;
            if (gridDim.x == 256) {
                const int k = v >> 8, c = v & 255;
                v = (((k << 4) + ((c & 7) << 1) + (c >> 7)) << 4) | ((c >> 3) & 15);
            }
            const int qb = v & 15, h = (v >> 4) & 15, b = v >> 8;
            att::attn_unit(Q, KV, KROPE, O, RT, b * 4096 + qb * 256, h, RL + b * 256, b * 4096, 256, 4352, qb * 256, (LAS char*)lds);
        }
    }
    __syncthreads();
}

__device__ __forceinline__ void ins16(float (&a)[16], float x) {
#pragma unroll
    for (int k = 0; k < 16; ++k) { const float t = fmaxf(a[k], x); x = fminf(a[k], x); a[k] = t; }
}
__device__ __forceinline__ void phase_peer_select(const Params& p, int nrows, LAS unsigned char* lds, int row0 = 0, int nb = 0) {
    unsigned char* ws = lws(p.ws);
    const int tid = ltid(), wid = tid >> 6, lane = tid & 63, r32 = lane & 31, hi = lane >> 5;
    const bf16_t* PQ = (const bf16_t*)(ws + WS_PQ); const bf16_t* KEYS = (const bf16_t*)(ws + WS_KEYS);
    int* IDX = (int*)(ws + WS_IDX); float* GATE = (float*)(ws + WS_GATE);
    const int nwu = (nrows / 32) * 8;
    for (int wu = (row0 / 32) * 8 + lbid() * 8 + wid; wu < nwu; wu += (nb ? nb : (int)gridDim.x) * 8) {
        const int h = wu & 7, tb = wu >> 3, row = tb * 32 + r32;
        float top[2][16];
#pragma unroll
        for (int pp = 0; pp < 2; ++pp) {
            bf16x8 qb[8];
#pragma unroll
            for (int s = 0; s < 8; ++s) qb[s] = *(const bf16x8*)(PQ + (size_t)row * D + h * 256 + pp * 128 + s * 16 + hi * 8);
            float a[16];
#pragma unroll
            for (int k = 0; k < 16; ++k) a[k] = -INFINITY;
#pragma unroll 1
            for (int kt = 0; kt < 4; ++kt) {
                f32x16 acc = (f32x16){0.f};
                const bf16_t* kp = KEYS + ((size_t)(pp * 8 + h) * 128 + kt * 32 + r32) * 128 + hi * 8;
#pragma unroll
                for (int s = 0; s < 8; ++s) acc = __builtin_amdgcn_mfma_f32_32x32x16_bf16(*(const bf16x8*)(kp + s * 16), qb[s], acc, 0, 0, 0);
#pragma unroll
                for (int r = 0; r < 16; ++r) {
                    const unsigned key = kt * 32 + crow(r, hi);
                    ins16(a, __uint_as_float((__float_as_uint(acc[r]) & ~0x7Fu) | key));
                }
            }
            float o[16];
#pragma unroll
            for (int k = 0; k < 16; ++k) o[k] = __shfl_xor(a[k], 32);
#pragma unroll
            for (int k = 0; k < 16; ++k) ins16(a, o[k]);
#pragma unroll
            for (int k = 0; k < 16; ++k) top[pp][k] = a[k];
        }
        LAS int* lut = (LAS int*)lds + wid * 2048 + lane;
#pragma unroll
        for (int k = 0; k < 16; ++k) { lut[k * 64] = (int)(__float_as_uint(top[0][k]) & 0x7Fu); lut[(16 + k) * 64] = (int)(__float_as_uint(top[1][k]) & 0x7Fu); }
        float best[16]; int bid[16];
#pragma unroll
        for (int k = 0; k < 16; ++k) best[k] = -INFINITY;
#pragma unroll
        for (int i = 0; i < 16; ++i)
#pragma unroll
            for (int j = 0; j < 16; ++j) {
                if ((i + 1) * (j + 1) <= 16) {
                    const float v = __uint_as_float(__float_as_uint(top[0][i]) & ~0x7Fu) + __uint_as_float(__float_as_uint(top[1][j]) & ~0x7Fu);
                    ins16(best, __uint_as_float((__float_as_uint(v) & ~0xFFu) | (unsigned)(i * 16 + j)));
                }
            }
        asm volatile("s_waitcnt lgkmcnt(0)" ::: "memory");
#pragma unroll
        for (int k = 0; k < 16; ++k) {
            const unsigned code = __float_as_uint(best[k]) & 0xFFu;
            bid[k] = lut[(code >> 4) * 64] * 128 + lut[(16 + (code & 15u)) * 64];
            best[k] = __uint_as_float(__float_as_uint(best[k]) & ~0xFFu);
        }
        float e[16], sum = 0.f;
#pragma unroll
        for (int k = 0; k < 16; ++k) { e[k] = __expf(best[k] - best[0]); sum += e[k]; }
        const float inv = 1.f / sum;
        if (hi == 0) {
#pragma unroll
            for (int k4 = 0; k4 < 4; ++k4) {
                *(int4*)(IDX + (size_t)row * 128 + h * 16 + k4 * 4) = make_int4(bid[k4 * 4], bid[k4 * 4 + 1], bid[k4 * 4 + 2], bid[k4 * 4 + 3]);
                *(f32x4*)(GATE + (size_t)row * 128 + h * 16 + k4 * 4) = (f32x4){e[k4 * 4] * inv, e[k4 * 4 + 1] * inv, e[k4 * 4 + 2] * inv, e[k4 * 4 + 3] * inv};
            }
        }
    }
}

typedef _Float16 f16x2 __attribute__((ext_vector_type(2)));
__device__ __forceinline__ float dot32_fp4(const u32x4 w, const f16x2* h) {
    float s0 = 0.f, s1 = 0.f, s2 = 0.f, s3 = 0.f;
#define DOT_D(d, acc) { acc = __builtin_amdgcn_fdot2(__builtin_bit_cast(f16x2, __builtin_amdgcn_cvt_scalef32_pk_f16_fp4(w[d], 1.0f, 0)), h[4 * d + 0], acc, false); \
    acc = __builtin_amdgcn_fdot2(__builtin_bit_cast(f16x2, __builtin_amdgcn_cvt_scalef32_pk_f16_fp4(w[d], 1.0f, 1)), h[4 * d + 1], acc, false); \
    acc = __builtin_amdgcn_fdot2(__builtin_bit_cast(f16x2, __builtin_amdgcn_cvt_scalef32_pk_f16_fp4(w[d], 1.0f, 2)), h[4 * d + 2], acc, false); \
    acc = __builtin_amdgcn_fdot2(__builtin_bit_cast(f16x2, __builtin_amdgcn_cvt_scalef32_pk_f16_fp4(w[d], 1.0f, 3)), h[4 * d + 3], acc, false); }
    DOT_D(0, s0) DOT_D(1, s1) DOT_D(2, s2) DOT_D(3, s3)
#undef DOT_D
    return (s0 + s1) + (s2 + s3);
}
__device__ __forceinline__ float dot32_i4(const u32x4 w, const unsigned (&ha)[4], const unsigned (&hb)[4]) {
    int hi = __builtin_amdgcn_sdot8((int)w[0], (int)ha[0], 0, false), lo = __builtin_amdgcn_sdot8((int)w[0], (int)hb[0], 0, false);
#pragma unroll
    for (int d = 1; d < 4; ++d) { hi = __builtin_amdgcn_sdot8((int)w[d], (int)ha[d], hi, false); lo = __builtin_amdgcn_sdot8((int)w[d], (int)hb[d], lo, false); }
    return (float)((hi << 4) + lo);
}
__device__ __forceinline__ void axpy32_fp4(f16x2* o, const u32x4 w, const f16x2 a) {
#define AXPY_B(d, b) o[4 * d + b] = __builtin_elementwise_fma(__builtin_bit_cast(f16x2, __builtin_amdgcn_cvt_scalef32_pk_f16_fp4(w[d], 1.0f, b)), a, o[4 * d + b]);
#pragma unroll
    for (int d = 0; d < 4; ++d) { AXPY_B(d, 0) AXPY_B(d, 1) AXPY_B(d, 2) AXPY_B(d, 3) }
#undef AXPY_B
}
__device__ __forceinline__ float reduce8(const float (&v)[8], int lane) {
    const bool h5 = lane & 32, h4 = lane & 16, h3 = lane & 8;
    float a[4];
#pragma unroll
    for (int i = 0; i < 4; ++i) a[i] = (h5 ? v[4 + i] : v[i]) + __shfl_xor(h5 ? v[i] : v[4 + i], 32);
    float b[2];
#pragma unroll
    for (int i = 0; i < 2; ++i) b[i] = (h4 ? a[2 + i] : a[i]) + __shfl_xor(h4 ? a[i] : a[2 + i], 16);
    float c = (h3 ? b[1] : b[0]) + __shfl_xor(h3 ? b[0] : b[1], 8);
    c += __shfl_xor(c, 4); c += __shfl_xor(c, 2); c += __shfl_xor(c, 1);
    return c;
}
__device__ __forceinline__ float reduce4(const float (&v)[4], int lane) {
    return row_sum16(swap_add16(swap_add32(v[0], v[2]), swap_add32(v[1], v[3])));
}
struct RowMap { int a0, sA, nA, b0, sB, n; __device__ __forceinline__ int operator()(int v) const { return v < nA ? a0 + v * sA : b0 + (v - nA) * sB; } };
__device__ __forceinline__ void phase_peer_gather(const Params& p, int l, bool last, const RowMap rm, LAS unsigned char* lds, int dry = 0) {
    unsigned char* ws = lws(p.ws);
    const int tid = ltid(), wid = tid >> 6, lane = tid & 63;
    const unsigned char* UT4 = ws + WS_UT; const unsigned char* VT4 = ws + WS_VT;
    const int* IDX = (const int*)(ws + WS_IDX); const float* GATE = (const float*)(ws + WS_GATE);
    const float* modl = (const float*)(ws + WS_MOD) + (size_t)l * 5 * NMOD;
    LAS float* actw = (LAS float*)lds + wid * 128;
    const int pself = ((lane >> 5) & 1) * 2 + ((lane >> 4) & 1);
#define ROWIN(r, IA, IB, GA, GB) do { IA = IDX[(size_t)(r) * 128 + lane]; IB = IDX[(size_t)(r) * 128 + 64 + lane]; GA = GATE[(size_t)(r) * 128 + lane]; GB = GATE[(size_t)(r) * 128 + 64 + lane]; } while (0)
#define XLOAD(r, XR) do { const float* _xp = ((r) >= RL) ? (const float*)(ws + WS_XC) + (size_t)((r) - RL) * D : p.out + (size_t)(r) * D; _Pragma("unroll") for (int q = 0; q < 8; ++q) XR[q] = *(const f32x4*)(_xp + lane * 32 + q * 4); } while (0)
    int idxA = 0, idxB = 0; float gA = 0.f, gB = 0.f;
    f32x4 xrow[8];
    int row = rm(0);
    if (rm.n > 0) { ROWIN(row, idxA, idxB, gA, gB); XLOAD(row, xrow); }
    for (int v = 0; v < rm.n; ++v) {
        const bool isc = row >= RL;
        const int mrow = isc ? 4 : (row >> 12);
#define GSEL(g, A, B) ((int)(((unsigned)(A) & (((g) < 16) ? 0xFFFFFFFFu : 0u)) | ((unsigned)(B) & (((g) < 16) ? 0u : 0xFFFFFFFFu))))
#define TLOAD(buf, g, T4) do { const int _si = GSEL(g, idxA, idxB); _Pragma("unroll") for (int q = 0; q < 4; ++q) { const int _e = __builtin_amdgcn_readlane(_si, ((g) * 4 + q) & 63); buf[q] = *(const GAS u32x4*)((const GAS unsigned char*)(T4) + (size_t)_e * 1024 + (unsigned)(lane * 16)); } } while (0)
        u32x4 b0[4], b1[4], b2[4], b3[4], b4[4], b5[4];
        TLOAD(b0, 0, UT4); TLOAD(b1, 1, UT4); TLOAD(b2, 2, UT4); TLOAD(b3, 3, UT4); TLOAD(b4, 4, UT4);
        unsigned ha[4], hb[4]; float kact, halfsq;
        {
            float ssx = 0.f;
#pragma unroll
            for (int q = 0; q < 8; ++q)
#pragma unroll
                for (int e = 0; e < 4; ++e) ssx += xrow[q][e] * xrow[q][e];
            ssx = wave_sum(ssx);
            const float rstd2 = rsqrtf(ssx * (1.f / D) + RMS_EPS);
            const float* g2p = p.in[7] + l * D + lane * 32; const float* scp = modl + (size_t)mrow * NMOD + 4 * D + lane * 32; const float* shp = modl + (size_t)mrow * NMOD + 3 * D + lane * 32;
            float hv[32]; float am = 0.f;
#pragma unroll
            for (int q = 0; q < 8; ++q) {
                const f32x4 g2 = *(const f32x4*)(g2p + q * 4), sc = *(const f32x4*)(scp + q * 4), sh = *(const f32x4*)(shp + q * 4);
#pragma unroll
                for (int e = 0; e < 4; ++e) { const float hval = xrow[q][e] * rstd2 * g2[e] * (1.f + sc[e]) + sh[e]; hv[q * 4 + e] = hval; am = fmaxf(am, fabsf(hval)); }
            }
            am = wave_max(am);
            const float hs = am > 0.f ? 119.f / am : 0.f;
            int sq = 0;
#pragma unroll
            for (int d = 0; d < 4; ++d) {
                unsigned A = 0u, Bn = 0u;
#pragma unroll
                for (int i = 0; i < 8; ++i) {
                    const int q0 = __float2int_rn(hv[d * 8 + i] * hs);
                    sq += q0;
                    Bn |= ((unsigned)q0 & 15u) << (4 * i);
                    A |= ((unsigned)((q0 + 8) >> 4) & 15u) << (4 * i);
                }
                ha[d] = A; hb[d] = Bn;
            }
            halfsq = 0.5f * wave_sum((float)sq);
            kact = am * (1.f / (119.f * U_IDELTA));
        }
#define UCOMP(buf, g) do { float part[4]; if (dry == 2) { _Pragma("unroll") for (int q = 0; q < 4; ++q) part[q] = __uint_as_float(buf[q].x ^ buf[q].y ^ buf[q].z ^ buf[q].w); } else _Pragma("unroll") for (int q = 0; q < 4; ++q) part[q] = dot32_i4(buf[q], ha, hb); \
        const float _r = reduce4(part, lane); if ((lane & 15) == 0) actw[(g) * 4 + pself] = (_r + halfsq) * kact; } while (0)
        {
#pragma unroll 1
            for (int g = 0; g < 30; g += 6) {
                TLOAD(b5, g + 5, UT4); UCOMP(b0, g);
                TLOAD(b0, g + 6, UT4); UCOMP(b1, g + 1);
                TLOAD(b1, g + 7, UT4); UCOMP(b2, g + 2);
                if (g + 8 < 32) TLOAD(b2, g + 8, UT4);
                UCOMP(b3, g + 3);
                if (g + 9 < 32) TLOAD(b3, g + 9, UT4);
                UCOMP(b4, g + 4);
                if (g + 10 < 32) TLOAD(b4, g + 10, UT4);
                UCOMP(b5, g + 5);
            }
            UCOMP(b0, 30); UCOMP(b1, 31);
        }
        u32x4 vb0[4], vb1[4], vb2[4];
        TLOAD(vb0, 0, VT4); TLOAD(vb1, 1, VT4);
        asm volatile("s_waitcnt lgkmcnt(0)" ::: "memory");
        const float aA = actw[lane], aB = actw[64 + lane];
        const float wA = gA * 0.5f * aA * (1.f + erff(aA * 0.70710678118654752f)) * (1.f / V_SCALE), wB = gB * 0.5f * aB * (1.f + erff(aB * 0.70710678118654752f)) * (1.f / V_SCALE);
        const int whA = (int)__builtin_bit_cast(unsigned, (f16x2){(_Float16)wA, (_Float16)wA}), whB = (int)__builtin_bit_cast(unsigned, (f16x2){(_Float16)wB, (_Float16)wB});
#define VCOMP(buf, g) do { if (dry == 2) { _Pragma("unroll") for (int q = 0; q < 4; ++q) out[q] += __uint_as_float(buf[q].x ^ buf[q].y ^ buf[q].z ^ buf[q].w); } else { const int _sw = GSEL(g, whA, whB); _Pragma("unroll") for (int q = 0; q < 4; ++q) { const f16x2 _w2 = __builtin_bit_cast(f16x2, (unsigned)__builtin_amdgcn_readlane(_sw, ((g) * 4 + q) & 63)); axpy32_fp4(oh, buf[q], _w2); } } } while (0)
        float* xr = isc ? (float*)(ws + WS_XC) + (size_t)(row - RL) * D : p.out + (size_t)row * D;
        const float* gp = modl + (size_t)mrow * NMOD + 5 * D;
        f32x4 grow[8];
#pragma unroll
        for (int q = 0; q < 8; ++q) grow[q] = *(const f32x4*)(gp + lane * 32 + q * 4);
        float out[32]; f16x2 oh[16];
#pragma unroll
        for (int e = 0; e < 16; ++e) oh[e] = (f16x2){(_Float16)0.f, (_Float16)0.f};
#pragma unroll
        for (int e = 0; e < 4; ++e) out[e] = 0.f;
        {
#pragma unroll 1
            for (int g = 0; g < 30; g += 3) {
                TLOAD(vb2, g + 2, VT4); VCOMP(vb0, g);
                TLOAD(vb0, g + 3, VT4); VCOMP(vb1, g + 1);
                TLOAD(vb1, g + 4, VT4); VCOMP(vb2, g + 2);
            }
            VCOMP(vb0, 30); VCOMP(vb1, 31);
        }
        if (dry != 2) {
#pragma unroll
            for (int e = 0; e < 16; ++e) { out[2 * e] = (float)oh[e].x; out[2 * e + 1] = (float)oh[e].y; }
        }
#undef GSEL
#undef TLOAD
#undef UCOMP
#undef VCOMP
        float x[32]; float ss = 0.f;
#pragma unroll
        for (int q = 0; q < 8; ++q) {
            const f32x4 xv = xrow[q], gv = grow[q];
#pragma unroll
            for (int e = 0; e < 4; ++e) { const float t = xv[e] + gv[e] * out[q * 4 + e]; x[q * 4 + e] = t; ss += t * t; }
        }
        ss = wave_sum(ss);
        const float rstd = rsqrtf(ss * (1.f / D) + RMS_EPS);
        int nia = 0, nib = 0; float nga = 0.f, ngb = 0.f;
        const bool more = v + 1 < rm.n;
        const int nrow = rm(v + 1);
        if (more) { ROWIN(nrow, nia, nib, nga, ngb); XLOAD(nrow, xrow); }
#define ROWNEXT() do { idxA = nia; idxB = nib; gA = nga; gB = ngb; row = nrow; } while (0)
        if (dry) { if (rstd == 123.456f) xr[lane] = rstd; ROWNEXT(); continue; }
        if (last) {
            const float* fn = p.in[25];
#pragma unroll
            for (int q = 0; q < 8; ++q) {
                const int c = lane * 32 + q * 4;
                const f32x4 f0 = *(const f32x4*)(fn + c);
                f32x4 o0;
#pragma unroll
                for (int e = 0; e < 4; ++e) o0[e] = x[q * 4 + e] * rstd * f0[e];
                *(f32x4*)(xr + c) = o0;
            }
        } else {
            const float* modn = (const float*)(ws + WS_MOD) + (size_t)(l + 1) * 5 * NMOD + (size_t)mrow * NMOD;
            const float* gain = p.in[6] + (l + 1) * D;
            bf16_t* hrow = (bf16_t*)(ws + WS_H) + (size_t)row * D;
#pragma unroll
            for (int q2 = 0; q2 < 4; ++q2) {
                float o[8];
#pragma unroll
                for (int q = 0; q < 2; ++q) {
                    const int c = lane * 32 + q2 * 8 + q * 4;
                    *(f32x4*)(xr + c) = (f32x4){x[q2 * 8 + q * 4], x[q2 * 8 + q * 4 + 1], x[q2 * 8 + q * 4 + 2], x[q2 * 8 + q * 4 + 3]};
                    const f32x4 g = *(const f32x4*)(gain + c), sh = *(const f32x4*)(modn + c), sc = *(const f32x4*)(modn + D + c);
#pragma unroll
                    for (int e = 0; e < 4; ++e) o[q * 4 + e] = x[q2 * 8 + q * 4 + e] * rstd * g[e] * (1.f + sc[e]) + sh[e];
                }
                u32x4 w0;
                w0.x = cvt_pk_bf16(o[0], o[1]); w0.y = cvt_pk_bf16(o[2], o[3]); w0.z = cvt_pk_bf16(o[4], o[5]); w0.w = cvt_pk_bf16(o[6], o[7]);
                *(u32x4*)(hrow + lane * 32 + q2 * 8) = w0;
                *(u32x2*)(ws + WS_H8 + (size_t)row * D + lane * 32 + q2 * 8) = (u32x2){pack4_fp8(o[0], o[1], o[2], o[3]), pack4_fp8(o[4], o[5], o[6], o[7])};
            }
        }
        ROWNEXT();
    }
#undef ROWIN
#undef XLOAD
#undef ROWNEXT
}

#ifdef DIAG_SCAN
__device__ __forceinline__ void dscan_bf16(const void* ptr, size_t nelem, unsigned* word, unsigned k) {
    const u32x4* q = (const u32x4*)ptr; const size_t n8 = nelem / 8; bool bad = false;
    for (size_t i = (size_t)lbid() * 512 + ltid(); i < n8; i += (size_t)gridDim.x * 512) {
        const u32x4 w = q[i];
#pragma unroll
        for (int e = 0; e < 4; ++e) { bad |= ((w[e] & 0x7F80u) == 0x7F80u); bad |= ((w[e] & 0x7F800000u) == 0x7F800000u); }
    }
    if (bad) atomicMax(word, 1000u - k);
}
__device__ __forceinline__ void dscan_f32(const void* ptr, size_t nelem, unsigned* word, unsigned k) {
    const unsigned* q = (const unsigned*)ptr; bool bad = false;
    for (size_t i = (size_t)lbid() * 512 + ltid(); i < nelem; i += (size_t)gridDim.x * 512) bad |= ((q[i] & 0x7F800000u) == 0x7F800000u);
    if (bad) atomicMax(word, 1000u - k);
}
#define DSB(off, n, k) if ((k) < 11) dscan_bf16(ws + (off), (size_t)(n), (unsigned*)(ws + WS_CTL) + 8192, (unsigned)(l * 16 + (k)))
#define DSF(off, n, k) if ((k) < 11) dscan_f32(ws + (off), (size_t)(n), (unsigned*)(ws + WS_CTL) + 8192, (unsigned)(l * 16 + (k)))
#else
#define DSB(off, n, k) do {} while (0)
#define DSF(off, n, k) do {} while (0)
#endif
__global__ void __launch_bounds__(512, 2) fwd_kernel(Params p) {
    extern __shared__ __attribute__((aligned(16))) unsigned char lds_raw[];
    LAS unsigned char* lds = (LAS unsigned char*)lds_raw;
    unsigned char* ws = p.ws;
    const int G = gridDim.x;
#if MK_ONE_LAUNCH
    if (threadIdx.x < 4) ((LAS unsigned*)(lds + LDS_BARW))[threadIdx.x] = 0u;
    __syncthreads();
    XcdBarrier bar = xcd_barrier_post((unsigned*)(ws + WS_CTL), (volatile LAS unsigned*)(lds + LDS_BARW));
#define GRID_BAR() xcd_barrier(bar)
#else
#define GRID_BAR() do {} while (0)
#endif
    const int lo = p.ph_lo, hi = p.ph_hi;
#define IN(k) (lo <= (k) && (k) < hi)
#define SEAM(k) do { if (IN(k) && IN((k) + 1)) { GRID_BAR(); if (PROBE_DUP == 20) GRID_BAR(); } } while (0)
    for (int l = 0; l < 2; ++l) {
        unsigned char* const ws = lws(p.ws);
        const bool last = (l == 1);
        const int base = l * NPH;
        const int nrows = last ? RL : ROWS;
        const float* modl = (const float*)(ws + WS_MOD) + (size_t)l * 5 * NMOD;
        const float* xin_l = (l == 0) ? p.in[0] : p.out;
        const float* xin_c = (l == 0) ? p.in[2] : (const float*)(ws + WS_XC);
        if (PH_ON(0) && IN(base + 0)) { DUP(0) phase_convert(p, l, lds); }
        SEAM(base + 0);
        if (PH_ON(1) && IN(base + 1)) { DSF(WS_MOD, 2 * 5 * NMOD, 1); DSB(WS_WIN, (WS_H - WS_WIN) / 2, 2); }
        if (PH_ON(1) && IN(base + 1) && l == 0) { phase_modulate(xin_l, xin_c, p.in[6] + l * D, modl, 0, 1, (bf16_t*)(ws + WS_H), ws + WS_H8, ROWS); }
        if (l == 0) SEAM(base + 1);
        if (PH_ON(2) && IN(base + 2)) {
            DSB(WS_H, (size_t)ROWS * D, 3);
            DUP(2) {
            if (SUB_ON(8)) {
                pg8::Gemm g{ws + WS_H8, ws + WS_WIN8, ROWS, NIN8, D, D, D, 0};
                pg8::StaticOrder S;
                if (!last) { S.init(ROWS, NIN8, G, lbid());
                    if (G == 256) S.set_tail(10, 48, 208); }
                else { S.init(RL, NIN8, G, lbid()); S.set_extra(4 * 11, 11, 0, -1);
                    if (G == 256) S.set_tail(10, 16, 240); }
                EpiWin8 E{ws, (const float*)(ws + WS_LB) + l * 4096};
                pg8::gemm_phase<true>(lds, g, S, E); }
            if (SUB_ON(9)) {
                pg8::Gemm g{ws + WS_H, ws + WS_WINF, ROWS, NINF, 2 * D, 2 * D, 2 * D, 0};
                pg8::StaticOrder S;
                if (!last) S.init(ROWS, NINF, G, lbid());
                else { S.init(RL, NINF, G, lbid()); S.set_extra(4 * 4, 4, 4, 0); }
                EpiLF E{ws, (const float*)(ws + WS_LB) + l * 4096};
                pg8::gemm_phase<false>(lds, g, S, E); }
            }
        }
        SEAM(base + 2);
        if (PH_ON(3) && IN(base + 3)) { DSB(WS_QH, (WS_GT - WS_QH) / 2, 4); DSB(WS_GT, (size_t)ROWS * 6144, 5); DSF(WS_KR, (size_t)ROWS * 64, 6); }
        if (PH_ON(3) && IN(base + 3)) { DUP(3) { if (SUB_ON(0)) { phase_misc(p, nrows); phase_cb(p, modl); } } DUP(13) { if (SUB_ON(1)) hgrn_local(p, lds); } }
        SEAM(base + 3);
        if (PH_ON(4) && IN(base + 4)) {
            DSF(WS_RSTD, 2 * ROWS, 7); DSB(WS_KROPE, (size_t)ROWS * 64, 7); DSB(WS_PYA, (size_t)nrows * 1024, 7); DSB(WS_ST, (size_t)NSTREAM * NCH * 16384, 8); DSF(WS_DEC, (size_t)NSTREAM * NCH * 128, 8);
            __syncthreads();
            if (SUB_ON(4)) hgrn_scan(p);
            DUP(4) {
            if (SUB_ON(5)) {   pg8::Gemm g{ws + WS_CQ8, ws + WS_WUQ, nrows, 3072, 512, 512, 512, 0};
                pg8::StaticOrder S; S.init(nrows, 3072, G, lbid());
                EpiScale<1> E{(bf16_t*)(ws + WS_Q), 3072, (const float*)(ws + WS_RSTD), 1.f / 32.f};
                pg8::gemm_phase<true>(lds, g, S, E); }
            if (SUB_ON(6)) {   pg8::Gemm g{ws + WS_CKV8, ws + WS_WUKV, ROWS, 4096, 512, 512, 512, 0};
                pg8::StaticOrder S; S.init(ROWS, 4096, G, (lbid() + G - 48) % G);
                EpiScale<1> E{(bf16_t*)(ws + WS_KV), 4096, (const float*)(ws + WS_RSTD) + ROWS, 1.f / 32.f};
                pg8::gemm_phase<true>(lds, g, S, E); }
            if (SUB_ON(7)) {   pg8::Gemm g{ws + WS_PYA, ws + WS_POOLT, nrows, 1024, 512, 2048, 512, 512};
                pg8::StaticOrder S; S.init(nrows, 1024, G, (lbid() + G - 112) % G);
                EpiScale<2> E{(bf16_t*)(ws + WS_YB), 1024, p.in[12] + l * 1024};
                pg8::gemm_phase<false>(lds, g, S, E); }
            }
        }
        SEAM(base + 4);
        if (PH_ON(5) && IN(base + 5)) { DSB(WS_Q, (size_t)nrows * 3072, 9); DSB(WS_KV, (size_t)ROWS * 4096, 9); DSB(WS_YB, (size_t)nrows * 1024, 9); DSB(WS_ST, (size_t)NSTREAM * NCH * 16384, 9); }
        if (PH_ON(5) && IN(base + 5)) { DUP(5) { if (SUB_ON(2)) phase_attention(p, last, lds); } DUP(15) { if (SUB_ON(3)) hgrn_out(p, l, last, lds); } }
        SEAM(base + 5);
        const bool side = CTX_SIDE && !last && G > 2 * NSUBC;
        const int nr6 = side ? RL : nrows;
        if (PH_ON(6) && IN(base + 6)) DUP(6) {
            {   pg8::Gemm g{ws + WS_PYA, ws + WS_WA, nr6, D, 1024, 2048, 1024, 0};
                pg8::StaticOrder S; S.init(nr6, D, G, lbid());
                EpiMerge<0> E{(bf16_t*)(ws + WS_M), (const bf16_t*)(ws + WS_GT), 0, 1.f / 256.f};
                pg8::gemm_phase<true>(lds, g, S, E); }
            {   pg8::Gemm g{ws + WS_YB, ws + WS_WB, nr6, D, 1024, 2048, 1024, 0};
                pg8::StaticOrder S; S.init(nr6, D, G, lbid());
                EpiMerge<1> E{(bf16_t*)(ws + WS_M), (const bf16_t*)(ws + WS_GT), D, 1.f / 128.f};
                pg8::gemm_phase<true>(lds, g, S, E); }
            {   pg8::Gemm g{ws + WS_YC, ws + WS_WC, nr6, D, D, 2 * D, D, 0};
                pg8::StaticOrder S; S.init(nr6, D, G, lbid());
                EpiMerge<1> E{(bf16_t*)(ws + WS_M), (const bf16_t*)(ws + WS_GT), 2 * D, 1.f / 512.f};
                pg8::gemm_phase<true>(lds, g, S, E); }
        }
        SEAM(base + 6);
        if (PH_ON(7) && IN(base + 7)) {
            pg8::Gemm g{ws + WS_M, ws + WS_WO, nr6, D, 2 * D, 2 * D, 2 * D, 0};
            pg8::StaticOrder S; S.init(nr6, D, G, lbid());
            EpiResid E{xin_l, xin_c, p.out, (float*)(ws + WS_XC), modl, p.in[7] + l * D, (bf16_t*)(ws + WS_H), (float*)(ws + WS_SS)};
            for (int _d = 0; _d < ((PROBE_DUP == 7 && l == 0) ? 2 : 1); ++_d) pg8::gemm_phase<false>(lds, g, S, E);
        }
        SEAM(base + 7);
        if (PH_ON(9) && IN(base + 9)) {
            pg8::Gemm g{ws + WS_H, ws + WS_WQ, nr6, D, 2 * D, 2 * D, 2 * D, 0};
            pg8::StaticOrder S; S.init(nr6, D, G, lbid());
            EpiPeerQ E{(bf16_t*)(ws + WS_PQ), (const float*)(ws + WS_SS), (const float*)(ws + WS_CB)};
            DUP(9) pg8::gemm_phase<false>(lds, g, S, E);
        }
        SEAM(base + 9);
        if (PH_ON(10) && IN(base + 10)) { DUP(10) phase_peer_select(p, nr6, lds); }
        SEAM(base + 10);
        if (PH_ON(11) && IN(base + 11)) {
            RowMap rm;
            const int wv = __builtin_amdgcn_readfirstlane(ltid() >> 6);
            if (side) {
                const int W = (G - NSUBC) * 8, L1 = (RL / W) * W;
                if (lbid() < NSUBC) {
                    unsigned char* wsc = lws(p.ws);
                    unsigned* barw = (unsigned*)(wsc + WS_CTL); unsigned tgt = 0u;
                    constexpr int NC = ROWS - RL, PM0 = RL / 256;
                    {   pg8::Gemm g{wsc + WS_PYA, wsc + WS_WA, NC, D, 1024, 2048, 1024, 0};
                        pg8::StaticOrder S; S.init(NC, D, NSUBC, lbid()); S.pm0 = PM0;
                        EpiMerge<0> E{(bf16_t*)(wsc + WS_M), (const bf16_t*)(wsc + WS_GT), 0, 1.f / 256.f};
                        pg8::gemm_phase<true>(lds, g, S, E); }
                    {   pg8::Gemm g{wsc + WS_YB, wsc + WS_WB, NC, D, 1024, 2048, 1024, 0};
                        pg8::StaticOrder S; S.init(NC, D, NSUBC, lbid()); S.pm0 = PM0;
                        EpiMerge<1> E{(bf16_t*)(wsc + WS_M), (const bf16_t*)(wsc + WS_GT), D, 1.f / 128.f};
                        pg8::gemm_phase<true>(lds, g, S, E); }
                    {   pg8::Gemm g{wsc + WS_YC, wsc + WS_WC, NC, D, D, 2 * D, D, 0};
                        pg8::StaticOrder S; S.init(NC, D, NSUBC, lbid()); S.pm0 = PM0;
                        EpiMerge<1> E{(bf16_t*)(wsc + WS_M), (const bf16_t*)(wsc + WS_GT), 2 * D, 1.f / 512.f};
                        pg8::gemm_phase<true>(lds, g, S, E); }
                    sub_barrier(barw, tgt += NSUBC);
                    {   pg8::Gemm g{wsc + WS_M, wsc + WS_WO, NC, D, 2 * D, 2 * D, 2 * D, 0};
                        pg8::StaticOrder S; S.init(NC, D, NSUBC, lbid()); S.pm0 = PM0;
                        EpiResid E{xin_l, xin_c, p.out, (float*)(wsc + WS_XC), modl, p.in[7] + l * D, (bf16_t*)(wsc + WS_H), (float*)(wsc + WS_SS)};
                        pg8::gemm_phase<false>(lds, g, S, E); }
                    sub_barrier(barw, tgt += NSUBC);
                    {   pg8::Gemm g{wsc + WS_H, wsc + WS_WQ, NC, D, 2 * D, 2 * D, 2 * D, 0};
                        pg8::StaticOrder S; S.init(NC, D, NSUBC, lbid()); S.pm0 = PM0;
                        EpiPeerQ E{(bf16_t*)(wsc + WS_PQ), (const float*)(wsc + WS_SS), (const float*)(wsc + WS_CB)};
                        pg8::gemm_phase<false>(lds, g, S, E); }
                    sub_barrier(barw, tgt += NSUBC);
                    phase_peer_select(p, ROWS, lds, RL, NSUBC);
                    sub_barrier(barw, tgt += NSUBC);
                    const int w = lbid() * 8 + wv, sw = NSUBC * 8;
                    rm.a0 = RL + w; rm.sA = sw; rm.nA = (NC - w + sw - 1) / sw;
                    rm.b0 = L1 + w; rm.sB = sw; rm.n = rm.nA + ((rm.b0 < RL) ? (RL - rm.b0 + sw - 1) / sw : 0);
                } else {
                    rm.a0 = (lbid() - NSUBC) * 8 + wv; rm.sA = W; rm.nA = RL / W; rm.b0 = 0; rm.sB = 0; rm.n = rm.nA;
                }
            } else {
                const int w = lbid() * 8 + wv, sw = G * 8;
                rm.a0 = w; rm.sA = sw; rm.nA = (w < nrows) ? (nrows - w + sw - 1) / sw : 0; rm.b0 = 0; rm.sB = 0; rm.n = rm.nA;
            }
            if (PROBE_DUP == 11) phase_peer_gather(p, l, last, rm, lds, 1);
            if (PROBE_DUP == 12) phase_peer_gather(p, l, last, rm, lds, 2);
            phase_peer_gather(p, l, last, rm, lds);
        }
        if (!last) SEAM(base + 11);
    }
#undef IN
#undef SEAM
}


#ifdef DIAG_SCAN
__global__ void diag_fill(float* out, const unsigned* word, int n) {
    const unsigned w = *word;
    if (w == 0u) return;
    const float c = sqrtf(10.f * (float)(1000u - w));
    for (int i = blockIdx.x * blockDim.x + threadIdx.x; i < n; i += gridDim.x * blockDim.x) out[i] = c;
}
#endif
extern "C" void kernel_launch(void* const* d_in, const int* in_sizes, int n_in, void* d_out, int out_size, void* d_ws, size_t ws_size, hipStream_t stream) {
    static int grid = 0;
    if (grid == 0) {
        if (n_in != 26 || out_size != RL * D || ws_size < WS_END) { fprintf(stderr, "kernel_launch: unexpected shapes (n_in %d out %d ws %zu need %zu)\n", n_in, out_size, ws_size, (size_t)WS_END); grid = -1; return; }
        int dev = 0, cus = 0, per_cu = 0;
        if (hipGetDevice(&dev) != hipSuccess || hipDeviceGetAttribute(&cus, hipDeviceAttributeMultiprocessorCount, dev) != hipSuccess) { grid = -1; return; }
        if (hipFuncSetAttribute((const void*)fwd_kernel, hipFuncAttributeMaxDynamicSharedMemorySize, LDS_BYTES) != hipSuccess) { fprintf(stderr, "kernel_launch: hipFuncSetAttribute failed\n"); grid = -1; return; }
        if (hipOccupancyMaxActiveBlocksPerMultiprocessor(&per_cu, (const void*)fwd_kernel, 512, LDS_BYTES) != hipSuccess || per_cu < 1) { fprintf(stderr, "kernel_launch: occupancy query says %d\n", per_cu); }
        (void)hipGetLastError();
        grid = cus;
    }
    if (grid < 0) return;
    hipMemsetAsync((char*)d_ws + WS_CTL, 0, 65536, stream);
    Params p{};
    for (int i = 0; i < 26; ++i) p.in[i] = (const float*)d_in[i];
    p.out = (float*)d_out; p.ws = (unsigned char*)d_ws;
#if MK_ONE_LAUNCH
    p.ph_lo = 0; p.ph_hi = 2 * NPH;
    hipLaunchKernelGGL(fwd_kernel, dim3(grid), dim3(512), LDS_BYTES, stream, p);
#else
    for (int ph = 0; ph < 2 * NPH; ++ph) {
#ifndef DIAG_SCAN
        if (ph == NPH + 1) continue;
#endif
        p.ph_lo = ph; p.ph_hi = ph + 1;
        hipLaunchKernelGGL(fwd_kernel, dim3(grid), dim3(512), LDS_BYTES, stream, p);
    }
#endif
#ifdef DIAG_SCAN
    hipLaunchKernelGGL(diag_fill, dim3(1024), dim3(256), 0, stream, (float*)d_out, (const unsigned*)((char*)d_ws + WS_CTL) + 8192, RL * D);
#endif
}
```

```cpp
#include <hip/hip_runtime.h>
#include <stdint.h>
#include <cstdio>

#define GAS __attribute__((address_space(1)))
#define LAS __attribute__((address_space(3)))
typedef unsigned short bf16_t;
typedef short bf16x8 __attribute__((ext_vector_type(8)));
typedef short s16x4 __attribute__((ext_vector_type(4)));
typedef float f32x2 __attribute__((ext_vector_type(2)));
typedef float f32x4 __attribute__((ext_vector_type(4)));
typedef float f32x16 __attribute__((ext_vector_type(16)));
typedef unsigned u32x4 __attribute__((ext_vector_type(4)));
typedef unsigned u32x2 __attribute__((ext_vector_type(2)));
typedef int i32x4_t __attribute__((ext_vector_type(4)));
typedef int i32x8_t __attribute__((ext_vector_type(8)));

#ifndef MK_ONE_LAUNCH
#define MK_ONE_LAUNCH 1
#define CTX_SIDE 1
#endif
#ifndef PROBE_DUP
#define PROBE_DUP -1
#endif
#define DUP(k) for (int _d = 0; _d < ((PROBE_DUP == (k)) ? 2 : 1); ++_d)
#ifndef PHASE_MASK
#define PHASE_MASK 0xFFF
#endif
#define PH_ON(k) (((PHASE_MASK) >> (k)) & 1)
#ifndef SUB_MASK
#define SUB_MASK 0xFFFF
#endif
#define SUB_ON(k) (((SUB_MASK) >> (k)) & 1)

constexpr int D = 2048, NB = 4, SEQ = 4096, CTXL = 256;
constexpr int RL = NB * SEQ, RC = NB * CTXL, ROWS = RL + RC;
constexpr int NIN = 13568;
constexpr int NMOD = 6 * D;
constexpr float RMS_EPS = 1e-6f;
constexpr int NCH = 68;
constexpr int NSTREAM = NB * 8 * 2;
constexpr int NPH = 12;
constexpr float U_SCALE = 90.50966799f, V_SCALE = 5.656854249f, U_IDELTA = 135.008f;

constexpr size_t al256(size_t x) { return (x + 255) / 256 * 256; }
constexpr size_t WS_CTL = 0;
constexpr size_t WS_MOD = 65536;
constexpr size_t WS_LB = WS_MOD + al256((size_t)2 * 5 * NMOD * 4);
constexpr size_t WS_RT = WS_LB + al256((size_t)2 * 2 * 2 * 1024 * 4);
constexpr size_t WS_RSTD = WS_RT + 8192;
constexpr size_t WS_DEC = WS_RSTD + al256((size_t)2 * ROWS * 4);
constexpr size_t WS_WIN = WS_DEC + al256((size_t)NSTREAM * NCH * 128 * 4);
constexpr size_t WS_WUQ = WS_WIN + (size_t)NIN * D * 2;
constexpr size_t WS_WUKV = WS_WUQ + (size_t)3072 * 512 * 2;
constexpr size_t WS_WA = WS_WUKV + (size_t)4096 * 512 * 2;
constexpr size_t WS_WB = WS_WA + (size_t)D * 1024 * 2;
constexpr size_t WS_WC = WS_WB + (size_t)D * 1024 * 2;
constexpr size_t WS_WO = WS_WC + (size_t)D * D * 2;
constexpr size_t WS_WQ = WS_WO + (size_t)D * D * 2;
constexpr size_t WS_POOLT = WS_WQ + (size_t)D * D * 2;
constexpr size_t WS_KEYS = WS_POOLT + (size_t)4 * 256 * 256 * 2;
constexpr size_t WS_UT = WS_KEYS + (size_t)2 * 8 * 128 * 128 * 2;
constexpr size_t WS_VT = WS_UT + (size_t)16384 * D / 2;
constexpr size_t WS_H8 = WS_VT + (size_t)16384 * D / 2;
constexpr size_t WS_H = WS_H8 + (size_t)ROWS * D;
constexpr size_t WS_QH = WS_H + (size_t)ROWS * D * 2;
constexpr size_t WS_IH = WS_QH + (size_t)ROWS * 1024 * 2;
constexpr size_t WS_GH = WS_IH + (size_t)ROWS * 1024 * 2;
constexpr size_t WS_PU = WS_GH + (size_t)ROWS * 1024 * 2;
constexpr size_t WS_CQ = WS_PU + (size_t)ROWS * 1024 * 2;
constexpr size_t WS_CKV = WS_CQ + (size_t)ROWS * 512 * 2;
constexpr size_t WS_LF = WS_CKV + (size_t)ROWS * 512 * 2;
constexpr size_t WS_GT = WS_LF + (size_t)2 * ROWS * 1024 * 2;
constexpr size_t WS_KR = WS_GT + (size_t)ROWS * 6144 * 2;
constexpr size_t WS_KROPE = WS_KR + (size_t)ROWS * 64 * 4;
constexpr size_t WS_Q = WS_KROPE + (size_t)ROWS * 64 * 2;
constexpr size_t WS_KV = WS_Q + (size_t)ROWS * 3072 * 2;
constexpr size_t WS_ST = WS_KV + (size_t)ROWS * 4096 * 2;
constexpr size_t WS_PYA = WS_ST + (size_t)NSTREAM * NCH * 128 * 128 * 2;
constexpr size_t WS_XC = WS_PYA + (size_t)ROWS * 1024 * 2;
constexpr size_t WS_CB = WS_XC + (size_t)RC * D * 4;
constexpr size_t WS_CQ8 = WS_CB + 65536;
constexpr size_t WS_CKV8 = WS_CQ8 + (size_t)ROWS * 512;
constexpr size_t WS_END = WS_CKV8 + (size_t)ROWS * 512;
constexpr size_t WS_YC = WS_H;
constexpr size_t WS_YB = WS_WIN;
constexpr int LF8_MASK = 1;
constexpr int lf8_pop = ((LF8_MASK >> 0) & 1) + ((LF8_MASK >> 1) & 1) + ((LF8_MASK >> 2) & 1);
__host__ __device__ constexpr int grp_nth(int mask, int k) { int c = 0; for (int g = 0; g < 3; ++g) if ((mask >> g) & 1) { if (c == k) return g; ++c; } return 0; }
__host__ __device__ constexpr int grp_src(int g) { return g == 0 ? 0 : (g == 1 ? 3072 : 4096); }
__host__ __device__ constexpr int grp_lt(int g) { return g == 0 ? 0 : (g == 1 ? 12 : 16); }
constexpr int NIN8 = 10496 + 1024 * lf8_pop, NINF = 1024 * (3 - lf8_pop);
constexpr size_t WS_WIN8 = WS_WIN;
constexpr size_t WS_WINF = WS_WIN + (size_t)NIN8 * D;
static_assert((size_t)NIN8 * D + (size_t)NINF * D * 2 <= (size_t)NIN * D * 2, "WIN region");
constexpr size_t WS_SS = WS_KR;
constexpr size_t WS_M = WS_QH;
constexpr size_t WS_PQ = WS_GH;
constexpr size_t WS_IDX = WS_CQ;
constexpr size_t WS_GATE = WS_CQ + (size_t)ROWS * 128 * 4;
static_assert((size_t)ROWS * 1024 * 2 <= (size_t)NIN * D * 2, "y_b alias");
static_assert(WS_GATE + (size_t)ROWS * 128 * 4 <= WS_LF, "idx/gate alias");

constexpr int LDS_BYTES = 147456;
constexpr int LDS_BARW = LDS_BYTES - 16;

struct Params {
    const float* in[26];
    float* out;
    unsigned char* ws;
    int ph_lo, ph_hi;
};

typedef __bf16 bf16v2_t __attribute__((ext_vector_type(2)));
__device__ __forceinline__ unsigned cvt_pk_bf16(float lo, float hi) { const f32x2 v = {lo, hi}; return __builtin_bit_cast(unsigned, __builtin_convertvector(v, bf16v2_t)); }
__device__ __forceinline__ bf16_t f2bf(float f) { return (bf16_t)(cvt_pk_bf16(f, 0.f) & 0xffffu); }
__device__ __forceinline__ float bf2f(bf16_t b) { return __uint_as_float(((unsigned)b) << 16); }
__device__ __forceinline__ float bflo(unsigned w) { return __uint_as_float(w << 16); }
__device__ __forceinline__ float bfhi(unsigned w) { return __uint_as_float(w & 0xffff0000u); }
__device__ __forceinline__ float swap_add32(float a, float b) {
    auto r = __builtin_amdgcn_permlane32_swap(__float_as_uint(a), __float_as_uint(b), false, false); return __uint_as_float(r[0]) + __uint_as_float(r[1]); }
__device__ __forceinline__ float swap_add16(float a, float b) {
    auto r = __builtin_amdgcn_permlane16_swap(__float_as_uint(a), __float_as_uint(b), false, false); return __uint_as_float(r[0]) + __uint_as_float(r[1]); }
__device__ __forceinline__ float row_sum16(float t) {
    t += __uint_as_float(__builtin_amdgcn_update_dpp(0, __float_as_uint(t), 0x128, 0xf, 0xf, true));
    t += __uint_as_float(__builtin_amdgcn_update_dpp(0, __float_as_uint(t), 0x124, 0xf, 0xf, true));
    t += __uint_as_float(__builtin_amdgcn_update_dpp(0, __float_as_uint(t), 0x122, 0xf, 0xf, true));
    t += __uint_as_float(__builtin_amdgcn_update_dpp(0, __float_as_uint(t), 0x121, 0xf, 0xf, true));
    return t;
}
__device__ __forceinline__ float wave_sum(float v) { const float t = swap_add32(v, v); return row_sum16(swap_add16(t, t)); }
__device__ __forceinline__ float wave_max(float v) {
    auto r = __builtin_amdgcn_permlane32_swap(__float_as_uint(v), __float_as_uint(v), false, false); float t = fmaxf(__uint_as_float(r[0]), __uint_as_float(r[1]));
    auto r2 = __builtin_amdgcn_permlane16_swap(__float_as_uint(t), __float_as_uint(t), false, false); t = fmaxf(__uint_as_float(r2[0]), __uint_as_float(r2[1]));
    t = fmaxf(t, __uint_as_float(__builtin_amdgcn_update_dpp(0, __float_as_uint(t), 0x128, 0xf, 0xf, true)));
    t = fmaxf(t, __uint_as_float(__builtin_amdgcn_update_dpp(0, __float_as_uint(t), 0x124, 0xf, 0xf, true)));
    t = fmaxf(t, __uint_as_float(__builtin_amdgcn_update_dpp(0, __float_as_uint(t), 0x122, 0xf, 0xf, true)));
    t = fmaxf(t, __uint_as_float(__builtin_amdgcn_update_dpp(0, __float_as_uint(t), 0x121, 0xf, 0xf, true)));
    return t;
}
__device__ __forceinline__ float silu_f(float x) { return x * __builtin_amdgcn_rcpf(1.f + __expf(-x)); }
__device__ __forceinline__ float sigmoid_f(float x) { return __builtin_amdgcn_rcpf(1.f + __expf(-x)); }
__device__ __forceinline__ u32x4 pack8(const f32x4 a, const f32x4 b) {
    u32x4 w; w.x = cvt_pk_bf16(a[0], a[1]); w.y = cvt_pk_bf16(a[2], a[3]); w.z = cvt_pk_bf16(b[0], b[1]); w.w = cvt_pk_bf16(b[2], b[3]); return w;
}
__device__ __forceinline__ int ltid() { int t = threadIdx.x; asm volatile("" : "+v"(t)); return t; }
__device__ __forceinline__ int lbid() { int b = blockIdx.x; asm volatile("" : "+s"(b)); return b; }
__device__ __forceinline__ unsigned char* lws(unsigned char* w) { asm volatile("" : "+s"(w)); return w; }
#ifdef DIAG_SCAN
#define DFLAG(cond, k) do { if (cond) atomicMax((unsigned*)(p.ws + WS_CTL) + 8192, 1000u - (unsigned)(k)); } while (0)
#define NONFIN(x) (!(fabsf(x) < 3e38f))
#else
#define DFLAG(cond, k) do {} while (0)
#define NONFIN(x) false
#endif
__device__ __forceinline__ int crow(int r, int hi) { return (r & 3) + 8 * (r >> 2) + 4 * hi; }

#define XB_TMO      128
#define XB_XCNT(j)  (256  + 64 * (j))
#define XB_XSUB(j)  (1280 + 64 * (j))
#define XB_XGEN(j)  (2304 + 64 * (j))
#define XB_TOP      3328
#define XB_TOPGEN   3392
#define XCD_BAR_WORDS 3456
#define XB_SPIN_CAP (1u << 22)

__device__ __forceinline__ unsigned xb_ld(unsigned* p)              { return __hip_atomic_load(p, __ATOMIC_RELAXED, __HIP_MEMORY_SCOPE_AGENT); }
__device__ __forceinline__ unsigned xb_add(unsigned* p, unsigned v) { return __hip_atomic_fetch_add(p, v, __ATOMIC_RELAXED, __HIP_MEMORY_SCOPE_AGENT); }
__device__ __forceinline__ unsigned xb_xcc_id() { return (unsigned)__builtin_amdgcn_s_getreg((3 << 11) | 20) & 0xFu; }
#define XB_SPIN(cond, bar) do { unsigned _sp = 0; while (cond) { __builtin_amdgcn_s_sleep(1); \
    if ((++_sp & 255u) == 0u) { if (xb_ld(&(bar)[XB_TMO])) break; if (_sp > XB_SPIN_CAP) { atomicAdd(&(bar)[XB_TMO], 1u); break; } } } } while (0)

struct XcdBarrier { unsigned* bar; unsigned x; volatile LAS unsigned* st; };

__device__ __forceinline__ XcdBarrier xcd_barrier_post(unsigned* bar, volatile LAS unsigned* st) {
    XcdBarrier b; b.bar = bar; b.x = xb_xcc_id(); b.st = st;
    if (threadIdx.x == 0) (void)xb_add(&bar[XB_XCNT(b.x)], 1u);
    return b;
}
__device__ __forceinline__ void xcd_barrier_complete(unsigned* bar, unsigned x, unsigned& nloc, unsigned& nx) {
    const unsigned G = gridDim.x * gridDim.y * gridDim.z;
    unsigned sum, cnt, mine, sp = 0u;
    for (;;) {
        sum = 0u; cnt = 0u; mine = 0u;
#pragma unroll
        for (unsigned j = 0; j < 16; ++j) { const unsigned c = xb_ld(&bar[XB_XCNT(j)]); sum += c; cnt += (c > 0u) ? 1u : 0u; mine = (j == x) ? c : mine; }
        if (sum == G) break;
        __builtin_amdgcn_s_sleep(1);
        if ((++sp & 255u) == 0u) { if (xb_ld(&bar[XB_TMO])) break; if (sp > XB_SPIN_CAP) { atomicAdd(&bar[XB_TMO], 1u); break; } }
    }
    nloc = mine > 0u ? mine : 1u; nx = cnt > 0u ? cnt : 1u;
}
__device__ __forceinline__ void xcd_barrier(const XcdBarrier& b) {
    asm volatile("s_waitcnt vmcnt(0)" ::: "memory");
    __syncthreads();
    if (threadIdx.x == 0) {
        unsigned* bar = b.bar;
        __builtin_amdgcn_s_waitcnt(0);
        unsigned nloc = b.st[0], nx = b.st[1];
        if (nloc == 0u) { xcd_barrier_complete(bar, b.x, nloc, nx); b.st[0] = nloc; b.st[1] = nx; }
        const unsigned old = xb_add(&bar[XB_XSUB(b.x)], 1u);
        const unsigned gen = old / nloc;
        if (old + 1u == (gen + 1u) * nloc) {
            __builtin_amdgcn_fence(__ATOMIC_RELEASE, "agent");
            asm volatile("s_waitcnt vmcnt(0)" ::: "memory");
            const unsigned og = xb_add(&bar[XB_TOP], 1u);
            const unsigned tg = og / nx;
            if (og + 1u == (tg + 1u) * nx) xb_add(&bar[XB_TOPGEN], 1u);
            else XB_SPIN(xb_ld(&bar[XB_TOPGEN]) == tg, bar);
            __builtin_amdgcn_fence(__ATOMIC_ACQUIRE, "agent");
            xb_add(&bar[XB_XGEN(b.x)], 1u);
            asm volatile("s_waitcnt vmcnt(0)" ::: "memory");
        } else {
            XB_SPIN(xb_ld(&bar[XB_XGEN(b.x)]) == gen, bar);
            __builtin_amdgcn_fence(__ATOMIC_ACQUIRE, "agent");
            asm volatile("s_waitcnt vmcnt(0)" ::: "memory");
        }
    }
    __syncthreads();
}

constexpr int NSUBC = 32;
#define XB_SUBCTR 4096
__device__ __forceinline__ void sub_barrier(unsigned* bar, unsigned target) {
    asm volatile("s_waitcnt vmcnt(0)" ::: "memory");
    __syncthreads();
    if (threadIdx.x == 0) {
        __builtin_amdgcn_fence(__ATOMIC_RELEASE, "agent");
        asm volatile("s_waitcnt vmcnt(0)" ::: "memory");
        (void)xb_add(&bar[XB_SUBCTR], 1u);
        XB_SPIN(xb_ld(&bar[XB_SUBCTR]) < target, bar);
        __builtin_amdgcn_fence(__ATOMIC_ACQUIRE, "agent");
        asm volatile("s_waitcnt vmcnt(0)" ::: "memory");
    }
    __syncthreads();
}

namespace pg8 {
constexpr int BM = 256, BK = 64, HALF = 128, HTB = HALF * BK * 2, STAGE_BYTES = 8 * HTB, NXCD = 8, WGM = 8;
__device__ __forceinline__ int lds_byte(int r, int c) { const int st = (r >> 4) * 2 + (c >> 5), rr = r & 15, cc = c & 31, ob = rr * 64 + cc * 2; return st * 1024 + (ob ^ (((ob >> 9) & 1) << 5)); }
__device__ __forceinline__ void stage_rc(int b, int& R, int& C) { const int st = b / 1024, sb = b % 1024, swz = sb ^ (((sb >> 9) & 1) << 5); R = (st >> 1) * 16 + swz / 64; C = (st & 1) * 32 + (swz % 64) / 2; }
__device__ __forceinline__ int perm32(int rho) { const int n = rho >> 4, i = rho & 15; return 8 * (i >> 2) + 4 * n + (i & 3); }

struct Unit { int pm, pn; };
struct Gemm { const void* A; const void* Bt; int M, N, Kb, ldab, ldbb, acolb; };

struct StaticOrder {
    int nM, nN, nwg, G, c, full, off, span, pm0, xn, xdiv, xbase, xalt;
    __device__ void init(int M, int N, int G_, int c_) { nM = M / BM; nN = N / BM; nwg = nM * nN; G = G_; c = c_; full = 1 << 20; off = 0; span = G_; pm0 = 0; xn = 0; xdiv = 1; xbase = 0; xalt = 0; }
    __device__ void set_extra(int xn_, int xdiv_, int xbase_, int xalt_) { xn = xn_; xdiv = xdiv_; xbase = xbase_; xalt = xalt_; }
    __device__ void set_tail(int full_, int off_, int span_) { full = full_; off = off_; span = span_; }
    __device__ bool next(int i, Unit& u) const {
        long L;
        if (i < full) L = (long)i * G + c;
        else { const int cc = c - off; if (cc < 0 || cc >= span) return false; L = (long)full * G + (long)(i - full) * span + cc; }
        if (L >= nwg) { const int e = (int)L - nwg; if (e >= xn) return false; const int t = e % xdiv; u.pm = pm0 + nM + e / xdiv; u.pn = (xalt < 0) ? (t < 2 ? 6 + t : (t == 2 ? 32 : 30 + t)) : ((xalt && t == xdiv - 1) ? xalt : xbase + t); return true; }
        int wgid = (int)L; { const int q = nwg / NXCD, r = nwg % NXCD, xcd = wgid % NXCD, off = wgid / NXCD; wgid = (xcd < r ? xcd * (q + 1) : r * (q + 1) + (xcd - r) * q) + off; }
        const int nig = WGM * nN, gid = wgid / nig, fm = gid * WGM, gsz = (nM - fm) < WGM ? (nM - fm) : WGM;
        u.pm = pm0 + fm + ((wgid % nig) % gsz); u.pn = (wgid % nig) / gsz; return true;
    }
};

template <bool FP8, class Epi>
__device__ __forceinline__ void gemm_phase(LAS unsigned char* lds, const Gemm g, const StaticOrder& S, const Epi& E) {
    const int tid = ltid(), wid = __builtin_amdgcn_readfirstlane(tid >> 6), lane = tid & 63, wr = wid >> 2, wc = wid & 3, fr = lane & 15, fq = lane >> 4;
    int Kl = g.Kb; asm volatile("" : "+s"(Kl));
    const int nt = Kl / (BK * 2);
    unsigned v_offA, v_offB;
    { int R, C; stage_rc(tid * 16, R, C); const int Rb = (R & ~31) + perm32(R & 31);
      v_offA = (unsigned)(R * g.ldab + C * 2); v_offB = (unsigned)(Rb * g.ldbb + C * 2); }
    const size_t pstep_offA = (size_t)64 * g.ldab, pstep_offB = (size_t)64 * g.ldbb;
    const size_t kstep = (size_t)(BK * 2);
    const size_t hstepA = (size_t)HALF * g.ldab, hstepB = (size_t)HALF * g.ldbb;
    const size_t tstepA = 2 * hstepA, tstepB = 2 * hstepB;
    const unsigned ldsw = (unsigned)wid * 1024u;
    const int aoff = lds_byte(wr * 64 + fr, fq * 8), boff = lds_byte(wc * 32 + fr, fq * 8);
#define PG8_SA(b, h) (((b) * 2 + (h)) * HTB)
#define PG8_SB(b, h) ((4 + (b) * 2 + (h)) * HTB)
#define PG8_STAGE(bufoff, gbase, voff) do { _Pragma("unroll") for (int _i = 0; _i < 2; ++_i) \
        __builtin_amdgcn_global_load_lds((const unsigned*)((const char*)(gbase) + _i * pstep_##voff + v_##voff), (LAS unsigned*)(lds + (bufoff) + ldsw + _i * 8192), 16, 0, 0); } while (0)
#define PG8_RD(off) (*(const LAS i32x4_t*)(lds + (off)))
#define PG8_LDA(dst, b, h) do { _Pragma("unroll") for (int m = 0; m < 4; ++m) dst[m] = __builtin_shufflevector(PG8_RD(PG8_SA(b, h) + aoff + m * 2048), PG8_RD(PG8_SA(b, h) + aoff + m * 2048 + 1024), 0, 1, 2, 3, 4, 5, 6, 7); } while (0)
#define PG8_LDB(dst, b, h) do { _Pragma("unroll") for (int n = 0; n < 2; ++n) dst[n] = __builtin_shufflevector(PG8_RD(PG8_SB(b, h) + boff + n * 2048), PG8_RD(PG8_SB(b, h) + boff + n * 2048 + 1024), 0, 1, 2, 3, 4, 5, 6, 7); } while (0)
#define PG8_LO(X) __builtin_bit_cast(bf16x8, __builtin_shufflevector(X, X, 0, 1, 2, 3))
#define PG8_HI(X) __builtin_bit_cast(bf16x8, __builtin_shufflevector(X, X, 4, 5, 6, 7))
#define PG8_MMA(ai, bj, At, Bt) do { __builtin_amdgcn_s_setprio(1); _Pragma("unroll") for (int m = 0; m < 4; ++m) _Pragma("unroll") for (int n = 0; n < 2; ++n) { \
        if constexpr (FP8) asm volatile("v_mfma_scale_f32_16x16x128_f8f6f4 %0, %1, %2, %0, %3, %3 op_sel_hi:[0,0,0]" : "+v"(acc[ai][bj][m][n]) : "v"(Bt[n]), "v"(At[m]), "v"(scl)); \
        else { acc[ai][bj][m][n] = __builtin_amdgcn_mfma_f32_16x16x32_bf16(PG8_LO(Bt[n]), PG8_LO(At[m]), acc[ai][bj][m][n], 0, 0, 0); \
               acc[ai][bj][m][n] = __builtin_amdgcn_mfma_f32_16x16x32_bf16(PG8_HI(Bt[n]), PG8_HI(At[m]), acc[ai][bj][m][n], 0, 0, 0); } } \
        __builtin_amdgcn_s_setprio(0); } while (0)
#define PG8_WAIT_V(n) asm volatile("s_waitcnt vmcnt(" #n ")" ::: "memory")
#define PG8_WAIT_L(n) asm volatile("s_waitcnt lgkmcnt(" #n ")" ::: "memory")
#define PG8_BAR __builtin_amdgcn_s_barrier()
#define PG8_SCHED __builtin_amdgcn_sched_barrier(0)
    Unit cur, nxt; int ui = 0;
    if (!S.next(0, cur)) return;
    f32x4 acc[2][2][4][2];
#pragma unroll
    for (int a = 0; a < 2; ++a)
#pragma unroll
        for (int b = 0; b < 2; ++b)
#pragma unroll
            for (int m = 0; m < 4; ++m)
#pragma unroll
                for (int n = 0; n < 2; ++n) acc[a][b][m][n] = (f32x4){0.f, 0.f, 0.f, 0.f};
    i32x8_t At[4], B0[2], B1[2];
    int scl = 0x7F7F7F7F; asm volatile("" : "+v"(scl));
    const char* cA = (const char*)g.A + (size_t)cur.pm * tstepA + (size_t)cur.pn * g.acolb; const char* cB = (const char*)g.Bt + (size_t)cur.pn * tstepB;
    PG8_STAGE(PG8_SB(0, 0), cB, offB); PG8_STAGE(PG8_SA(0, 0), cA, offA); PG8_STAGE(PG8_SB(0, 1), cB + hstepB, offB); PG8_STAGE(PG8_SA(0, 1), cA + hstepA, offA);
    if (wr == 1) PG8_BAR;
    PG8_WAIT_V(4); PG8_BAR;
    PG8_STAGE(PG8_SB(1, 0), cB + kstep, offB); PG8_STAGE(PG8_SA(1, 0), cA + kstep, offA); PG8_STAGE(PG8_SB(1, 1), cB + hstepB + kstep, offB);
    PG8_WAIT_V(6); PG8_BAR;
    for (;;) {
        const bool has_next = S.next(ui + 1, nxt);
        const char* nA = has_next ? (const char*)g.A + (size_t)nxt.pm * tstepA + (size_t)nxt.pn * g.acolb : cA; const char* nB = has_next ? (const char*)g.Bt + (size_t)nxt.pn * tstepB : cB;
        for (int t = 0; t < nt; t += 2) {
            const bool last = (t == nt - 2);
            const char* a1 = cA + (size_t)(t + 1) * kstep;
            const char* a2 = last ? nA : cA + (size_t)(t + 2) * kstep; const char* b2 = last ? nB : cB + (size_t)(t + 2) * kstep;
            const char* a3 = a2 + kstep; const char* b3 = b2 + kstep;
            PG8_LDB(B0, 0, 0); PG8_SCHED; PG8_LDA(At, 0, 0); PG8_STAGE(PG8_SA(1, 1), a1 + hstepA, offA);
            PG8_WAIT_L(8); PG8_BAR; PG8_WAIT_L(0); PG8_MMA(0, 0, At, B0); PG8_BAR; PG8_SCHED;
            PG8_LDB(B1, 0, 1); PG8_STAGE(PG8_SB(0, 0), b2, offB);
            PG8_BAR; PG8_WAIT_L(0); PG8_MMA(0, 1, At, B1); PG8_BAR;
            PG8_LDA(At, 0, 1); PG8_STAGE(PG8_SA(0, 0), a2, offA);
            PG8_BAR; PG8_WAIT_L(0); PG8_MMA(1, 0, At, B0); PG8_BAR; PG8_SCHED;
            PG8_STAGE(PG8_SB(0, 1), b2 + hstepB, offB);
            PG8_WAIT_V(6); PG8_BAR; PG8_MMA(1, 1, At, B1); PG8_BAR;
            PG8_LDB(B0, 1, 0); PG8_SCHED; PG8_LDA(At, 1, 0); PG8_STAGE(PG8_SA(0, 1), a2 + hstepA, offA);
            PG8_WAIT_L(8); PG8_BAR; PG8_WAIT_L(0); PG8_MMA(0, 0, At, B0); PG8_BAR; PG8_SCHED;
            PG8_LDB(B1, 1, 1); PG8_STAGE(PG8_SB(1, 0), b3, offB);
            PG8_BAR; PG8_WAIT_L(0); PG8_MMA(0, 1, At, B1); PG8_BAR;
            PG8_LDA(At, 1, 1); PG8_STAGE(PG8_SA(1, 0), a3, offA);
            PG8_BAR; PG8_WAIT_L(0); PG8_MMA(1, 0, At, B0); PG8_BAR; PG8_SCHED;
            PG8_STAGE(PG8_SB(1, 1), b3 + hstepB, offB);
            PG8_WAIT_V(6); PG8_BAR; PG8_MMA(1, 1, At, B1); PG8_BAR;
        }
        if constexpr (FP8) asm volatile("s_nop 15\n\ts_nop 15" ::: "memory");
        { int fr_ = fr, fq_ = fq; asm volatile("" : "+v"(fr_), "+v"(fq_));
          E(acc, cur, wr, wc, fr_, fq_); }
        if (!has_next) break;
#pragma unroll
        for (int a = 0; a < 2; ++a)
#pragma unroll
            for (int b = 0; b < 2; ++b)
#pragma unroll
                for (int m = 0; m < 4; ++m)
#pragma unroll
                    for (int n = 0; n < 2; ++n) acc[a][b][m][n] = (f32x4){0.f, 0.f, 0.f, 0.f};
        cur = nxt; cA = nA; cB = nB; ++ui;
    }
    PG8_WAIT_V(0);
    if (wr == 0) PG8_BAR;
    PG8_BAR;
#undef PG8_SA
#undef PG8_SB
#undef PG8_STAGE
#undef PG8_LDA
#undef PG8_LDB
#undef PG8_MMA
#undef PG8_LO
#undef PG8_HI
#undef PG8_RD
#undef PG8_WAIT_V
#undef PG8_WAIT_L
#undef PG8_BAR
#undef PG8_SCHED
}
}

typedef const f32x4 (&AccRef)[2][2][4][2];

struct EpiLF {
    unsigned char* ws; const float* lbp;
    __device__ __forceinline__ void operator()(AccRef acc, const pg8::Unit& u, int wr, int wc, int fr, int fq) const {
        tile(acc, grp_lt(grp_nth(~LF8_MASK & 7, u.pn >> 2)) + (u.pn & 3), u.pm * 256 + wr * 64 + fr, wc * 32 + 8 * fq, 1.f);
    }
    __device__ __forceinline__ void tile(AccRef acc, const int pn, const int row0, const int lc0, const float mul) const {
        if (pn >= 4 && pn < 12) {
            const int dir = (pn - 4) >> 2, cb = ((pn - 4) & 3) * 256;
            bf16_t* dst = (bf16_t*)(ws + WS_LF) + (size_t)dir * ROWS * 1024;
#pragma unroll
            for (int bj = 0; bj < 2; ++bj) {
                const int c = cb + bj * 128 + lc0;
                float la[8], lb1[8];
#pragma unroll
                for (int e = 0; e < 8; ++e) { la[e] = lbp[dir * 1024 + c + e]; lb1[e] = lbp[2048 + dir * 1024 + c + e]; }
#pragma unroll
                for (int ai = 0; ai < 2; ++ai)
#pragma unroll
                    for (int m = 0; m < 4; ++m) {
                        const int row = row0 + ai * 128 + m * 16;
                        float o[8];
#pragma unroll
                        for (int e = 0; e < 8; ++e) {
                            const float x = acc[ai][bj][m][e >> 2][e & 3] * mul;
                            const float ls = fminf(x, 0.f) - __logf(1.f + __expf(-fabsf(x)));
                            const float a = la[e], b = lb1[e] + ls;
                            const float mx = fmaxf(a, b);
                            o[e] = mx + __logf(1.f + __expf(-fabsf(a - b)));
                        }
                        u32x4 w; w.x = cvt_pk_bf16(o[0], o[1]); w.y = cvt_pk_bf16(o[2], o[3]); w.z = cvt_pk_bf16(o[4], o[5]); w.w = cvt_pk_bf16(o[6], o[7]);
                        *(u32x4*)(dst + (size_t)row * 1024 + c) = w;
                    }
            }
            return;
        }
        bf16_t* dst; int cb, act;
        if (pn < 4) { dst = (bf16_t*)(ws + WS_QH); cb = pn * 256; act = 1; }
        else if (pn < 16) { dst = (bf16_t*)(ws + WS_IH); cb = (pn - 12) * 256; act = 0; }
        else { dst = (bf16_t*)(ws + WS_GH); cb = (pn - 16) * 256; act = 1; }
#pragma unroll
        for (int ai = 0; ai < 2; ++ai)
#pragma unroll
            for (int m = 0; m < 4; ++m) {
                const int row = row0 + ai * 128 + m * 16;
#pragma unroll
                for (int bj = 0; bj < 2; ++bj) {
                    f32x4 v0 = acc[ai][bj][m][0] * mul, v1 = acc[ai][bj][m][1] * mul;
                    if (act == 1) {
#pragma unroll
                        for (int e = 0; e < 4; ++e) { v0[e] = silu_f(v0[e]); v1[e] = silu_f(v1[e]); }
                    }
                    *(u32x4*)(dst + (size_t)row * 1024 + cb + bj * 128 + lc0) = pack8(v0, v1);
                }
            }
    }
};
__device__ __forceinline__ unsigned pack4_fp8(float a, float b, float c, float d);
struct EpiWin8 {
    unsigned char* ws; const float* lbp;
    __device__ __forceinline__ void operator()(AccRef acc, const pg8::Unit& u, int wr, int wc, int fr, int fq) const {
        const int pn = u.pn, row0 = u.pm * 256 + wr * 64 + fr, lc0 = wc * 32 + 8 * fq;
        constexpr float WS_ = 1.f / 32.f;
        if (pn >= 33) { const EpiLF e{ws, lbp}; e.tile(acc, pn < 41 ? pn - 33 + 4 : grp_lt(grp_nth(LF8_MASK, (pn - 41) >> 2)) + ((pn - 41) & 3), row0, lc0, WS_); return; }
        if (pn == 32) {
            if (wc < 2) {
                float* dst = (float*)(ws + WS_KR);
#pragma unroll
                for (int ai = 0; ai < 2; ++ai)
#pragma unroll
                    for (int m = 0; m < 4; ++m) {
                        const int row = row0 + ai * 128 + m * 16;
                        *(f32x4*)(dst + (size_t)row * 64 + lc0) = acc[ai][0][m][0] * WS_;
                        *(f32x4*)(dst + (size_t)row * 64 + lc0 + 4) = acc[ai][0][m][1] * WS_;
                    }
            }
            return;
        }
        bf16_t* dst; int ld, cb, act;
        if (pn < 4) { dst = (bf16_t*)(ws + WS_PU); ld = 1024; cb = pn * 256; act = 0; }
        else if (pn < 6) { dst = (bf16_t*)(ws + WS_CQ); ld = 512; cb = (pn - 4) * 256; act = 0; }
        else if (pn < 8) { dst = (bf16_t*)(ws + WS_CKV); ld = 512; cb = (pn - 6) * 256; act = 0; }
        else { dst = (bf16_t*)(ws + WS_GT); ld = 6144; cb = (pn - 8) * 256; act = 2; }
#pragma unroll
        for (int ai = 0; ai < 2; ++ai)
#pragma unroll
            for (int m = 0; m < 4; ++m) {
                const int row = row0 + ai * 128 + m * 16;
#pragma unroll
                for (int bj = 0; bj < 2; ++bj) {
                    f32x4 v0 = acc[ai][bj][m][0] * WS_, v1 = acc[ai][bj][m][1] * WS_;
                    if (act == 1) {
#pragma unroll
                        for (int e = 0; e < 4; ++e) { v0[e] = silu_f(v0[e]); v1[e] = silu_f(v1[e]); }
                    } else if (act == 2) {
#pragma unroll
                        for (int e = 0; e < 4; ++e) { v0[e] = sigmoid_f(v0[e]); v1[e] = sigmoid_f(v1[e]); }
                    }
                    *(u32x4*)(dst + (size_t)row * ld + cb + bj * 128 + lc0) = pack8(v0, v1);
                    if (pn >= 4 && pn < 8)
                        *(u32x2*)(ws + (pn < 6 ? WS_CQ8 : WS_CKV8) + (size_t)row * 512 + cb + bj * 128 + lc0) = (u32x2){pack4_fp8(v0[0], v0[1], v0[2], v0[3]), pack4_fp8(v1[0], v1[1], v1[2], v1[3])};
                }
            }
    }
};
template <int MODE> struct EpiScale {
    bf16_t* O; int ld; const float* scale; float mul = 1.f;
    __device__ __forceinline__ void operator()(AccRef acc, const pg8::Unit& u, int wr, int wc, int fr, int fq) const {
        const int row0 = u.pm * 256 + wr * 64 + fr, col0 = u.pn * 256 + wc * 32 + 8 * fq;
        float rsv[2][4]; f32x4 csv[2][2];
#pragma unroll
        for (int ai = 0; ai < 2; ++ai)
#pragma unroll
            for (int m = 0; m < 4; ++m) rsv[ai][m] = (MODE == 1) ? scale[row0 + ai * 128 + m * 16] * mul : 1.f;
#pragma unroll
        for (int bj = 0; bj < 2; ++bj)
#pragma unroll
            for (int n = 0; n < 2; ++n) csv[bj][n] = (MODE == 2) ? *(const f32x4*)(scale + col0 + bj * 128 + 4 * n) : (f32x4){1.f, 1.f, 1.f, 1.f};
#pragma unroll
        for (int ai = 0; ai < 2; ++ai)
#pragma unroll
            for (int m = 0; m < 4; ++m) {
                const int row = row0 + ai * 128 + m * 16;
                const float rs = rsv[ai][m];
#pragma unroll
                for (int bj = 0; bj < 2; ++bj) {
                    f32x4 v0 = acc[ai][bj][m][0], v1 = acc[ai][bj][m][1];
                    if (MODE == 1) { v0 *= rs; v1 *= rs; }
                    if (MODE == 2) { v0 *= csv[bj][0]; v1 *= csv[bj][1]; }
                    if (MODE == 2) { v0 *= 4.f; v1 *= 4.f;
                        *(u32x2*)((unsigned char*)O + (size_t)row * (2 * ld) + col0 + bj * 128) = (u32x2){pack4_fp8(v0[0], v0[1], v0[2], v0[3]), pack4_fp8(v1[0], v1[1], v1[2], v1[3])}; }
                    else *(u32x4*)(O + (size_t)row * ld + col0 + bj * 128) = pack8(v0, v1);
                }
            }
    }
};
template <int MODE> struct EpiMerge {
    bf16_t* Mb; const bf16_t* GT; int gofs; float mul = 1.f;
    __device__ __forceinline__ void operator()(AccRef acc, const pg8::Unit& u, int wr, int wc, int fr, int fq) const {
        const int row0 = u.pm * 256 + wr * 64 + fr, col0 = u.pn * 256 + wc * 32 + 8 * fq;
#pragma unroll
        for (int ai = 0; ai < 2; ++ai) {
            u32x4 g[4][2], o[4][2];
#pragma unroll
            for (int m = 0; m < 4; ++m)
#pragma unroll
                for (int bj = 0; bj < 2; ++bj) {
                    const size_t row = (size_t)(row0 + ai * 128 + m * 16); const int col = col0 + bj * 128;
                    g[m][bj] = *(const u32x4*)(GT + row * 6144 + gofs + col);
                    if (MODE) o[m][bj] = *(const u32x4*)(Mb + row * D + col);
                }
#pragma unroll
            for (int m = 0; m < 4; ++m)
#pragma unroll
                for (int bj = 0; bj < 2; ++bj) {
                    const size_t row = (size_t)(row0 + ai * 128 + m * 16); const int col = col0 + bj * 128;
                    const u32x4 gg = g[m][bj];
                    f32x4 v0 = acc[ai][bj][m][0] * mul, v1 = acc[ai][bj][m][1] * mul;
                    v0[0] *= bflo(gg.x); v0[1] *= bfhi(gg.x); v0[2] *= bflo(gg.y); v0[3] *= bfhi(gg.y);
                    v1[0] *= bflo(gg.z); v1[1] *= bfhi(gg.z); v1[2] *= bflo(gg.w); v1[3] *= bfhi(gg.w);
                    if (MODE) { const u32x4 oo = o[m][bj];
                        v0[0] += bflo(oo.x); v0[1] += bfhi(oo.x); v0[2] += bflo(oo.y); v0[3] += bfhi(oo.y);
                        v1[0] += bflo(oo.z); v1[1] += bfhi(oo.z); v1[2] += bflo(oo.w); v1[3] += bfhi(oo.w); }
                    *(u32x4*)(Mb + row * D + col) = pack8(v0, v1);
                }
        }
    }
};
struct EpiResid {
    const float* xin_l; const float* xin_c; float* xout_l; float* xout_c; const float* modl; const float* gain2; bf16_t* XA; float* SS;
    __device__ __forceinline__ void operator()(AccRef acc, const pg8::Unit& u, int wr, int wc, int fr, int fq) const {
        const int col0 = u.pn * 256 + wc * 32 + 8 * fq;
        const bool isc = u.pm >= 64;
        const int mrow = isc ? 4 : (u.pm >> 4);
        const float* xin = isc ? xin_c : xin_l; float* xout = isc ? xout_c : xout_l;
        const int rbase = (isc ? (u.pm - 64) * 256 : u.pm * 256) + wr * 64 + fr;
        const int grow0 = u.pm * 256 + wr * 64 + fr;
        const float* gp = modl + (size_t)mrow * NMOD + 2 * D;
        const float* scp = modl + (size_t)mrow * NMOD + 4 * D;
        f32x4 gs[2][2], av[2][2];
#pragma unroll
        for (int bj = 0; bj < 2; ++bj)
#pragma unroll
            for (int n = 0; n < 2; ++n) {
                gs[bj][n] = *(const f32x4*)(gp + col0 + bj * 128 + 4 * n);
                const f32x4 g2 = *(const f32x4*)(gain2 + col0 + bj * 128 + 4 * n), sc = *(const f32x4*)(scp + col0 + bj * 128 + 4 * n);
                av[bj][n] = g2 * (sc + 1.f);
            }
#pragma unroll
        for (int am = 0; am < 4; ++am) {
            const int ai = am >> 1, m0 = (am & 1) * 2;
            f32x4 xi[2][2][2];
#pragma unroll
            for (int m = 0; m < 2; ++m)
#pragma unroll
                for (int bj = 0; bj < 2; ++bj)
#pragma unroll
                    for (int n = 0; n < 2; ++n) xi[m][bj][n] = *(const f32x4*)(xin + (size_t)(rbase + ai * 128 + (m0 + m) * 16) * D + col0 + bj * 128 + 4 * n);
            float ssr[2];
#pragma unroll
            for (int m = 0; m < 2; ++m) {
                float ss = 0.f;
#pragma unroll
                for (int bj = 0; bj < 2; ++bj) {
                    const f32x4 o0 = xi[m][bj][0] + gs[bj][0] * acc[ai][bj][m0 + m][0], o1 = xi[m][bj][1] + gs[bj][1] * acc[ai][bj][m0 + m][1];
                    *(f32x4*)(xout + (size_t)(rbase + ai * 128 + (m0 + m) * 16) * D + col0 + bj * 128) = o0;
                    *(f32x4*)(xout + (size_t)(rbase + ai * 128 + (m0 + m) * 16) * D + col0 + bj * 128 + 4) = o1;
#pragma unroll
                    for (int e = 0; e < 4; ++e) ss += o0[e] * o0[e] + o1[e] * o1[e];
                    *(u32x4*)(XA + (size_t)(grow0 + ai * 128 + (m0 + m) * 16) * D + col0 + bj * 128) = pack8(o0 * av[bj][0], o1 * av[bj][1]);
                }
                ssr[m] = ss;
            }
            float t = swap_add32(ssr[0], ssr[1]); t = swap_add16(t, t);
            if ((fq & 1) == 0) SS[(size_t)(grow0 + ai * 128 + (m0 + (fq >> 1)) * 16) * 32 + u.pn * 4 + wc] = t;
        }
    }
};
struct EpiPeerQ {
    bf16_t* O; const float* SS; const float* CB;
    __device__ __forceinline__ void operator()(AccRef acc, const pg8::Unit& u, int wr, int wc, int fr, int fq) const {
        const int row0 = u.pm * 256 + wr * 64 + fr, col0 = u.pn * 256 + wc * 32 + 8 * fq;
        const int mrow = (u.pm >= 64) ? 4 : (u.pm >> 4);
        float rs[2][4]; f32x4 cbv[2][2];
#pragma unroll
        for (int ai = 0; ai < 2; ++ai)
#pragma unroll
            for (int m = 0; m < 4; ++m) {
                const float* sp = SS + (size_t)(row0 + ai * 128 + m * 16) * 32 + fq * 8;
                const f32x4 s0 = *(const f32x4*)sp, s1 = *(const f32x4*)(sp + 4);
                rs[ai][m] = ((s0[0] + s0[1]) + (s0[2] + s0[3])) + ((s1[0] + s1[1]) + (s1[2] + s1[3]));
            }
#pragma unroll
        for (int bj = 0; bj < 2; ++bj)
#pragma unroll
            for (int n = 0; n < 2; ++n) cbv[bj][n] = *(const f32x4*)(CB + (size_t)mrow * D + col0 + bj * 128 + 4 * n);
#pragma unroll
        for (int ai = 0; ai < 2; ++ai)
#pragma unroll
            for (int m = 0; m < 4; ++m) { float t = swap_add32(rs[ai][m], rs[ai][m]); t = swap_add16(t, t); rs[ai][m] = rsqrtf(t * (1.f / D) + RMS_EPS); }
#pragma unroll
        for (int ai = 0; ai < 2; ++ai)
#pragma unroll
            for (int m = 0; m < 4; ++m) {
                const int row = row0 + ai * 128 + m * 16;
                const float r = rs[ai][m];
#pragma unroll
                for (int bj = 0; bj < 2; ++bj)
                    *(u32x4*)(O + (size_t)row * D + col0 + bj * 128) = pack8(acc[ai][bj][m][0] * r + cbv[bj][0], acc[ai][bj][m][1] * r + cbv[bj][1]);
            }
    }
};

struct TJob { const float* src; int ldsrc; void* dst; int K, N; const float* kscale; int winmap; float oscale; };
__device__ __forceinline__ void tjob_load(const TJob& j, int t, int nkt, int tid, f32x4& a, f32x4& b) {
    const int kt = t % nkt, ntl = t / nkt, n0 = ntl * 64, k0 = kt * 64;
    int s0 = n0; bool zero = false;
    if (j.winmap == 1) { if (n0 < 2048) s0 = n0 + 5120; else if (n0 < 8192) s0 = n0 - 2048 + 7232; else if (n0 < 8256) s0 = n0 - 8192 + 7168; else if (n0 < 8448) zero = true; else if (n0 < 10496) s0 = n0 - 8448 + 1024;
                         else s0 = grp_src(grp_nth(LF8_MASK, (n0 - 10496) >> 10)) + ((n0 - 10496) & 1023); }
    if (j.winmap == 2) s0 = grp_src(grp_nth(~LF8_MASK & 7, n0 >> 10)) + (n0 & 1023);
    if (j.winmap == 3) s0 = n0;
    const int kk = tid >> 3, cc = (tid & 7) * 8;
    a = (f32x4){0.f, 0.f, 0.f, 0.f}; b = a;
    if (!zero) { const float* sp = j.src + (size_t)(k0 + kk) * j.ldsrc + s0 + cc; a = *(const f32x4*)sp; b = *(const f32x4*)(sp + 4); }
    if (j.kscale) { const float s = j.kscale[k0 + kk]; a *= s; b *= s; }
}
__device__ __forceinline__ void tjob_run(const TJob& j, LAS float* tile  ) {
    const int tid = ltid(), nkt = j.K / 64, nnt = j.N / 64, ntile = nkt * nnt;
    int t = lbid();
    f32x4 a, b, a2, b2;
    if (t < ntile) tjob_load(j, t, nkt, tid, a, b);
    if (t + (int)gridDim.x < ntile) tjob_load(j, t + gridDim.x, nkt, tid, a2, b2);
    for (; t < ntile; t += gridDim.x) {
        const int kt = t % nkt, ntl = t / nkt;
        const int n0 = ntl * 64, k0 = kt * 64;
        __syncthreads();
        {
            const int kk = tid >> 3, cc = (tid & 7) * 8;
#pragma unroll
            for (int e = 0; e < 4; ++e) { tile[kk * 65 + cc + e] = a[e]; tile[kk * 65 + cc + 4 + e] = b[e]; }
        }
        __syncthreads();
        a = a2; b = b2;
        if (t + 2 * (int)gridDim.x < ntile) tjob_load(j, t + 2 * gridDim.x, nkt, tid, a2, b2);
        {
            const int nn = tid >> 3, kc = (tid & 7) * 8;
            float v[8];
#pragma unroll
            for (int e = 0; e < 8; ++e) v[e] = tile[(kc + e) * 65 + nn];
            if (j.winmap == 1 || j.winmap == 3) {
                int t0 = __builtin_amdgcn_cvt_pk_fp8_f32(v[0] * j.oscale, v[1] * j.oscale, 0, false); t0 = __builtin_amdgcn_cvt_pk_fp8_f32(v[2] * j.oscale, v[3] * j.oscale, t0, true);
                int t1 = __builtin_amdgcn_cvt_pk_fp8_f32(v[4] * j.oscale, v[5] * j.oscale, 0, false); t1 = __builtin_amdgcn_cvt_pk_fp8_f32(v[6] * j.oscale, v[7] * j.oscale, t1, true);
                *(u32x2*)((unsigned char*)j.dst + (size_t)(n0 + nn) * j.K + k0 + kc) = (u32x2){(unsigned)t0, (unsigned)t1};
            } else {
                u32x4 w; w.x = cvt_pk_bf16(v[0], v[1]); w.y = cvt_pk_bf16(v[2], v[3]); w.z = cvt_pk_bf16(v[4], v[5]); w.w = cvt_pk_bf16(v[6], v[7]);
                *(u32x4*)((bf16_t*)j.dst + (size_t)(n0 + nn) * j.K + k0 + kc) = w;
            }
        }
    }
    __syncthreads();
}
__device__ __forceinline__ void cvt_plain(const float* src, bf16_t* dst, size_t n8) {
    for (size_t i = (size_t)lbid() * 512 + ltid(); i < n8; i += (size_t)gridDim.x * 512) {
        const f32x4 a = *(const f32x4*)(src + i * 8), b = *(const f32x4*)(src + i * 8 + 4);
        *(u32x4*)(dst + i * 8) = pack8(a, b);
    }
}

__device__ __forceinline__ u32x4 fp4_pack32(const f32x4 (&x)[8], float scale) {
    u32x4 w;
#pragma unroll
    for (int d = 0; d < 4; ++d) {
        const f32x4 a = x[2 * d] * scale, b = x[2 * d + 1] * scale;
        unsigned t = 0u;
        t = __builtin_amdgcn_cvt_scalef32_pk_fp4_f32(t, a[0], a[1], 1.0f, 0);
        t = __builtin_amdgcn_cvt_scalef32_pk_fp4_f32(t, a[2], a[3], 1.0f, 1);
        t = __builtin_amdgcn_cvt_scalef32_pk_fp4_f32(t, b[0], b[1], 1.0f, 2);
        t = __builtin_amdgcn_cvt_scalef32_pk_fp4_f32(t, b[2], b[3], 1.0f, 3);
        w[d] = t;
    }
    return w;
}
__device__ __forceinline__ u32x4 i4_pack32(const f32x4 (&x)[8], float scale) {
    u32x4 w;
#pragma unroll
    for (int d = 0; d < 4; ++d) {
        unsigned t = 0u;
#pragma unroll
        for (int i = 0; i < 8; ++i) {
            const float v = (i < 4) ? x[2 * d][i & 3] : x[2 * d + 1][i & 3];
            const int n = __float2int_rn(__builtin_amdgcn_fmed3f(v * scale - 0.5f, -8.f, 7.f));
            t |= ((unsigned)n & 15u) << (4 * i);
        }
        w[d] = t;
    }
    return w;
}
template <bool I4>
__device__ __forceinline__ void cvt_fp4(const float* src, unsigned char* dst, size_t n32, float scale) {
    const size_t stride = (size_t)gridDim.x * 512;
    for (size_t i = (size_t)lbid() * 512 + ltid(); i < n32; i += 2 * stride) {
        const size_t i2 = i + stride; const bool two = i2 < n32;
        f32x4 x[8], y[8];
#pragma unroll
        for (int q = 0; q < 8; ++q) x[q] = *(const f32x4*)(src + i * 32 + q * 4);
        if (two) {
#pragma unroll
            for (int q = 0; q < 8; ++q) y[q] = *(const f32x4*)(src + i2 * 32 + q * 4);
        }
        *(u32x4*)(dst + i * 16) = I4 ? i4_pack32(x, scale) : fp4_pack32(x, scale);
        if (two) *(u32x4*)(dst + i2 * 16) = I4 ? i4_pack32(y, scale) : fp4_pack32(y, scale);
    }
}
__device__ __forceinline__ void phase_convert(const Params& p, int l, LAS unsigned char* lds) {
    unsigned char* ws = lws(p.ws);
    LAS float* tile = (LAS float*)lds;
    const int tid = ltid();
    if (l == 0) {
        LAS float* sc = (LAS float*)(lds + 32768);
        LAS float* red = (LAS float*)(lds + 32768 + 5 * 2048 * 4);
        for (int i = tid; i < 5 * 2048; i += 512) { const int r = i >> 11, k = i & 2047; const float v = (r < 4) ? p.in[1][r * 2048 + k] : p.in[3][k]; sc[i] = silu_f(v); }
        __syncthreads();
        const int wid = tid >> 6, lane = tid & 63;
        for (int task = lbid(); task < 2 * NMOD / 128; task += gridDim.x) {
            const int ll = task / (NMOD / 128), n0 = (task % (NMOD / 128)) * 128;
            const float* W = p.in[4] + (size_t)ll * D * NMOD + n0 + 2 * lane;
            const int kb = wid * 256;
            f32x2 a0 = {0.f, 0.f}, a1 = a0, a2 = a0, a3 = a0, a4 = a0;
#pragma unroll 16
            for (int k = 0; k < 256; ++k) { const f32x2 w = *(const f32x2*)(W + (size_t)(kb + k) * NMOD);
                a0 += sc[kb + k] * w; a1 += sc[2048 + kb + k] * w; a2 += sc[4096 + kb + k] * w; a3 += sc[6144 + kb + k] * w; a4 += sc[8192 + kb + k] * w; }
            *(LAS f32x2*)(red + (wid * 5 + 0) * 128 + 2 * lane) = a0; *(LAS f32x2*)(red + (wid * 5 + 1) * 128 + 2 * lane) = a1; *(LAS f32x2*)(red + (wid * 5 + 2) * 128 + 2 * lane) = a2;
            *(LAS f32x2*)(red + (wid * 5 + 3) * 128 + 2 * lane) = a3; *(LAS f32x2*)(red + (wid * 5 + 4) * 128 + 2 * lane) = a4;
            __syncthreads();
            for (int i = tid; i < 640; i += 512) { const int r = i >> 7, c = i & 127; float sm = 0.f;
#pragma unroll
                for (int w = 0; w < 8; ++w) sm += red[(w * 5 + r) * 128 + c];
                ((float*)(ws + WS_MOD))[((size_t)ll * 5 + r) * NMOD + n0 + c] = sm + p.in[5][ll * NMOD + n0 + c]; }
            __syncthreads();
        }
        for (int i = lbid() * 512 + tid; i < 2048; i += gridDim.x * 512) {
            float* LB = (float*)(ws + WS_LB);
            const float x0 = p.in[9][i], x1 = p.in[9][2048 + i];
            const float dlt = x1 - x0;
            const float ls1 = fminf(dlt, 0.f) - log1pf(expf(-fabsf(dlt)));
            const float ls0 = fminf(-dlt, 0.f) - log1pf(expf(-fabsf(dlt)));
            LB[i] = -INFINITY; LB[2048 + i] = 0.f;
            LB[4096 + i] = ls1; LB[4096 + 2048 + i] = ls0;
        }
        for (int i = lbid() * 512 + tid; i < 1024; i += gridDim.x * 512) {
            const int pos = i >> 4, jf = i & 15;
            const float fr = powf(10000.f, -(float)jf / 16.f);
            const float ang = (float)pos * fr;
            float* RT = (float*)(ws + WS_RT);
            RT[i * 2] = cosf(ang); RT[i * 2 + 1] = sinf(ang);
        }
    }
    { TJob j{p.in[8] + (size_t)l * D * 13376, 13376, ws + WS_WIN8, D, NIN8, nullptr, 1, 32.f}; tjob_run(j, tile); }
    { TJob j{p.in[8] + (size_t)l * D * 13376, 13376, ws + WS_WINF, D, NINF, nullptr, 2, 1.f}; tjob_run(j, tile); }
    { TJob j{p.in[14] + (size_t)l * 512 * 3072, 3072, ws + WS_WUQ, 512, 3072, p.in[13] + l * 512, 3, 32.f}; tjob_run(j, tile); }
    { TJob j{p.in[16] + (size_t)l * 512 * 4096, 4096, ws + WS_WUKV, 512, 4096, p.in[15] + l * 512, 3, 32.f}; tjob_run(j, tile); }
    { TJob j{p.in[17] + (size_t)l * 1024 * D, D, ws + WS_WA, 1024, D, nullptr, 3, 32.f}; tjob_run(j, tile); }
    { TJob j{p.in[18] + (size_t)l * 1024 * D, D, ws + WS_WB, 1024, D, nullptr, 3, 32.f}; tjob_run(j, tile); }
    { TJob j{p.in[19] + (size_t)l * D * D, D, ws + WS_WC, D, D, nullptr, 3, 32.f}; tjob_run(j, tile); }
    { TJob j{p.in[20] + (size_t)l * D * D, D, (bf16_t*)(ws + WS_WO), D, D, nullptr, 0, 1.f}; tjob_run(j, tile); }
    { TJob j{p.in[21] + (size_t)l * D * D, D, (bf16_t*)(ws + WS_WQ), D, D, nullptr, 0, 1.f}; tjob_run(j, tile); }
    for (int g = 0; g < 4; ++g) { TJob j{p.in[11] + ((size_t)l * 4 + g) * 65536, 256, (bf16_t*)(ws + WS_POOLT) + (size_t)g * 65536, 256, 256, nullptr, 0, 1.f}; tjob_run(j, tile); }
    cvt_plain(p.in[22] + (size_t)l * 2 * 8 * 128 * 128, (bf16_t*)(ws + WS_KEYS), (size_t)2 * 8 * 128 * 128 / 8);
    cvt_fp4<true>(p.in[23] + (size_t)l * 16384 * D, ws + WS_UT, (size_t)16384 * D / 32, U_IDELTA);
    cvt_fp4<false>(p.in[24] + (size_t)l * 16384 * D, ws + WS_VT, (size_t)16384 * D / 32, V_SCALE);
}

__device__ __forceinline__ unsigned pack4_fp8(float a, float b, float c, float d) {
    a = __builtin_amdgcn_fmed3f(a, -448.f, 448.f); b = __builtin_amdgcn_fmed3f(b, -448.f, 448.f); c = __builtin_amdgcn_fmed3f(c, -448.f, 448.f); d = __builtin_amdgcn_fmed3f(d, -448.f, 448.f);
    int t = __builtin_amdgcn_cvt_pk_fp8_f32(a, b, 0, false); return (unsigned)__builtin_amdgcn_cvt_pk_fp8_f32(c, d, t, true); }
__device__ __forceinline__ void modulate_store(const float (&x)[32], float rstd, const float* gain, const float* shift, const float* scale, bf16_t* hrow, unsigned char* h8row, int lane) {
#pragma unroll
    for (int j = 0; j < 4; ++j) {
        const int c = (j * 64 + lane) * 8;
        float o[8];
#pragma unroll
        for (int h4 = 0; h4 < 2; ++h4) {
            const f32x4 g = *(const f32x4*)(gain + c + 4 * h4), sh = *(const f32x4*)(shift + c + 4 * h4), sc = *(const f32x4*)(scale + c + 4 * h4);
#pragma unroll
            for (int e = 0; e < 4; ++e) o[h4 * 4 + e] = x[j * 8 + h4 * 4 + e] * rstd * g[e] * (1.f + sc[e]) + sh[e];
        }
        u32x4 w; w.x = cvt_pk_bf16(o[0], o[1]); w.y = cvt_pk_bf16(o[2], o[3]); w.z = cvt_pk_bf16(o[4], o[5]); w.w = cvt_pk_bf16(o[6], o[7]);
        *(u32x4*)(hrow + c) = w;
        if (h8row) *(u32x2*)(h8row + c) = (u32x2){pack4_fp8(o[0], o[1], o[2], o[3]), pack4_fp8(o[4], o[5], o[6], o[7])};
    }
}
__device__ __forceinline__ void load_row32(const float* xr, float (&x)[32], int lane) {
#pragma unroll
    for (int j = 0; j < 4; ++j) {
        const f32x4 a = *(const f32x4*)(xr + (j * 64 + lane) * 8), b = *(const f32x4*)(xr + (j * 64 + lane) * 8 + 4);
#pragma unroll
        for (int e = 0; e < 4; ++e) { x[j * 8 + e] = a[e]; x[j * 8 + 4 + e] = b[e]; }
    }
}
__device__ __forceinline__ void phase_modulate(const float* xl, const float* xc, const float* gain, const float* modl, int shift_i, int scale_i, bf16_t* H, unsigned char* H8, int nrows, int row0 = 0, int nb = 0) {
    const int tid_ = ltid(); const int wid = tid_ >> 6, lane = tid_ & 63;
    const int rstride = (nb ? nb : (int)gridDim.x) * 8;
    int row = row0 + lbid() * 8 + wid;
    float xn[32];
    if (row < nrows) load_row32((row >= RL) ? xc + (size_t)(row - RL) * D : xl + (size_t)row * D, xn, lane);
    for (; row < nrows; row += rstride) {
        const bool isc = row >= RL;
        const int mrow = isc ? 4 : (row >> 12);
        float x[32];
#pragma unroll
        for (int e = 0; e < 32; ++e) x[e] = xn[e];
        { const int nr = row + rstride;
          if (nr < nrows) load_row32((nr >= RL) ? xc + (size_t)(nr - RL) * D : xl + (size_t)nr * D, xn, lane); }
        float ss = 0.f;
#pragma unroll
        for (int e = 0; e < 32; ++e) ss += x[e] * x[e];
        ss = wave_sum(ss);
        const float rstd = rsqrtf(ss * (1.f / D) + RMS_EPS);
        modulate_store(x, rstd, gain, modl + (size_t)mrow * NMOD + shift_i * D, modl + (size_t)mrow * NMOD + scale_i * D, H + (size_t)row * D, H8 ? H8 + (size_t)row * D : nullptr, lane);
    }
}

__device__ __forceinline__ void phase_misc(const Params& p, int nrows) {
    unsigned char* ws = lws(p.ws);
    const int tid_ = ltid(); const int wid = tid_ >> 6, lane = tid_ & 63;
    const bf16_t* CQ = (const bf16_t*)(ws + WS_CQ); const bf16_t* CKV = (const bf16_t*)(ws + WS_CKV);
    const bf16_t* PU = (const bf16_t*)(ws + WS_PU); bf16_t* PO = (bf16_t*)(ws + WS_PYA);
    float* RS = (float*)(ws + WS_RSTD); const float* KR = (const float*)(ws + WS_KR); bf16_t* KROPE = (bf16_t*)(ws + WS_KROPE);
    const float* RT = (const float*)(ws + WS_RT);
    for (int row = lbid() * 8 + wid; row < ROWS; row += gridDim.x * 8) {
        const u32x4 a = *(const u32x4*)(CQ + (size_t)row * 512 + lane * 8), b = *(const u32x4*)(CKV + (size_t)row * 512 + lane * 8);
        const float xv = KR[(size_t)row * 64 + lane], xp = KR[(size_t)row * 64 + (lane ^ 16)];
        float cs = 1.f, sn = 0.f;
        if (row < RL) { const int t = row & 4095, part = lane >> 5, pos = part ? (t & 63) : (t >> 6), jf = lane & 15; cs = RT[(pos * 16 + jf) * 2]; sn = RT[(pos * 16 + jf) * 2 + 1]; }
        if (row < nrows) {
            const int seq0 = (row < RL) ? (row & ~4095) : (RL + ((row - RL) & ~255)), L = (row < RL) ? 4096 : 256, t = row - seq0;
            u32x4 w0[4], w1[16], me[2];
            float inv[2];
#pragma unroll
            for (int j = 0; j < 2; ++j) {
                const int ch = (j * 64 + lane) * 8, g = ch >> 8, half = 1 << g;
                int lo = t - half, hi = t + half; lo = lo < 0 ? 0 : lo; hi = hi > L ? L : hi;
                inv[j] = 1.f / (float)(hi - lo);
                me[j] = *(const u32x4*)(PU + (size_t)row * 1024 + ch);
                if (j == 0) {
#pragma unroll
                    for (int i = 0; i < 4; ++i) { int r = t - half + i; r = r < 0 ? 0 : (r >= L ? L - 1 : r); w0[i] = *(const u32x4*)(PU + (size_t)(seq0 + r) * 1024 + ch); }
                } else {
#pragma unroll
                    for (int i = 0; i < 16; ++i) { int r = t - half + i; r = r < 0 ? 0 : (r >= L ? L - 1 : r); w1[i] = *(const u32x4*)(PU + (size_t)(seq0 + r) * 1024 + ch); }
                }
            }
#pragma unroll
            for (int j = 0; j < 2; ++j) {
                const int ch = (j * 64 + lane) * 8, g = ch >> 8, half = 1 << g;
                float sacc[8] = {0.f, 0.f, 0.f, 0.f, 0.f, 0.f, 0.f, 0.f};
#pragma unroll
                for (int i = 0; i < (j == 0 ? 4 : 16); ++i) {
                    const int r = t - half + i; const bool ok = (i < 2 * half) && r >= 0 && r < L;
                    const u32x4 w = (j == 0) ? w0[i < 4 ? i : 0] : w1[i];
#pragma unroll
                    for (int e = 0; e < 4; ++e) { sacc[2 * e] += ok ? bflo(w[e]) : 0.f; sacc[2 * e + 1] += ok ? bfhi(w[e]) : 0.f; }
                }
                float o[8];
#pragma unroll
                for (int e = 0; e < 4; ++e) { o[2 * e] = sacc[2 * e] * inv[j] - bflo(me[j][e]); o[2 * e + 1] = sacc[2 * e + 1] * inv[j] - bfhi(me[j][e]); }
                u32x4 w; w.x = cvt_pk_bf16(o[0], o[1]); w.y = cvt_pk_bf16(o[2], o[3]); w.z = cvt_pk_bf16(o[4], o[5]); w.w = cvt_pk_bf16(o[6], o[7]);
                *(u32x4*)(PO + (size_t)row * 1024 + ch) = w;
            }
        }
        {
            float sa = 0.f, sb = 0.f;
#pragma unroll
            for (int e = 0; e < 4; ++e) { const float l0 = bflo(a[e]), h0 = bfhi(a[e]), l1 = bflo(b[e]), h1 = bfhi(b[e]); sa += l0 * l0 + h0 * h0; sb += l1 * l1 + h1 * h1; }
            sa = wave_sum(sa); sb = wave_sum(sb);
            if (lane == 0) { RS[row] = rsqrtf(sa * (1.f / 512.f) + RMS_EPS); RS[ROWS + row] = rsqrtf(sb * (1.f / 512.f) + RMS_EPS); }
        }
        {
            float o = xv;
            if (row < RL) o = (lane & 16) ? (xv * cs + xp * sn) : (xv * cs - xp * sn);
            KROPE[(size_t)row * 64 + lane] = f2bf(o);
        }
    }
}

__device__ __forceinline__ int chunk_row0(int b, int m) { return (m < 4) ? (RL + b * 256 + m * 64) : (b * 4096 + (m - 4) * 64); }
__device__ __forceinline__ int chunk_n(int m, int dir) { return dir ? ((m < 4) ? 3 - m : 71 - m) : m; }

__device__ __forceinline__ void phase_cb(const Params& p, const float* modl) {
    unsigned char* ws = lws(p.ws);
    const int tid = ltid(), wid = tid >> 6, lane = tid & 63;
    const bf16_t* WQ = (const bf16_t*)(ws + WS_WQ); float* CB = (float*)(ws + WS_CB);
    for (int n = lbid() * 8 + wid; n < D; n += gridDim.x * 8) {
        float w[32];
#pragma unroll
        for (int q = 0; q < 4; ++q) { const u32x4 ww = *(const u32x4*)(WQ + (size_t)n * D + lane * 32 + q * 8);
#pragma unroll
            for (int e = 0; e < 4; ++e) { w[q * 8 + 2 * e] = bflo(ww[e]); w[q * 8 + 2 * e + 1] = bfhi(ww[e]); } }
        float acc5[5];
#pragma unroll
        for (int b = 0; b < 5; ++b) {
            const float* sh = modl + (size_t)b * NMOD + 3 * D + lane * 32;
            float a = 0.f;
#pragma unroll
            for (int q = 0; q < 8; ++q) { const f32x4 sv = *(const f32x4*)(sh + q * 4);
#pragma unroll
                for (int e = 0; e < 4; ++e) a += sv[e] * w[q * 4 + e]; }
            acc5[b] = wave_sum(a);
        }
        if (lane < 5) CB[(size_t)lane * D + n] = (lane == 0) ? acc5[0] : (lane == 1) ? acc5[1] : (lane == 2) ? acc5[2] : (lane == 3) ? acc5[3] : acc5[4];
    }
}
__device__ __forceinline__ void hgrn_local(const Params& p, LAS unsigned char* lds) {
    unsigned char* ws = lws(p.ws);
    const int tid = ltid(), wid = tid >> 6, lane = tid & 63, r32 = lane & 31, hi = lane >> 5;
    const bf16_t* LF = (const bf16_t*)(ws + WS_LF); const bf16_t* IH = (const bf16_t*)(ws + WS_IH);
    bf16_t* ST = (bf16_t*)(ws + WS_ST); float* DEC = (float*)(ws + WS_DEC);
    constexpr int LQ = 136;
    LAS bf16_t* KT = (LAS bf16_t*)lds;
    LAS bf16_t* VT = (LAS bf16_t*)(lds + 2 * 128 * 72 * 2);
    LAS bf16_t* RLF = (LAS bf16_t*)(lds + 3 * 128 * 72 * 2);
    LAS float* SEG = (LAS float*)(lds + 3 * 128 * 72 * 2 + 2 * 64 * LQ * 2);
    for (int u = lbid(); u < NB * 8 * NCH; u += gridDim.x) {
        const int m = u % NCH, bh = u / NCH, b = bh >> 3, h = bh & 7, r0 = chunk_row0(b, m);
        __syncthreads();
#pragma unroll
        for (int i = 0; i < 2; ++i) {
            const int id = tid + 512 * i, row = id >> 4, c8 = (id & 15) * 8;
            const size_t g = (size_t)(r0 + row) * 1024 + h * 128 + c8;
            const u32x4 l0 = *(const u32x4*)(LF + g), l1 = *(const u32x4*)(LF + (size_t)ROWS * 1024 + g), vv = *(const u32x4*)(IH + g);
            *(LAS u32x4*)(RLF + row * LQ + c8) = l0; *(LAS u32x4*)(RLF + (64 + row) * LQ + c8) = l1;
#pragma unroll
            for (int e = 0; e < 4; ++e) { VT[(c8 + 2 * e) * 72 + row] = (bf16_t)(vv[e] & 0xffffu); VT[(c8 + 2 * e + 1) * 72 + row] = (bf16_t)(vv[e] >> 16); }
        }
        __syncthreads();
        const int c = tid & 127, seg = tid >> 7;
        float lf[2][16];
#pragma unroll
        for (int d = 0; d < 2; ++d) { float tot = 0.f;
#pragma unroll
            for (int r = 0; r < 16; ++r) { lf[d][r] = bf2f(RLF[(d * 64 + seg * 16 + r) * LQ + c]); tot += lf[d][r]; }
            SEG[(d * 4 + seg) * 128 + c] = tot; }
        __syncthreads();
#pragma unroll
        for (int d = 0; d < 2; ++d) {
            const float s0 = SEG[(d * 4 + 0) * 128 + c], s1 = SEG[(d * 4 + 1) * 128 + c], s2 = SEG[(d * 4 + 2) * 128 + c], s3 = SEG[(d * 4 + 3) * 128 + c];
            float run = (d == 0) ? ((seg < 3 ? s3 : 0.f) + (seg < 2 ? s2 : 0.f) + (seg < 1 ? s1 : 0.f))
                                 : ((seg > 0 ? s0 : 0.f) + (seg > 1 ? s1 : 0.f) + (seg > 2 ? s2 : 0.f));
            LAS bf16_t* dst = KT + (d * 128 + c) * 72 + seg * 16;
#pragma unroll
            for (int rr = 0; rr < 16; ++rr) {
                const int r = (d == 0) ? 15 - rr : rr;
                const float lv = (d == 0) ? lf[0][15 - rr] : lf[1][rr];
                dst[r] = f2bf((1.f - __expf(lv)) * __expf(run));
                run += lv;
            }
            if (seg == 0) DEC[((size_t)((bh * 2 + d) * NCH) + chunk_n(m, d)) * 128 + c] = __expf(s0 + s1 + s2 + s3);
        }
        __syncthreads();
        {
            const int dir = wid >> 2, vt = wid & 3;
            f32x16 acc[4];
#pragma unroll
            for (int ct = 0; ct < 4; ++ct) acc[ct] = (f32x16){0.f};
#pragma unroll
            for (int s_ = 0; s_ < 4; ++s_) {
                const bf16x8 a = *(const LAS bf16x8*)(VT + (vt * 32 + r32) * 72 + s_ * 16 + hi * 8);
#pragma unroll
                for (int ct = 0; ct < 4; ++ct) {
                    const bf16x8 bb = *(const LAS bf16x8*)(KT + (dir * 128 + ct * 32 + r32) * 72 + s_ * 16 + hi * 8);
                    acc[ct] = __builtin_amdgcn_mfma_f32_32x32x16_bf16(a, bb, acc[ct], 0, 0, 0);
                }
            }
            unsigned char* dst = (unsigned char*)ST + ((size_t)((bh * 2 + dir) * NCH) + chunk_n(m, dir)) * 16384;
#pragma unroll
            for (int ct = 0; ct < 4; ++ct)
#pragma unroll
                for (int r = 0; r < 16; ++r) { const float sv = __builtin_amdgcn_fmed3f(acc[ct][r], -448.f, 448.f); dst[(vt * 32 + crow(r, hi)) * 128 + ct * 32 + r32] = (unsigned char)__builtin_amdgcn_cvt_pk_fp8_f32(sv, sv, 0, false); }
        }
    }
    __syncthreads();
}
__device__ __forceinline__ void hgrn_scan(const Params& p) {
    unsigned char* ws = lws(p.ws);
    unsigned char* ST = ws + WS_ST; const float* DEC = (const float*)(ws + WS_DEC);
    for (int gid = lbid() * 512 + ltid(); gid < NSTREAM * 2048; gid += gridDim.x * 512) {
        const int stream = gid >> 11, rem = gid & 2047, c8 = (rem & 15) * 8;
        unsigned char* sp = ST + (size_t)stream * NCH * 16384 + (rem >> 4) * 128 + c8;
        const float* dp = DEC + (size_t)stream * NCH * 128 + c8;
        float S[8] = {0.f, 0.f, 0.f, 0.f, 0.f, 0.f, 0.f, 0.f};
        for (int n0 = 0; n0 < NCH; n0 += 4) {
            u32x2 uw[4]; f32x4 d0[4], d1[4];
#pragma unroll
            for (int i = 0; i < 4; ++i) { uw[i] = *(const u32x2*)(sp + (size_t)(n0 + i) * 16384); d0[i] = *(const f32x4*)(dp + (n0 + i) * 128); d1[i] = *(const f32x4*)(dp + (n0 + i) * 128 + 4); }
#pragma unroll
            for (int i = 0; i < 4; ++i) {
                *(u32x2*)(sp + (size_t)(n0 + i) * 16384) = (u32x2){pack4_fp8(S[0], S[1], S[2], S[3]), pack4_fp8(S[4], S[5], S[6], S[7])};
                const f32x2 u0 = __builtin_amdgcn_cvt_pk_f32_fp8((int)uw[i].x, false), u1 = __builtin_amdgcn_cvt_pk_f32_fp8((int)uw[i].x, true);
                const f32x2 u2 = __builtin_amdgcn_cvt_pk_f32_fp8((int)uw[i].y, false), u3 = __builtin_amdgcn_cvt_pk_f32_fp8((int)uw[i].y, true);
                S[0] = d0[i][0] * S[0] + u0[0]; S[1] = d0[i][1] * S[1] + u0[1]; S[2] = d0[i][2] * S[2] + u1[0]; S[3] = d0[i][3] * S[3] + u1[1];
                S[4] = d1[i][0] * S[4] + u2[0]; S[5] = d1[i][1] * S[5] + u2[1]; S[6] = d1[i][2] * S[6] + u3[0]; S[7] = d1[i][3] * S[7] + u3[1];
            }
        }
    }
}
__device__ __forceinline__ void hgrn_out(const Params& p, int l, bool last, LAS unsigned char* lds) {
    unsigned char* ws = lws(p.ws);
    const int tid = ltid(), wid = tid >> 6, lane = tid & 63, r32 = lane & 31, hi = lane >> 5;
    const bf16_t* LF = (const bf16_t*)(ws + WS_LF); const bf16_t* IH = (const bf16_t*)(ws + WS_IH); const bf16_t* QH = (const bf16_t*)(ws + WS_QH);
    const bf16_t* GH = (const bf16_t*)(ws + WS_GH); const bf16_t* ST = (const bf16_t*)(ws + WS_ST); bf16_t* YA = (bf16_t*)(ws + WS_PYA);
    const float* hgn = p.in[10] + l * 128;
    constexpr int LQ = 136;
    LAS bf16_t* Qt = (LAS bf16_t*)lds;
    LAS bf16_t* Kt = Qt + 64 * LQ;
    LAS bf16_t* Qi = Kt + 64 * LQ;
    LAS bf16_t* VT = Qi + 64 * LQ;
    LAS float* OB = (LAS float*)(lds + 3 * 64 * LQ * 2 + 128 * 72 * 2);
    LAS bf16_t* RQ = (LAS bf16_t*)(lds + 3 * 64 * LQ * 2 + 128 * 72 * 2 + 64 * 132 * 4);
    LAS bf16_t* RL_ = RQ + 64 * LQ;
    LAS float* SEG = (LAS float*)(RL_ + 64 * LQ);
    for (int u = lbid(); u < NB * 8 * NCH; u += gridDim.x) {
        const int m = u % NCH, bh = u / NCH, b = bh >> 3, h = bh & 7, r0 = chunk_row0(b, m);
        if (last && m < 4) continue;
        __syncthreads();
        u32x4 lfr[2][2], ghr[2];
        { const int grow = tid >> 3, gseg = (tid & 7) * 16; const size_t goff = (size_t)(r0 + grow) * 1024 + h * 128 + gseg;
          ghr[0] = *(const u32x4*)(GH + goff); ghr[1] = *(const u32x4*)(GH + goff + 8); }
#pragma unroll
        for (int i = 0; i < 2; ++i) {
            const int id = tid + 512 * i, row = id >> 4, c8 = (id & 15) * 8;
            lfr[0][i] = *(const u32x4*)(LF + (size_t)(r0 + row) * 1024 + h * 128 + c8);
            lfr[1][i] = *(const u32x4*)(LF + (size_t)ROWS * 1024 + (size_t)(r0 + row) * 1024 + h * 128 + c8);
            *(LAS u32x4*)(RQ + row * LQ + c8) = *(const u32x4*)(QH + (size_t)(r0 + row) * 1024 + h * 128 + c8);
            const u32x4 vv = *(const u32x4*)(IH + (size_t)(r0 + row) * 1024 + h * 128 + c8);
#pragma unroll
            for (int e = 0; e < 4; ++e) { VT[(c8 + 2 * e) * 72 + row] = (bf16_t)(vv[e] & 0xffffu); VT[(c8 + 2 * e + 1) * 72 + row] = (bf16_t)(vv[e] >> 16); }
        }
        f32x16 o = (f32x16){0.f};
        const int I = wid >> 2, vt = wid & 3;
        for (int dir = 0; dir < 2; ++dir) {
            __syncthreads();
#pragma unroll
            for (int i = 0; i < 2; ++i) {
                const int id = tid + 512 * i, row = id >> 4, c8 = (id & 15) * 8;
                *(LAS u32x4*)(RL_ + row * LQ + c8) = dir ? lfr[1][i] : lfr[0][i];
            }
            const unsigned char* Sg = (const unsigned char*)ST + ((size_t)((bh * 2 + dir) * NCH) + chunk_n(m, dir)) * 16384 + (size_t)(vt * 32 + r32) * 128 + hi * 8;
            u32x2 sraw[8];
#pragma unroll
            for (int s = 0; s < 8; ++s) sraw[s] = *(const u32x2*)(Sg + s * 16);
            bf16x8 sf[8];
#pragma unroll
            for (int s = 0; s < 8; ++s) {
                const f32x2 u0 = __builtin_amdgcn_cvt_pk_f32_fp8((int)sraw[s].x, false), u1 = __builtin_amdgcn_cvt_pk_f32_fp8((int)sraw[s].x, true);
                const f32x2 u2 = __builtin_amdgcn_cvt_pk_f32_fp8((int)sraw[s].y, false), u3 = __builtin_amdgcn_cvt_pk_f32_fp8((int)sraw[s].y, true);
                u32x4 w; w.x = cvt_pk_bf16(u0[0], u0[1]); w.y = cvt_pk_bf16(u1[0], u1[1]); w.z = cvt_pk_bf16(u2[0], u2[1]); w.w = cvt_pk_bf16(u3[0], u3[1]);
                sf[s] = *reinterpret_cast<bf16x8*>(&w);
            }
            __syncthreads();
            const int c = tid & 127, seg = tid >> 7;
            float lf[16]; float tot = 0.f;
#pragma unroll
            for (int r = 0; r < 16; ++r) { lf[r] = bf2f(RL_[(seg * 16 + r) * LQ + c]); tot += lf[r]; }
            SEG[seg * 128 + c] = tot;
            __syncthreads();
            {
                const float s0 = SEG[c], s1 = SEG[128 + c], s2 = SEG[256 + c], s3 = SEG[384 + c];
                const float bmid = dir ? (s2 + s3) : (s0 + s1);
                float run;
                if (dir == 0) run = (seg > 0 ? s0 : 0.f) + (seg > 1 ? s1 : 0.f) + (seg > 2 ? s2 : 0.f);
                else          run = (seg < 3 ? s3 : 0.f) + (seg < 2 ? s2 : 0.f) + (seg < 1 ? s1 : 0.f);
#pragma unroll
                for (int rr = 0; rr < 16; ++rr) {
                    const int r = dir ? 15 - rr : rr, row = seg * 16 + r;
                    const float lv = dir ? lf[15 - rr] : lf[rr];
                    const float q = bf2f(RQ[row * LQ + c]);
                    run += lv;
                    const float k = 1.f - __expf(lv);
                    const float dq = fminf(fmaxf(run - bmid, -80.f), 80.f);
                    Qt[row * LQ + c] = f2bf(q * __expf(dq));
                    Kt[row * LQ + c] = f2bf(k * __expf(-dq));
                    Qi[row * LQ + c] = f2bf(q * __expf(run));
                }
            }
            __syncthreads();
            for (int Jt = 0; Jt < 2; ++Jt) {
                const bool use = dir ? (Jt >= I) : (Jt <= I);
                if (!use) continue;
                f32x16 X = (f32x16){0.f};
#pragma unroll
                for (int s = 0; s < 8; ++s) {
                    const bf16x8 ka = *(const LAS bf16x8*)(Kt + (Jt * 32 + r32) * LQ + s * 16 + hi * 8);
                    const bf16x8 qb = *(const LAS bf16x8*)(Qt + (I * 32 + r32) * LQ + s * 16 + hi * 8);
                    X = __builtin_amdgcn_mfma_f32_32x32x16_bf16(ka, qb, X, 0, 0, 0);
                }
                if (Jt == I) {
#pragma unroll
                    for (int r = 0; r < 16; ++r) { const bool keep = dir ? (crow(r, hi) >= r32) : (crow(r, hi) <= r32); X[r] = keep ? X[r] : 0.f; }
                }
#pragma unroll
                for (int s2 = 0; s2 < 2; ++s2) {
                    u32x4 pw; pw.x = cvt_pk_bf16(X[8 * s2 + 0], X[8 * s2 + 1]); pw.y = cvt_pk_bf16(X[8 * s2 + 2], X[8 * s2 + 3]); pw.z = cvt_pk_bf16(X[8 * s2 + 4], X[8 * s2 + 5]); pw.w = cvt_pk_bf16(X[8 * s2 + 6], X[8 * s2 + 7]);
                    const int j0 = Jt * 32 + 16 * s2 + 4 * hi;
                    const u32x2 v0 = *(const LAS u32x2*)(VT + (vt * 32 + r32) * 72 + j0), v1 = *(const LAS u32x2*)(VT + (vt * 32 + r32) * 72 + j0 + 8);
                    u32x4 vw; vw.x = v0.x; vw.y = v0.y; vw.z = v1.x; vw.w = v1.y;
                    o = __builtin_amdgcn_mfma_f32_32x32x16_bf16(*(bf16x8*)&pw, *(bf16x8*)&vw, o, 0, 0, 0);
                }
            }
#pragma unroll
            for (int s = 0; s < 8; ++s) {
                const bf16x8 qa = *(const LAS bf16x8*)(Qi + (I * 32 + r32) * LQ + s * 16 + hi * 8);
                o = __builtin_amdgcn_mfma_f32_32x32x16_bf16(qa, sf[s], o, 0, 0, 0);
            }
        }
#pragma unroll
        for (int r = 0; r < 16; ++r) OB[(I * 32 + crow(r, hi)) * 132 + vt * 32 + r32] = o[r];
        __syncthreads();
        {
            const int row = tid >> 3, seg = (tid & 7) * 16;
            float ov[16]; float ss = 0.f;
#pragma unroll
            for (int e = 0; e < 16; ++e) { ov[e] = OB[row * 132 + seg + e]; ss += ov[e] * ov[e]; }
            ss += __shfl_xor(ss, 1); ss += __shfl_xor(ss, 2); ss += __shfl_xor(ss, 4);
            const float rstd = rsqrtf(ss * (1.f / 128.f) + RMS_EPS);
            const size_t off = (size_t)(r0 + row) * 1024 + h * 128 + seg;
            const u32x4 g0 = ghr[0], g1 = ghr[1];
            float y[16];
#pragma unroll
            for (int e = 0; e < 4; ++e) {
                y[2 * e] = ov[2 * e] * rstd * hgn[seg + 2 * e] * bflo(g0[e]); y[2 * e + 1] = ov[2 * e + 1] * rstd * hgn[seg + 2 * e + 1] * bfhi(g0[e]);
                y[8 + 2 * e] = ov[8 + 2 * e] * rstd * hgn[seg + 8 + 2 * e] * bflo(g1[e]); y[8 + 2 * e + 1] = ov[8 + 2 * e + 1] * rstd * hgn[seg + 8 + 2 * e + 1] * bfhi(g1[e]);
            }
            u32x4 w0;
            w0.x = pack4_fp8(y[0] * 8.f, y[1] * 8.f, y[2] * 8.f, y[3] * 8.f); w0.y = pack4_fp8(y[4] * 8.f, y[5] * 8.f, y[6] * 8.f, y[7] * 8.f);
            w0.z = pack4_fp8(y[8] * 8.f, y[9] * 8.f, y[10] * 8.f, y[11] * 8.f); w0.w = pack4_fp8(y[12] * 8.f, y[13] * 8.f, y[14] * 8.f, y[15] * 8.f);
            *(u32x4*)((unsigned char*)YA + (size_t)(r0 + row) * 2048 + h * 128 + seg) = w0;
        }
    }
    __syncthreads();
}

namespace att {
constexpr int SHM_V = 64 * 128 * 2, SHM_K = 64 * 192 * 2;
constexpr float SCALE = 0.07216878364870323f;
constexpr float THR = 8.f;
#define KSWZ(row, c16) ((row) * 384 + ((((c16) ^ (((row) >> 1) & 7))) << 4))
#define SBAR() __builtin_amdgcn_sched_barrier(0)
__device__ __forceinline__ void partialSM(f32x16& p0, f32x16& p1, float& m_reg, float& mn, float& alpha) {
    constexpr float C = SCALE * 1.4426950408889634f;
    float pmax = p0[0];
#pragma unroll
    for (int r = 1; r < 16; ++r) pmax = fmaxf(pmax, p0[r]);
#pragma unroll
    for (int r = 0; r < 16; ++r) pmax = fmaxf(pmax, p1[r]);
    { auto rr = __builtin_amdgcn_permlane32_swap(__float_as_uint(pmax), __float_as_uint(pmax), false, false);
      pmax = fmaxf(__uint_as_float(rr[0]), __uint_as_float(rr[1])); }
    if (__builtin_expect(__all(pmax - m_reg <= THR / SCALE), 1)) { mn = m_reg; alpha = 1.f; }
    else { mn = fmaxf(m_reg, pmax); alpha = __builtin_amdgcn_exp2f((m_reg - mn) * C); m_reg = mn; }
    const float mnC = -mn * C;
#pragma unroll
    for (int r = 0; r < 16; ++r) p0[r] = fmaf(p0[r], C, mnC);
#pragma unroll
    for (int r = 0; r < 16; ++r) p1[r] = fmaf(p1[r], C, mnC);
#pragma unroll
    for (int r = 0; r < 16; ++r) p0[r] = __builtin_amdgcn_exp2f(p0[r]);
}
__device__ __forceinline__ void finishSM(f32x16& p0, f32x16& p1, float alpha, float& l_reg, bf16x8& pa0, bf16x8& pa1, bf16x8& pa2, bf16x8& pa3) {
#pragma unroll
    for (int r = 0; r < 16; ++r) p1[r] = __builtin_amdgcn_exp2f(p1[r]);
    float ps = 0;
#pragma unroll
    for (int r = 0; r < 16; ++r) ps += p0[r];
#pragma unroll
    for (int r = 0; r < 16; ++r) ps += p1[r];
    { auto rr = __builtin_amdgcn_permlane32_swap(__float_as_uint(ps), __float_as_uint(ps), false, false);
      ps = __uint_as_float(rr[0]) + __uint_as_float(rr[1]); }
    l_reg = l_reg * alpha + ps;
#define PK4(P, BASE, OUT) do { unsigned a0 = cvt_pk_bf16(P[BASE + 0], P[BASE + 1]), a1 = cvt_pk_bf16(P[BASE + 2], P[BASE + 3]);   \
    unsigned b0 = cvt_pk_bf16(P[BASE + 4], P[BASE + 5]), b1 = cvt_pk_bf16(P[BASE + 6], P[BASE + 7]);                              \
    auto r0 = __builtin_amdgcn_permlane32_swap(a0, b0, false, false); auto r1 = __builtin_amdgcn_permlane32_swap(a1, b1, false, false); \
    u32x4 w = {r0[0], r1[0], r0[1], r1[1]}; OUT = *reinterpret_cast<bf16x8*>(&w); } while (0)
    PK4(p0, 0, pa0); PK4(p0, 8, pa1); PK4(p1, 0, pa2); PK4(p1, 8, pa3);
#undef PK4
}
__device__ __forceinline__ void qkt(f32x16& p0, f32x16& p1, const LAS char* Ks, const bf16x8* qr, int r32, int hi) {
    p0 = f32x16{}; p1 = f32x16{};
#pragma unroll
    for (int d0 = 0; d0 < 12; ++d0) { const int c16 = d0 * 2 + hi;
        const bf16x8 b0 = *reinterpret_cast<const LAS bf16x8*>(Ks + KSWZ(r32, c16));
        const bf16x8 b1 = *reinterpret_cast<const LAS bf16x8*>(Ks + KSWZ(32 + r32, c16));
        p0 = __builtin_amdgcn_mfma_f32_32x32x16_bf16(b0, qr[d0], p0, 0, 0, 0);
        p1 = __builtin_amdgcn_mfma_f32_32x32x16_bf16(b1, qr[d0], p1, 0, 0, 0); }
}
__device__ __forceinline__ int v_st(int k, int c) { const int kk = (k & ~0xC) | ((k & 4) << 1) | ((k & 8) >> 1); return ((kk >> 3) * 4 + (c >> 5)) * 512 + ((kk & 7) * 32 + (c & 31)) * 2; }
__device__ __forceinline__ int v_rd_base(int lane) { return ((lane & 3) << 3) | (((lane >> 2) & 3) << 6) | (((lane >> 4) & 1) << 5) | (((lane >> 5) & 1) << 8); }
constexpr int v_rd_off(int d0, int ks, int half) { return d0 * 512 + ks * 4096 + half * 2048; }
template <int OFF> __device__ __forceinline__ s16x4 tr_read(int vb) {
    s16x4 r; asm volatile("ds_read_b64_tr_b16 %0, %1 offset:%2" : "=&v"(r) : "v"(vb), "i"(OFF) : "memory"); return r;
}
template <int D0> __device__ __forceinline__ void pv_one(f32x16& od, int vb, bf16x8 pa0, bf16x8 pa1, bf16x8 pa2, bf16x8 pa3) {
    const s16x4 l0 = tr_read<v_rd_off(D0, 0, 0)>(vb), h0 = tr_read<v_rd_off(D0, 0, 1)>(vb), l1 = tr_read<v_rd_off(D0, 1, 0)>(vb), h1 = tr_read<v_rd_off(D0, 1, 1)>(vb);
    const s16x4 l2 = tr_read<v_rd_off(D0, 2, 0)>(vb), h2 = tr_read<v_rd_off(D0, 2, 1)>(vb), l3 = tr_read<v_rd_off(D0, 3, 0)>(vb), h3 = tr_read<v_rd_off(D0, 3, 1)>(vb);
    asm volatile("s_waitcnt lgkmcnt(0)" ::: "memory"); SBAR();
#define PK(L, H) (bf16x8){L[0], L[1], L[2], L[3], H[0], H[1], H[2], H[3]}
    od = __builtin_amdgcn_mfma_f32_32x32x16_bf16(pa0, PK(l0, h0), od, 0, 0, 0);
    od = __builtin_amdgcn_mfma_f32_32x32x16_bf16(pa1, PK(l1, h1), od, 0, 0, 0);
    od = __builtin_amdgcn_mfma_f32_32x32x16_bf16(pa2, PK(l2, h2), od, 0, 0, 0);
    od = __builtin_amdgcn_mfma_f32_32x32x16_bf16(pa3, PK(l3, h3), od, 0, 0, 0);
#undef PK
}
__device__ __forceinline__ void pv_d0(f32x16* o, int vb, bf16x8 pa0, bf16x8 pa1, bf16x8 pa2, bf16x8 pa3) {
    pv_one<0>(o[0], vb, pa0, pa1, pa2, pa3); pv_one<1>(o[1], vb, pa0, pa1, pa2, pa3); pv_one<2>(o[2], vb, pa0, pa1, pa2, pa3); pv_one<3>(o[3], vb, pa0, pa1, pa2, pa3);
}
constexpr int SHM_KV = SHM_K + SHM_V;
__device__ __forceinline__ void attn_unit(const bf16_t* __restrict__ Q, const bf16_t* __restrict__ KV, const bf16_t* __restrict__ KROPE, bf16_t* __restrict__ O, const float* __restrict__ RT,
                                          int q0, int h, int ctx0, int lat0, int nctx, int nkeys, int rope_t0, LAS char* lds) {
    const int tid = ltid(), wid = __builtin_amdgcn_readfirstlane(tid >> 6), lane = tid & 63, r32 = lane & 31, hi = lane >> 5;
    LAS float* wsm = (LAS float*)(lds + 3 * SHM_KV) + wid * 64; LAS float* li_l = wsm; LAS float* al_l = wsm + 32;
    const int vrb = v_rd_base(lane);
    int koff[3]; bool krope[3]; int voff[2];
#pragma unroll
    for (int i = 0; i < 3; ++i) { const int L = (wid + 8 * i) * 64 + lane, row = L / 24, c16 = (L % 24) ^ ((row >> 1) & 7);
        krope[i] = c16 >= 16; koff[i] = krope[i] ? row * 64 + (c16 - 16) * 8 : row * 4096 + c16 * 8; }
#pragma unroll
    for (int i = 0; i < 2; ++i) { const int L = (wid + 8 * i) * 64 + lane, st = L >> 5, w = L & 31, kk = (st >> 2) * 8 + (w >> 2);
        const int k = (kk & ~0xC) | ((kk & 4) << 1) | ((kk & 8) >> 1), c = (st & 3) * 32 + (w & 3) * 8; voff[i] = k * 4096 + 128 + c; }
    const bf16_t* KVh = KV + h * 256;
#define KVROW(k0) (((k0) < nctx) ? (ctx0 + (k0)) : (lat0 + (k0) - nctx))
#define DMA_TILE(t) do { const int _rb = KVROW((t) * 64); const bf16_t* _kv = KVh + (size_t)_rb * 4096; const bf16_t* _kr = KROPE + (size_t)_rb * 64; \
    LAS char* _kb = lds + ((t) % 3) * SHM_KV; \
    _Pragma("unroll") for (int _i = 0; _i < 3; ++_i) __builtin_amdgcn_global_load_lds((const unsigned*)((krope[_i] ? _kr : _kv) + koff[_i]), (LAS unsigned*)(_kb + (wid + 8 * _i) * 1024), 16, 0, 0); \
    _Pragma("unroll") for (int _i = 0; _i < 2; ++_i) __builtin_amdgcn_global_load_lds((const unsigned*)(_kv + voff[_i]), (LAS unsigned*)(_kb + SHM_K + (wid + 8 * _i) * 1024), 16, 0, 0); } while (0)
#define KBUF(t) (lds + ((t) % 3) * SHM_KV)
#define VBASE(t) ((int)(uintptr_t)(lds + ((t) % 3) * SHM_KV + SHM_K) + vrb)
#define LANDED() do { asm volatile("s_waitcnt vmcnt(0)" ::: "memory"); __syncthreads(); } while (0)
#define RESC(a) do { if (__any((a) < 1.f)) { if (hi == 0) al_l[r32] = (a); asm volatile("s_waitcnt lgkmcnt(0)" ::: "memory"); \
    _Pragma("unroll") for (int d = 0; d < 4; ++d) _Pragma("unroll") for (int r = 0; r < 16; ++r) o[d][r] *= al_l[crow(r, hi)]; } } while (0)
    f32x16 pA0, pA1, pB0, pB1; float mnA, mnB, alA, alB; bf16x8 pa0, pa1, pa2, pa3; const int NT = nkeys / 64;
    __syncthreads();
    DMA_TILE(0); DMA_TILE(1);
    float m_reg = -1e30f, l_reg = 0; f32x16 o[4] = {}; bf16x8 qr[12];
    const bf16_t* Qw = Q + (size_t)(q0 + wid * 32 + r32) * 3072 + h * 192 + hi * 8;
#pragma unroll
    for (int d0 = 0; d0 < 12; ++d0) qr[d0] = *reinterpret_cast<const bf16x8*>(Qw + d0 * 16);
    if (rope_t0 >= 0) {
        const int t = rope_t0 + wid * 32 + r32;
#pragma unroll
        for (int part = 0; part < 2; ++part) {
            const int pos = part ? (t & 63) : (t >> 6);
            const u32x4 x1 = *reinterpret_cast<u32x4*>(&qr[8 + 2 * part]), x2 = *reinterpret_cast<u32x4*>(&qr[9 + 2 * part]);
            float a[8], bq[8], o1[8], o2[8];
#pragma unroll
            for (int e = 0; e < 4; ++e) { a[2 * e] = bflo(x1[e]); a[2 * e + 1] = bfhi(x1[e]); bq[2 * e] = bflo(x2[e]); bq[2 * e + 1] = bfhi(x2[e]); }
#pragma unroll
            for (int e = 0; e < 8; ++e) { const f32x2 cssn = *(const f32x2*)(RT + (pos * 16 + hi * 8 + e) * 2); o1[e] = a[e] * cssn.x - bq[e] * cssn.y; o2[e] = bq[e] * cssn.x + a[e] * cssn.y; }
            u32x4 w1, w2;
            w1.x = cvt_pk_bf16(o1[0], o1[1]); w1.y = cvt_pk_bf16(o1[2], o1[3]); w1.z = cvt_pk_bf16(o1[4], o1[5]); w1.w = cvt_pk_bf16(o1[6], o1[7]);
            w2.x = cvt_pk_bf16(o2[0], o2[1]); w2.y = cvt_pk_bf16(o2[2], o2[3]); w2.z = cvt_pk_bf16(o2[4], o2[5]); w2.w = cvt_pk_bf16(o2[6], o2[7]);
            qr[8 + 2 * part] = *reinterpret_cast<bf16x8*>(&w1); qr[9 + 2 * part] = *reinterpret_cast<bf16x8*>(&w2);
        }
    }
    LANDED();
    qkt(pA0, pA1, KBUF(0), qr, r32, hi); partialSM(pA0, pA1, m_reg, mnA, alA);
    LANDED();
#define STEP(c0, c1, mnc, alc, p0_, p1_, alp, j, more) do { \
    if (more) DMA_TILE((j) + 1); \
    SBAR(); qkt(c0, c1, KBUF(j), qr, r32, hi); \
    finishSM(p0_, p1_, alp, l_reg, pa0, pa1, pa2, pa3); SBAR(); \
    pv_d0(o, VBASE((j) - 1), pa0, pa1, pa2, pa3); partialSM(c0, c1, m_reg, mnc, alc); \
    RESC(alc); LANDED(); } while (0)
    int j = 1;
    for (; j + 1 < NT; j += 2) {
        STEP(pB0, pB1, mnB, alB, pA0, pA1, alA, j, true);
        STEP(pA0, pA1, mnA, alA, pB0, pB1, alB, j + 1, true);
    }
    STEP(pB0, pB1, mnB, alB, pA0, pA1, alA, j, false);
    finishSM(pB0, pB1, alB, l_reg, pa0, pa1, pa2, pa3); SBAR();
    pv_d0(o, VBASE(j), pa0, pa1, pa2, pa3);
    if (hi == 0) li_l[r32] = l_reg; asm volatile("s_waitcnt lgkmcnt(0)" ::: "memory");
    float rli[16];
#pragma unroll
    for (int r = 0; r < 16; ++r) rli[r] = __builtin_amdgcn_rcpf(li_l[crow(r, hi)]);
    unsigned char* Ow = (unsigned char*)O + (size_t)(q0 + wid * 32) * (2 * D) + h * 128;
#pragma unroll
    for (int r = 0; r < 16; ++r) { const int orow = crow(r, hi); const float rs = rli[r] * 16.f;
#pragma unroll
        for (int d0 = 0; d0 < 4; ++d0) { const float val = __builtin_amdgcn_fmed3f(o[d0][r] * rs, -448.f, 448.f); Ow[(size_t)orow * (2 * D) + d0 * 32 + r32] = (unsigned char)__builtin_amdgcn_cvt_pk_fp8_f32(val, val, 0, false); } }
#undef KVROW
#undef DMA_TILE
#undef KBUF
#undef VBASE
#undef LANDED
#undef RESC
#undef STEP
}
}

__device__ __forceinline__ void phase_attention(const Params& p, bool last, LAS unsigned char* lds) {
    unsigned char* ws = lws(p.ws);
    const bf16_t* Q = (const bf16_t*)(ws + WS_Q); const bf16_t* KV = (const bf16_t*)(ws + WS_KV); const bf16_t* KROPE = (const bf16_t*)(ws + WS_KROPE);
    bf16_t* O = (bf16_t*)(ws + WS_YC); const float* RT = (const float*)(ws + WS_RT);
    const int nctxu = last ? 0 : 64, total = nctxu + 1024;
    for (int u = lbid(); u < total; u += gridDim.x) {
        if (u < nctxu) {
            const int b = u >> 4, h = u & 15;
            att::attn_unit(Q, KV, KROPE, O, RT, RL + b * 256, h, RL + b * 256, 0, 256, 256, -1, (LAS char*)lds);
        } else {
            int v = u - nctxu;
            if (gridDim.x == 256) {
                const int k = v >> 8, c = v & 255;
                v = (((k << 4) + ((c & 7) << 1) + (c >> 7)) << 4) | ((c >> 3) & 15);
            }
            const int qb = v & 15, h = (v >> 4) & 15, b = v >> 8;
            att::attn_unit(Q, KV, KROPE, O, RT, b * 4096 + qb * 256, h, RL + b * 256, b * 4096, 256, 4352, qb * 256, (LAS char*)lds);
        }
    }
    __syncthreads();
}

__device__ __forceinline__ void ins16(float (&a)[16], float x) {
#pragma unroll
    for (int k = 0; k < 16; ++k) { const float t = fmaxf(a[k], x); x = fminf(a[k], x); a[k] = t; }
}
__device__ __forceinline__ void phase_peer_select(const Params& p, int nrows, LAS unsigned char* lds, int row0 = 0, int nb = 0) {
    unsigned char* ws = lws(p.ws);
    const int tid = ltid(), wid = tid >> 6, lane = tid & 63, r32 = lane & 31, hi = lane >> 5;
    const bf16_t* PQ = (const bf16_t*)(ws + WS_PQ); const bf16_t* KEYS = (const bf16_t*)(ws + WS_KEYS);
    int* IDX = (int*)(ws + WS_IDX); float* GATE = (float*)(ws + WS_GATE);
    const int nwu = (nrows / 32) * 8;
    for (int wu = (row0 / 32) * 8 + lbid() * 8 + wid; wu < nwu; wu += (nb ? nb : (int)gridDim.x) * 8) {
        const int h = wu & 7, tb = wu >> 3, row = tb * 32 + r32;
        float top[2][16];
#pragma unroll
        for (int pp = 0; pp < 2; ++pp) {
            bf16x8 qb[8];
#pragma unroll
            for (int s = 0; s < 8; ++s) qb[s] = *(const bf16x8*)(PQ + (size_t)row * D + h * 256 + pp * 128 + s * 16 + hi * 8);
            float a[16];
#pragma unroll
            for (int k = 0; k < 16; ++k) a[k] = -INFINITY;
#pragma unroll 1
            for (int kt = 0; kt < 4; ++kt) {
                f32x16 acc = (f32x16){0.f};
                const bf16_t* kp = KEYS + ((size_t)(pp * 8 + h) * 128 + kt * 32 + r32) * 128 + hi * 8;
#pragma unroll
                for (int s = 0; s < 8; ++s) acc = __builtin_amdgcn_mfma_f32_32x32x16_bf16(*(const bf16x8*)(kp + s * 16), qb[s], acc, 0, 0, 0);
#pragma unroll
                for (int r = 0; r < 16; ++r) {
                    const unsigned key = kt * 32 + crow(r, hi);
                    ins16(a, __uint_as_float((__float_as_uint(acc[r]) & ~0x7Fu) | key));
                }
            }
            float o[16];
#pragma unroll
            for (int k = 0; k < 16; ++k) o[k] = __shfl_xor(a[k], 32);
#pragma unroll
            for (int k = 0; k < 16; ++k) ins16(a, o[k]);
#pragma unroll
            for (int k = 0; k < 16; ++k) top[pp][k] = a[k];
        }
        LAS int* lut = (LAS int*)lds + wid * 2048 + lane;
#pragma unroll
        for (int k = 0; k < 16; ++k) { lut[k * 64] = (int)(__float_as_uint(top[0][k]) & 0x7Fu); lut[(16 + k) * 64] = (int)(__float_as_uint(top[1][k]) & 0x7Fu); }
        float best[16]; int bid[16];
#pragma unroll
        for (int k = 0; k < 16; ++k) best[k] = -INFINITY;
#pragma unroll
        for (int i = 0; i < 16; ++i)
#pragma unroll
            for (int j = 0; j < 16; ++j) {
                if ((i + 1) * (j + 1) <= 16) {
                    const float v = __uint_as_float(__float_as_uint(top[0][i]) & ~0x7Fu) + __uint_as_float(__float_as_uint(top[1][j]) & ~0x7Fu);
                    ins16(best, __uint_as_float((__float_as_uint(v) & ~0xFFu) | (unsigned)(i * 16 + j)));
                }
            }
        asm volatile("s_waitcnt lgkmcnt(0)" ::: "memory");
#pragma unroll
        for (int k = 0; k < 16; ++k) {
            const unsigned code = __float_as_uint(best[k]) & 0xFFu;
            bid[k] = lut[(code >> 4) * 64] * 128 + lut[(16 + (code & 15u)) * 64];
            best[k] = __uint_as_float(__float_as_uint(best[k]) & ~0xFFu);
        }
        float e[16], sum = 0.f;
#pragma unroll
        for (int k = 0; k < 16; ++k) { e[k] = __expf(best[k] - best[0]); sum += e[k]; }
        const float inv = 1.f / sum;
        if (hi == 0) {
#pragma unroll
            for (int k4 = 0; k4 < 4; ++k4) {
                *(int4*)(IDX + (size_t)row * 128 + h * 16 + k4 * 4) = make_int4(bid[k4 * 4], bid[k4 * 4 + 1], bid[k4 * 4 + 2], bid[k4 * 4 + 3]);
                *(f32x4*)(GATE + (size_t)row * 128 + h * 16 + k4 * 4) = (f32x4){e[k4 * 4] * inv, e[k4 * 4 + 1] * inv, e[k4 * 4 + 2] * inv, e[k4 * 4 + 3] * inv};
            }
        }
    }
}

typedef _Float16 f16x2 __attribute__((ext_vector_type(2)));
__device__ __forceinline__ float dot32_fp4(const u32x4 w, const f16x2* h) {
    float s0 = 0.f, s1 = 0.f, s2 = 0.f, s3 = 0.f;
#define DOT_D(d, acc) { acc = __builtin_amdgcn_fdot2(__builtin_bit_cast(f16x2, __builtin_amdgcn_cvt_scalef32_pk_f16_fp4(w[d], 1.0f, 0)), h[4 * d + 0], acc, false); \
    acc = __builtin_amdgcn_fdot2(__builtin_bit_cast(f16x2, __builtin_amdgcn_cvt_scalef32_pk_f16_fp4(w[d], 1.0f, 1)), h[4 * d + 1], acc, false); \
    acc = __builtin_amdgcn_fdot2(__builtin_bit_cast(f16x2, __builtin_amdgcn_cvt_scalef32_pk_f16_fp4(w[d], 1.0f, 2)), h[4 * d + 2], acc, false); \
    acc = __builtin_amdgcn_fdot2(__builtin_bit_cast(f16x2, __builtin_amdgcn_cvt_scalef32_pk_f16_fp4(w[d], 1.0f, 3)), h[4 * d + 3], acc, false); }
    DOT_D(0, s0) DOT_D(1, s1) DOT_D(2, s2) DOT_D(3, s3)
#undef DOT_D
    return (s0 + s1) + (s2 + s3);
}
__device__ __forceinline__ float dot32_i4(const u32x4 w, const unsigned (&ha)[4], const unsigned (&hb)[4]) {
    int hi = __builtin_amdgcn_sdot8((int)w[0], (int)ha[0], 0, false), lo = __builtin_amdgcn_sdot8((int)w[0], (int)hb[0], 0, false);
#pragma unroll
    for (int d = 1; d < 4; ++d) { hi = __builtin_amdgcn_sdot8((int)w[d], (int)ha[d], hi, false); lo = __builtin_amdgcn_sdot8((int)w[d], (int)hb[d], lo, false); }
    return (float)((hi << 4) + lo);
}
__device__ __forceinline__ void axpy32_fp4(f16x2* o, const u32x4 w, const f16x2 a) {
#define AXPY_B(d, b) o[4 * d + b] = __builtin_elementwise_fma(__builtin_bit_cast(f16x2, __builtin_amdgcn_cvt_scalef32_pk_f16_fp4(w[d], 1.0f, b)), a, o[4 * d + b]);
#pragma unroll
    for (int d = 0; d < 4; ++d) { AXPY_B(d, 0) AXPY_B(d, 1) AXPY_B(d, 2) AXPY_B(d, 3) }
#undef AXPY_B
}
__device__ __forceinline__ float reduce8(const float (&v)[8], int lane) {
    const bool h5 = lane & 32, h4 = lane & 16, h3 = lane & 8;
    float a[4];
#pragma unroll
    for (int i = 0; i < 4; ++i) a[i] = (h5 ? v[4 + i] : v[i]) + __shfl_xor(h5 ? v[i] : v[4 + i], 32);
    float b[2];
#pragma unroll
    for (int i = 0; i < 2; ++i) b[i] = (h4 ? a[2 + i] : a[i]) + __shfl_xor(h4 ? a[i] : a[2 + i], 16);
    float c = (h3 ? b[1] : b[0]) + __shfl_xor(h3 ? b[0] : b[1], 8);
    c += __shfl_xor(c, 4); c += __shfl_xor(c, 2); c += __shfl_xor(c, 1);
    return c;
}
__device__ __forceinline__ float reduce4(const float (&v)[4], int lane) {
    return row_sum16(swap_add16(swap_add32(v[0], v[2]), swap_add32(v[1], v[3])));
}
struct RowMap { int a0, sA, nA, b0, sB, n; __device__ __forceinline__ int operator()(int v) const { return v < nA ? a0 + v * sA : b0 + (v - nA) * sB; } };
__device__ __forceinline__ void phase_peer_gather(const Params& p, int l, bool last, const RowMap rm, LAS unsigned char* lds, int dry = 0) {
    unsigned char* ws = lws(p.ws);
    const int tid = ltid(), wid = tid >> 6, lane = tid & 63;
    const unsigned char* UT4 = ws + WS_UT; const unsigned char* VT4 = ws + WS_VT;
    const int* IDX = (const int*)(ws + WS_IDX); const float* GATE = (const float*)(ws + WS_GATE);
    const float* modl = (const float*)(ws + WS_MOD) + (size_t)l * 5 * NMOD;
    LAS float* actw = (LAS float*)lds + wid * 128;
    const int pself = ((lane >> 5) & 1) * 2 + ((lane >> 4) & 1);
#define ROWIN(r, IA, IB, GA, GB) do { IA = IDX[(size_t)(r) * 128 + lane]; IB = IDX[(size_t)(r) * 128 + 64 + lane]; GA = GATE[(size_t)(r) * 128 + lane]; GB = GATE[(size_t)(r) * 128 + 64 + lane]; } while (0)
#define XLOAD(r, XR) do { const float* _xp = ((r) >= RL) ? (const float*)(ws + WS_XC) + (size_t)((r) - RL) * D : p.out + (size_t)(r) * D; _Pragma("unroll") for (int q = 0; q < 8; ++q) XR[q] = *(const f32x4*)(_xp + lane * 32 + q * 4); } while (0)
    int idxA = 0, idxB = 0; float gA = 0.f, gB = 0.f;
    f32x4 xrow[8];
    int row = rm(0);
    if (rm.n > 0) { ROWIN(row, idxA, idxB, gA, gB); XLOAD(row, xrow); }
    for (int v = 0; v < rm.n; ++v) {
        const bool isc = row >= RL;
        const int mrow = isc ? 4 : (row >> 12);
#define GSEL(g, A, B) ((int)(((unsigned)(A) & (((g) < 16) ? 0xFFFFFFFFu : 0u)) | ((unsigned)(B) & (((g) < 16) ? 0u : 0xFFFFFFFFu))))
#define TLOAD(buf, g, T4) do { const int _si = GSEL(g, idxA, idxB); _Pragma("unroll") for (int q = 0; q < 4; ++q) { const int _e = __builtin_amdgcn_readlane(_si, ((g) * 4 + q) & 63); buf[q] = *(const GAS u32x4*)((const GAS unsigned char*)(T4) + (size_t)_e * 1024 + (unsigned)(lane * 16)); } } while (0)
        u32x4 b0[4], b1[4], b2[4], b3[4], b4[4], b5[4];
        TLOAD(b0, 0, UT4); TLOAD(b1, 1, UT4); TLOAD(b2, 2, UT4); TLOAD(b3, 3, UT4); TLOAD(b4, 4, UT4);
        unsigned ha[4], hb[4]; float kact, halfsq;
        {
            float ssx = 0.f;
#pragma unroll
            for (int q = 0; q < 8; ++q)
#pragma unroll
                for (int e = 0; e < 4; ++e) ssx += xrow[q][e] * xrow[q][e];
            ssx = wave_sum(ssx);
            const float rstd2 = rsqrtf(ssx * (1.f / D) + RMS_EPS);
            const float* g2p = p.in[7] + l * D + lane * 32; const float* scp = modl + (size_t)mrow * NMOD + 4 * D + lane * 32; const float* shp = modl + (size_t)mrow * NMOD + 3 * D + lane * 32;
            float hv[32]; float am = 0.f;
#pragma unroll
            for (int q = 0; q < 8; ++q) {
                const f32x4 g2 = *(const f32x4*)(g2p + q * 4), sc = *(const f32x4*)(scp + q * 4), sh = *(const f32x4*)(shp + q * 4);
#pragma unroll
                for (int e = 0; e < 4; ++e) { const float hval = xrow[q][e] * rstd2 * g2[e] * (1.f + sc[e]) + sh[e]; hv[q * 4 + e] = hval; am = fmaxf(am, fabsf(hval)); }
            }
            am = wave_max(am);
            const float hs = am > 0.f ? 119.f / am : 0.f;
            int sq = 0;
#pragma unroll
            for (int d = 0; d < 4; ++d) {
                unsigned A = 0u, Bn = 0u;
#pragma unroll
                for (int i = 0; i < 8; ++i) {
                    const int q0 = __float2int_rn(hv[d * 8 + i] * hs);
                    sq += q0;
                    Bn |= ((unsigned)q0 & 15u) << (4 * i);
                    A |= ((unsigned)((q0 + 8) >> 4) & 15u) << (4 * i);
                }
                ha[d] = A; hb[d] = Bn;
            }
            halfsq = 0.5f * wave_sum((float)sq);
            kact = am * (1.f / (119.f * U_IDELTA));
        }
#define UCOMP(buf, g) do { float part[4]; if (dry == 2) { _Pragma("unroll") for (int q = 0; q < 4; ++q) part[q] = __uint_as_float(buf[q].x ^ buf[q].y ^ buf[q].z ^ buf[q].w); } else _Pragma("unroll") for (int q = 0; q < 4; ++q) part[q] = dot32_i4(buf[q], ha, hb); \
        const float _r = reduce4(part, lane); if ((lane & 15) == 0) actw[(g) * 4 + pself] = (_r + halfsq) * kact; } while (0)
        {
#pragma unroll 1
            for (int g = 0; g < 30; g += 6) {
                TLOAD(b5, g + 5, UT4); UCOMP(b0, g);
                TLOAD(b0, g + 6, UT4); UCOMP(b1, g + 1);
                TLOAD(b1, g + 7, UT4); UCOMP(b2, g + 2);
                if (g + 8 < 32) TLOAD(b2, g + 8, UT4);
                UCOMP(b3, g + 3);
                if (g + 9 < 32) TLOAD(b3, g + 9, UT4);
                UCOMP(b4, g + 4);
                if (g + 10 < 32) TLOAD(b4, g + 10, UT4);
                UCOMP(b5, g + 5);
            }
            UCOMP(b0, 30); UCOMP(b1, 31);
        }
        u32x4 vb0[4], vb1[4], vb2[4];
        TLOAD(vb0, 0, VT4); TLOAD(vb1, 1, VT4);
        asm volatile("s_waitcnt lgkmcnt(0)" ::: "memory");
        const float aA = actw[lane], aB = actw[64 + lane];
        const float wA = gA * 0.5f * aA * (1.f + erff(aA * 0.70710678118654752f)) * (1.f / V_SCALE), wB = gB * 0.5f * aB * (1.f + erff(aB * 0.70710678118654752f)) * (1.f / V_SCALE);
        const int whA = (int)__builtin_bit_cast(unsigned, (f16x2){(_Float16)wA, (_Float16)wA}), whB = (int)__builtin_bit_cast(unsigned, (f16x2){(_Float16)wB, (_Float16)wB});
#define VCOMP(buf, g) do { if (dry == 2) { _Pragma("unroll") for (int q = 0; q < 4; ++q) out[q] += __uint_as_float(buf[q].x ^ buf[q].y ^ buf[q].z ^ buf[q].w); } else { const int _sw = GSEL(g, whA, whB); _Pragma("unroll") for (int q = 0; q < 4; ++q) { const f16x2 _w2 = __builtin_bit_cast(f16x2, (unsigned)__builtin_amdgcn_readlane(_sw, ((g) * 4 + q) & 63)); axpy32_fp4(oh, buf[q], _w2); } } } while (0)
        float* xr = isc ? (float*)(ws + WS_XC) + (size_t)(row - RL) * D : p.out + (size_t)row * D;
        const float* gp = modl + (size_t)mrow * NMOD + 5 * D;
        f32x4 grow[8];
#pragma unroll
        for (int q = 0; q < 8; ++q) grow[q] = *(const f32x4*)(gp + lane * 32 + q * 4);
        float out[32]; f16x2 oh[16];
#pragma unroll
        for (int e = 0; e < 16; ++e) oh[e] = (f16x2){(_Float16)0.f, (_Float16)0.f};
#pragma unroll
        for (int e = 0; e < 4; ++e) out[e] = 0.f;
        {
#pragma unroll 1
            for (int g = 0; g < 30; g += 3) {
                TLOAD(vb2, g + 2, VT4); VCOMP(vb0, g);
                TLOAD(vb0, g + 3, VT4); VCOMP(vb1, g + 1);
                TLOAD(vb1, g + 4, VT4); VCOMP(vb2, g + 2);
            }
            VCOMP(vb0, 30); VCOMP(vb1, 31);
        }
        if (dry != 2) {
#pragma unroll
            for (int e = 0; e < 16; ++e) { out[2 * e] = (float)oh[e].x; out[2 * e + 1] = (float)oh[e].y; }
        }
#undef GSEL
#undef TLOAD
#undef UCOMP
#undef VCOMP
        float x[32]; float ss = 0.f;
#pragma unroll
        for (int q = 0; q < 8; ++q) {
            const f32x4 xv = xrow[q], gv = grow[q];
#pragma unroll
            for (int e = 0; e < 4; ++e) { const float t = xv[e] + gv[e] * out[q * 4 + e]; x[q * 4 + e] = t; ss += t * t; }
        }
        ss = wave_sum(ss);
        const float rstd = rsqrtf(ss * (1.f / D) + RMS_EPS);
        int nia = 0, nib = 0; float nga = 0.f, ngb = 0.f;
        const bool more = v + 1 < rm.n;
        const int nrow = rm(v + 1);
        if (more) { ROWIN(nrow, nia, nib, nga, ngb); XLOAD(nrow, xrow); }
#define ROWNEXT() do { idxA = nia; idxB = nib; gA = nga; gB = ngb; row = nrow; } while (0)
        if (dry) { if (rstd == 123.456f) xr[lane] = rstd; ROWNEXT(); continue; }
        if (last) {
            const float* fn = p.in[25];
#pragma unroll
            for (int q = 0; q < 8; ++q) {
                const int c = lane * 32 + q * 4;
                const f32x4 f0 = *(const f32x4*)(fn + c);
                f32x4 o0;
#pragma unroll
                for (int e = 0; e < 4; ++e) o0[e] = x[q * 4 + e] * rstd * f0[e];
                *(f32x4*)(xr + c) = o0;
            }
        } else {
            const float* modn = (const float*)(ws + WS_MOD) + (size_t)(l + 1) * 5 * NMOD + (size_t)mrow * NMOD;
            const float* gain = p.in[6] + (l + 1) * D;
            bf16_t* hrow = (bf16_t*)(ws + WS_H) + (size_t)row * D;
#pragma unroll
            for (int q2 = 0; q2 < 4; ++q2) {
                float o[8];
#pragma unroll
                for (int q = 0; q < 2; ++q) {
                    const int c = lane * 32 + q2 * 8 + q * 4;
                    *(f32x4*)(xr + c) = (f32x4){x[q2 * 8 + q * 4], x[q2 * 8 + q * 4 + 1], x[q2 * 8 + q * 4 + 2], x[q2 * 8 + q * 4 + 3]};
                    const f32x4 g = *(const f32x4*)(gain + c), sh = *(const f32x4*)(modn + c), sc = *(const f32x4*)(modn + D + c);
#pragma unroll
                    for (int e = 0; e < 4; ++e) o[q * 4 + e] = x[q2 * 8 + q * 4 + e] * rstd * g[e] * (1.f + sc[e]) + sh[e];
                }
                u32x4 w0;
                w0.x = cvt_pk_bf16(o[0], o[1]); w0.y = cvt_pk_bf16(o[2], o[3]); w0.z = cvt_pk_bf16(o[4], o[5]); w0.w = cvt_pk_bf16(o[6], o[7]);
                *(u32x4*)(hrow + lane * 32 + q2 * 8) = w0;
                *(u32x2*)(ws + WS_H8 + (size_t)row * D + lane * 32 + q2 * 8) = (u32x2){pack4_fp8(o[0], o[1], o[2], o[3]), pack4_fp8(o[4], o[5], o[6], o[7])};
            }
        }
        ROWNEXT();
    }
#undef ROWIN
#undef XLOAD
#undef ROWNEXT
}

#ifdef DIAG_SCAN
__device__ __forceinline__ void dscan_bf16(const void* ptr, size_t nelem, unsigned* word, unsigned k) {
    const u32x4* q = (const u32x4*)ptr; const size_t n8 = nelem / 8; bool bad = false;
    for (size_t i = (size_t)lbid() * 512 + ltid(); i < n8; i += (size_t)gridDim.x * 512) {
        const u32x4 w = q[i];
#pragma unroll
        for (int e = 0; e < 4; ++e) { bad |= ((w[e] & 0x7F80u) == 0x7F80u); bad |= ((w[e] & 0x7F800000u) == 0x7F800000u); }
    }
    if (bad) atomicMax(word, 1000u - k);
}
__device__ __forceinline__ void dscan_f32(const void* ptr, size_t nelem, unsigned* word, unsigned k) {
    const unsigned* q = (const unsigned*)ptr; bool bad = false;
    for (size_t i = (size_t)lbid() * 512 + ltid(); i < nelem; i += (size_t)gridDim.x * 512) bad |= ((q[i] & 0x7F800000u) == 0x7F800000u);
    if (bad) atomicMax(word, 1000u - k);
}
#define DSB(off, n, k) if ((k) < 11) dscan_bf16(ws + (off), (size_t)(n), (unsigned*)(ws + WS_CTL) + 8192, (unsigned)(l * 16 + (k)))
#define DSF(off, n, k) if ((k) < 11) dscan_f32(ws + (off), (size_t)(n), (unsigned*)(ws + WS_CTL) + 8192, (unsigned)(l * 16 + (k)))
#else
#define DSB(off, n, k) do {} while (0)
#define DSF(off, n, k) do {} while (0)
#endif
__global__ void __launch_bounds__(512, 2) fwd_kernel(Params p) {
    extern __shared__ __attribute__((aligned(16))) unsigned char lds_raw[];
    LAS unsigned char* lds = (LAS unsigned char*)lds_raw;
    unsigned char* ws = p.ws;
    const int G = gridDim.x;
#if MK_ONE_LAUNCH
    if (threadIdx.x < 4) ((LAS unsigned*)(lds + LDS_BARW))[threadIdx.x] = 0u;
    __syncthreads();
    XcdBarrier bar = xcd_barrier_post((unsigned*)(ws + WS_CTL), (volatile LAS unsigned*)(lds + LDS_BARW));
#define GRID_BAR() xcd_barrier(bar)
#else
#define GRID_BAR() do {} while (0)
#endif
    const int lo = p.ph_lo, hi = p.ph_hi;
#define IN(k) (lo <= (k) && (k) < hi)
#define SEAM(k) do { if (IN(k) && IN((k) + 1)) { GRID_BAR(); if (PROBE_DUP == 20) GRID_BAR(); } } while (0)
    for (int l = 0; l < 2; ++l) {
        unsigned char* const ws = lws(p.ws);
        const bool last = (l == 1);
        const int base = l * NPH;
        const int nrows = last ? RL : ROWS;
        const float* modl = (const float*)(ws + WS_MOD) + (size_t)l * 5 * NMOD;
        const float* xin_l = (l == 0) ? p.in[0] : p.out;
        const float* xin_c = (l == 0) ? p.in[2] : (const float*)(ws + WS_XC);
        if (PH_ON(0) && IN(base + 0)) { DUP(0) phase_convert(p, l, lds); }
        SEAM(base + 0);
        if (PH_ON(1) && IN(base + 1)) { DSF(WS_MOD, 2 * 5 * NMOD, 1); DSB(WS_WIN, (WS_H - WS_WIN) / 2, 2); }
        if (PH_ON(1) && IN(base + 1) && l == 0) { phase_modulate(xin_l, xin_c, p.in[6] + l * D, modl, 0, 1, (bf16_t*)(ws + WS_H), ws + WS_H8, ROWS); }
        if (l == 0) SEAM(base + 1);
        if (PH_ON(2) && IN(base + 2)) {
            DSB(WS_H, (size_t)ROWS * D, 3);
            DUP(2) {
            if (SUB_ON(8)) {
                pg8::Gemm g{ws + WS_H8, ws + WS_WIN8, ROWS, NIN8, D, D, D, 0};
                pg8::StaticOrder S;
                static_assert(LF8_MASK == 1, "the dealing below is written for q on the fp8 part, i and g on the bf16 part");
                if (!last) { S.init(ROWS, NIN8, G, lbid());
                    if (G == 256) S.set_tail(11, 32, 224); }
                else { S.init(RL, NIN8, G, lbid()); S.set_extra(4 * 11, 11, 0, -1);
                    if (G == 256) S.set_tail(11, 16, 240); }
                EpiWin8 E{ws, (const float*)(ws + WS_LB) + l * 4096};
                pg8::gemm_phase<true>(lds, g, S, E); }
            if (SUB_ON(9)) {
                pg8::Gemm g{ws + WS_H, ws + WS_WINF, ROWS, NINF, 2 * D, 2 * D, 2 * D, 0};
                pg8::StaticOrder S;
                if (!last) S.init(ROWS, NINF, G, lbid());
                else { S.init(RL, NINF, G, lbid()); S.set_extra(4 * 4, 4, 0, 0); }
                EpiLF E{ws, (const float*)(ws + WS_LB) + l * 4096};
                pg8::gemm_phase<false>(lds, g, S, E); }
            }
        }
        SEAM(base + 2);
        if (PH_ON(3) && IN(base + 3)) { DSB(WS_QH, (WS_GT - WS_QH) / 2, 4); DSB(WS_GT, (size_t)ROWS * 6144, 5); DSF(WS_KR, (size_t)ROWS * 64, 6); }
        if (PH_ON(3) && IN(base + 3)) { DUP(3) { if (SUB_ON(0)) { phase_misc(p, nrows); phase_cb(p, modl); } } DUP(13) { if (SUB_ON(1)) hgrn_local(p, lds); } }
        SEAM(base + 3);
        if (PH_ON(4) && IN(base + 4)) {
            DSF(WS_RSTD, 2 * ROWS, 7); DSB(WS_KROPE, (size_t)ROWS * 64, 7); DSB(WS_PYA, (size_t)nrows * 1024, 7); DSB(WS_ST, (size_t)NSTREAM * NCH * 16384, 8); DSF(WS_DEC, (size_t)NSTREAM * NCH * 128, 8);
            __syncthreads();
            if (SUB_ON(4)) hgrn_scan(p);
            DUP(4) {
            if (SUB_ON(5)) {   pg8::Gemm g{ws + WS_CQ8, ws + WS_WUQ, nrows, 3072, 512, 512, 512, 0};
                pg8::StaticOrder S; S.init(nrows, 3072, G, lbid());
                EpiScale<1> E{(bf16_t*)(ws + WS_Q), 3072, (const float*)(ws + WS_RSTD), 1.f / 32.f};
                pg8::gemm_phase<true>(lds, g, S, E); }
            if (SUB_ON(6)) {   pg8::Gemm g{ws + WS_CKV8, ws + WS_WUKV, ROWS, 4096, 512, 512, 512, 0};
                pg8::StaticOrder S; S.init(ROWS, 4096, G, (lbid() + G - 48) % G);
                EpiScale<1> E{(bf16_t*)(ws + WS_KV), 4096, (const float*)(ws + WS_RSTD) + ROWS, 1.f / 32.f};
                pg8::gemm_phase<true>(lds, g, S, E); }
            if (SUB_ON(7)) {   pg8::Gemm g{ws + WS_PYA, ws + WS_POOLT, nrows, 1024, 512, 2048, 512, 512};
                pg8::StaticOrder S; S.init(nrows, 1024, G, (lbid() + G - 112) % G);
                EpiScale<2> E{(bf16_t*)(ws + WS_YB), 1024, p.in[12] + l * 1024};
                pg8::gemm_phase<false>(lds, g, S, E); }
            }
        }
        SEAM(base + 4);
        if (PH_ON(5) && IN(base + 5)) { DSB(WS_Q, (size_t)nrows * 3072, 9); DSB(WS_KV, (size_t)ROWS * 4096, 9); DSB(WS_YB, (size_t)nrows * 1024, 9); DSB(WS_ST, (size_t)NSTREAM * NCH * 16384, 9); }
        if (PH_ON(5) && IN(base + 5)) { DUP(5) { if (SUB_ON(2)) phase_attention(p, last, lds); } DUP(15) { if (SUB_ON(3)) hgrn_out(p, l, last, lds); } }
        SEAM(base + 5);
        const bool side = CTX_SIDE && !last && G > 2 * NSUBC;
        const int nr6 = side ? RL : nrows;
        if (PH_ON(6) && IN(base + 6)) DUP(6) {
            {   pg8::Gemm g{ws + WS_PYA, ws + WS_WA, nr6, D, 1024, 2048, 1024, 0};
                pg8::StaticOrder S; S.init(nr6, D, G, lbid());
                EpiMerge<0> E{(bf16_t*)(ws + WS_M), (const bf16_t*)(ws + WS_GT), 0, 1.f / 256.f};
                pg8::gemm_phase<true>(lds, g, S, E); }
            {   pg8::Gemm g{ws + WS_YB, ws + WS_WB, nr6, D, 1024, 2048, 1024, 0};
                pg8::StaticOrder S; S.init(nr6, D, G, lbid());
                EpiMerge<1> E{(bf16_t*)(ws + WS_M), (const bf16_t*)(ws + WS_GT), D, 1.f / 128.f};
                pg8::gemm_phase<true>(lds, g, S, E); }
            {   pg8::Gemm g{ws + WS_YC, ws + WS_WC, nr6, D, D, 2 * D, D, 0};
                pg8::StaticOrder S; S.init(nr6, D, G, lbid());
                EpiMerge<1> E{(bf16_t*)(ws + WS_M), (const bf16_t*)(ws + WS_GT), 2 * D, 1.f / 512.f};
                pg8::gemm_phase<true>(lds, g, S, E); }
        }
        SEAM(base + 6);
        if (PH_ON(7) && IN(base + 7)) {
            pg8::Gemm g{ws + WS_M, ws + WS_WO, nr6, D, 2 * D, 2 * D, 2 * D, 0};
            pg8::StaticOrder S; S.init(nr6, D, G, lbid());
            EpiResid E{xin_l, xin_c, p.out, (float*)(ws + WS_XC), modl, p.in[7] + l * D, (bf16_t*)(ws + WS_H), (float*)(ws + WS_SS)};
            for (int _d = 0; _d < ((PROBE_DUP == 7 && l == 0) ? 2 : 1); ++_d) pg8::gemm_phase<false>(lds, g, S, E);
        }
        SEAM(base + 7);
        if (PH_ON(9) && IN(base + 9)) {
            pg8::Gemm g{ws + WS_H, ws + WS_WQ, nr6, D, 2 * D, 2 * D, 2 * D, 0};
            pg8::StaticOrder S; S.init(nr6, D, G, lbid());
            EpiPeerQ E{(bf16_t*)(ws + WS_PQ), (const float*)(ws + WS_SS), (const float*)(ws + WS_CB)};
            DUP(9) pg8::gemm_phase<false>(lds, g, S, E);
        }
        SEAM(base + 9);
        if (PH_ON(10) && IN(base + 10)) { DUP(10) phase_peer_select(p, nr6, lds); }
        SEAM(base + 10);
        if (PH_ON(11) && IN(base + 11)) {
            RowMap rm;
            const int wv = __builtin_amdgcn_readfirstlane(ltid() >> 6);
            if (side) {
                const int W = (G - NSUBC) * 8, L1 = (RL / W) * W;
                if (lbid() < NSUBC) {
                    unsigned char* wsc = lws(p.ws);
                    unsigned* barw = (unsigned*)(wsc + WS_CTL); unsigned tgt = 0u;
                    constexpr int NC = ROWS - RL, PM0 = RL / 256;
                    {   pg8::Gemm g{wsc + WS_PYA, wsc + WS_WA, NC, D, 1024, 2048, 1024, 0};
                        pg8::StaticOrder S; S.init(NC, D, NSUBC, lbid()); S.pm0 = PM0;
                        EpiMerge<0> E{(bf16_t*)(wsc + WS_M), (const bf16_t*)(wsc + WS_GT), 0, 1.f / 256.f};
                        pg8::gemm_phase<true>(lds, g, S, E); }
                    {   pg8::Gemm g{wsc + WS_YB, wsc + WS_WB, NC, D, 1024, 2048, 1024, 0};
                        pg8::StaticOrder S; S.init(NC, D, NSUBC, lbid()); S.pm0 = PM0;
                        EpiMerge<1> E{(bf16_t*)(wsc + WS_M), (const bf16_t*)(wsc + WS_GT), D, 1.f / 128.f};
                        pg8::gemm_phase<true>(lds, g, S, E); }
                    {   pg8::Gemm g{wsc + WS_YC, wsc + WS_WC, NC, D, D, 2 * D, D, 0};
                        pg8::StaticOrder S; S.init(NC, D, NSUBC, lbid()); S.pm0 = PM0;
                        EpiMerge<1> E{(bf16_t*)(wsc + WS_M), (const bf16_t*)(wsc + WS_GT), 2 * D, 1.f / 512.f};
                        pg8::gemm_phase<true>(lds, g, S, E); }
                    sub_barrier(barw, tgt += NSUBC);
                    {   pg8::Gemm g{wsc + WS_M, wsc + WS_WO, NC, D, 2 * D, 2 * D, 2 * D, 0};
                        pg8::StaticOrder S; S.init(NC, D, NSUBC, lbid()); S.pm0 = PM0;
                        EpiResid E{xin_l, xin_c, p.out, (float*)(wsc + WS_XC), modl, p.in[7] + l * D, (bf16_t*)(wsc + WS_H), (float*)(wsc + WS_SS)};
                        pg8::gemm_phase<false>(lds, g, S, E); }
                    sub_barrier(barw, tgt += NSUBC);
                    {   pg8::Gemm g{wsc + WS_H, wsc + WS_WQ, NC, D, 2 * D, 2 * D, 2 * D, 0};
                        pg8::StaticOrder S; S.init(NC, D, NSUBC, lbid()); S.pm0 = PM0;
                        EpiPeerQ E{(bf16_t*)(wsc + WS_PQ), (const float*)(wsc + WS_SS), (const float*)(wsc + WS_CB)};
                        pg8::gemm_phase<false>(lds, g, S, E); }
                    sub_barrier(barw, tgt += NSUBC);
                    phase_peer_select(p, ROWS, lds, RL, NSUBC);
                    sub_barrier(barw, tgt += NSUBC);
                    const int w = lbid() * 8 + wv, sw = NSUBC * 8;
                    rm.a0 = RL + w; rm.sA = sw; rm.nA = (NC - w + sw - 1) / sw;
                    rm.b0 = L1 + w; rm.sB = sw; rm.n = rm.nA + ((rm.b0 < RL) ? (RL - rm.b0 + sw - 1) / sw : 0);
                } else {
                    rm.a0 = (lbid() - NSUBC) * 8 + wv; rm.sA = W; rm.nA = RL / W; rm.b0 = 0; rm.sB = 0; rm.n = rm.nA;
                }
            } else {
                const int w = lbid() * 8 + wv, sw = G * 8;
                rm.a0 = w; rm.sA = sw; rm.nA = (w < nrows) ? (nrows - w + sw - 1) / sw : 0; rm.b0 = 0; rm.sB = 0; rm.n = rm.nA;
            }
            if (PROBE_DUP == 11) phase_peer_gather(p, l, last, rm, lds, 1);
            if (PROBE_DUP == 12) phase_peer_gather(p, l, last, rm, lds, 2);
            phase_peer_gather(p, l, last, rm, lds);
        }
        if (!last) SEAM(base + 11);
    }
#undef IN
#undef SEAM
}


#ifdef DIAG_SCAN
__global__ void diag_fill(float* out, const unsigned* word, int n) {
    const unsigned w = *word;
    if (w == 0u) return;
    const float c = sqrtf(10.f * (float)(1000u - w));
    for (int i = blockIdx.x * blockDim.x + threadIdx.x; i < n; i += gridDim.x * blockDim.x) out[i] = c;
}
#endif
extern "C" void kernel_launch(void* const* d_in, const int* in_sizes, int n_in, void* d_out, int out_size, void* d_ws, size_t ws_size, hipStream_t stream) {
    static int grid = 0;
    if (grid == 0) {
        if (n_in != 26 || out_size != RL * D || ws_size < WS_END) { fprintf(stderr, "kernel_launch: unexpected shapes (n_in %d out %d ws %zu need %zu)\n", n_in, out_size, ws_size, (size_t)WS_END); grid = -1; return; }
        int dev = 0, cus = 0, per_cu = 0;
        if (hipGetDevice(&dev) != hipSuccess || hipDeviceGetAttribute(&cus, hipDeviceAttributeMultiprocessorCount, dev) != hipSuccess) { grid = -1; return; }
        if (hipFuncSetAttribute((const void*)fwd_kernel, hipFuncAttributeMaxDynamicSharedMemorySize, LDS_BYTES) != hipSuccess) { fprintf(stderr, "kernel_launch: hipFuncSetAttribute failed\n"); grid = -1; return; }
        if (hipOccupancyMaxActiveBlocksPerMultiprocessor(&per_cu, (const void*)fwd_kernel, 512, LDS_BYTES) != hipSuccess || per_cu < 1) { fprintf(stderr, "kernel_launch: occupancy query says %d\n", per_cu); }
        (void)hipGetLastError();
        grid = cus;
    }
    if (grid < 0) return;
    hipMemsetAsync((char*)d_ws + WS_CTL, 0, 65536, stream);
    Params p{};
    for (int i = 0; i < 26; ++i) p.in[i] = (const float*)d_in[i];
    p.out = (float*)d_out; p.ws = (unsigned char*)d_ws;
#if MK_ONE_LAUNCH
    p.ph_lo = 0; p.ph_hi = 2 * NPH;
    hipLaunchKernelGGL(fwd_kernel, dim3(grid), dim3(512), LDS_BYTES, stream, p);
#else
    for (int ph = 0; ph < 2 * NPH; ++ph) {
#ifndef DIAG_SCAN
        if (ph == NPH + 1) continue;
#endif
        p.ph_lo = ph; p.ph_hi = ph + 1;
        hipLaunchKernelGGL(fwd_kernel, dim3(grid), dim3(512), LDS_BYTES, stream, p);
    }
#endif
#ifdef DIAG_SCAN
    hipLaunchKernelGGL(diag_fill, dim3(1024), dim3(256), 0, stream, (float*)d_out, (const unsigned*)((char*)d_ws + WS_CTL) + 8192, RL * D);
#endif
}
```
